# Optimizing an MI355X kernel written in HIP

```python
import math
import jax
import jax.numpy as jnp
from jax import lax
import numpy as np


D_MODEL = 2048
BATCH = 8
SEQ = 2048
DEPTH = 2

HEAD_DIM = 128
MIX_WIDTH = D_MODEL
A_WIDTH = MIX_WIDTH // 2
A_GROUPS = A_WIDTH // HEAD_DIM
B_HEADS = (MIX_WIDTH - A_WIDTH) // HEAD_DIM
B_WIDTH = B_HEADS * HEAD_DIM
C_WIDTH = MIX_WIDTH // 2
D_HEADS = (MIX_WIDTH - C_WIDTH) // HEAD_DIM
D_WIDTH = D_HEADS * HEAD_DIM
IN_AB = 2 * A_WIDTH + 3 * B_WIDTH
IN_CD = 3 * C_WIDTH + 3 * D_WIDTH
CHUNK = 128
GRID_W = 64
NA_ROWS = 8
NA_COLS = 16
NA_QBLK = 16
NA_BAND = 32
CONV_W = 3
DIL_PATTERNS = ((128, 1), (512, 4), (2048, 16))
DIL_BLOCK = 64
N_EXPERTS = 16
EC_CAPACITY_FACTOR = 2
D_EXPERT = 2048
N_EVEN = (DEPTH + 1) // 2
N_ODD = DEPTH // 2
RMS_EPS = 1e-6
LN_EPS = 1e-5
NEG_INF = -1e30

kernel_name = "hybrid_sgu_natten_shortconv_dilated_ec_moe"


def rms_norm(x, g):
    xf = x.astype(jnp.float32)
    y = xf * lax.rsqrt(jnp.mean(xf * xf, axis=-1, keepdims=True) + RMS_EPS)
    return (y * g.astype(jnp.float32)).astype(x.dtype)


def alibi_slopes(n):
    return np.array([2.0 ** (-8.0 * (h + 1) / n) for h in range(n)], dtype=np.float32)


def spatial_gating_unit(u_raw, v_raw, ln_g, w_s, b_s):
    bsz, seq, _ = u_raw.shape
    u = jax.nn.gelu(u_raw)
    vf = jax.nn.gelu(v_raw).astype(jnp.float32)
    mu = jnp.mean(vf, axis=-1, keepdims=True)
    var = jnp.mean(jnp.square(vf - mu), axis=-1, keepdims=True)
    v = ((vf - mu) * lax.rsqrt(var + LN_EPS) * ln_g.astype(jnp.float32)).astype(u_raw.dtype)
    v = v.reshape(bsz, seq // CHUNK, CHUNK, A_GROUPS, HEAD_DIM)
    mixed = jnp.einsum('gts,bnsgc->bntgc', w_s, v) + b_s.T[None, None, :, :, None]
    return u * mixed.reshape(bsz, seq, A_WIDTH)


def neighbourhood_attention(q, k, v, rpb):
    bsz, seq, nh, dh = q.shape
    rows = seq // GRID_W
    kh = min(NA_ROWS, rows)
    scale = dh ** -0.5
    qg = q.reshape(bsz, rows, GRID_W, nh, dh)
    kg = k.reshape(bsz, rows, GRID_W, nh, dh)
    vg = v.reshape(bsz, rows, GRID_W, nh, dh)
    row_start = jnp.asarray(np.clip(np.arange(rows) - kh // 2, 0, rows - kh), jnp.int32)
    col_start = np.clip(np.arange(GRID_W) - NA_COLS // 2, 0, GRID_W - NA_COLS)
    n_cb = GRID_W // NA_QBLK
    band0 = np.clip(np.arange(n_cb) * NA_QBLK - NA_COLS // 2, 0, GRID_W - NA_BAND)
    key_cols = band0[:, None] + np.arange(NA_BAND)
    q_cols = np.arange(n_cb)[:, None] * NA_QBLK + np.arange(NA_QBLK)
    kc = key_cols[:, None, :]
    qc = q_cols[:, :, None]
    col_valid = jnp.asarray((kc >= col_start[qc]) & (kc < col_start[qc] + NA_COLS))
    dc_idx = np.clip(kc - qc + NA_COLS - 1, 0, 2 * NA_COLS - 2)
    rpb_cols = rpb[:, :, dc_idx]

    def row_block(r):
        rs = row_start[r]
        k_rows = lax.dynamic_slice_in_dim(kg, rs, kh, axis=1)
        v_rows = lax.dynamic_slice_in_dim(vg, rs, kh, axis=1)
        k_band = k_rows[:, :, key_cols]
        v_band = v_rows[:, :, key_cols]
        q_row = lax.dynamic_index_in_dim(qg, r, axis=1, keepdims=False).reshape(bsz, n_cb, NA_QBLK, nh, dh)
        s = jnp.einsum('bcihd,bacjhd->bhciaj', q_row, k_band).astype(jnp.float32) * scale
        bias = rpb_cols[:, rs + jnp.arange(kh) - r + NA_ROWS - 1]
        s = s + bias.transpose(0, 2, 3, 1, 4)[None].astype(jnp.float32)
        s = jnp.where(col_valid[None, None, :, :, None, :], s, NEG_INF)
        p = jax.nn.softmax(s, axis=(-2, -1))
        o = jnp.einsum('bhciaj,bacjhd->bcihd', p.astype(v.dtype), v_band)
        return o.reshape(bsz, GRID_W, nh, dh)

    out = lax.map(row_block, jnp.arange(rows, dtype=jnp.int32))
    return out.transpose(1, 0, 2, 3, 4).reshape(bsz, seq, nh * dh)


def dilated_branch(q, k, v, dil, radius, slopes):
    bsz, seq, nh, dh = q.shape
    length = seq // dil
    blk = DIL_BLOCK
    nb = -(-length // blk)
    lp = nb * blk
    n = bsz * dil
    scale = dh ** -0.5

    def to_sub(t):
        return t.reshape(bsz, length, dil, nh, dh).transpose(0, 2, 1, 3, 4).reshape(n, length, nh, dh)

    def band(t):
        tp = jnp.pad(t, ((0, 0), (blk, lp - length + blk), (0, 0), (0, 0))).reshape(n, nb + 2, blk, nh, dh)
        return jnp.concatenate([tp[:, :-2], tp[:, 1:-1], tp[:, 2:]], axis=2)

    qs = jnp.pad(to_sub(q), ((0, 0), (0, lp - length), (0, 0), (0, 0))).reshape(n, nb, blk, nh, dh)
    kb = band(to_sub(k))
    vb = band(to_sub(v))
    s = jnp.einsum('nqihd,nqjhd->nqhij', qs, kb).astype(jnp.float32) * scale
    delta = np.arange(3 * blk)[None, :] - blk - np.arange(blk)[:, None]
    tk = (np.arange(nb)[:, None] - 1) * blk + np.arange(3 * blk)[None, :]
    valid = (np.abs(delta) <= radius)[None] & ((tk >= 0) & (tk < length))[:, None, :]
    penalty = (slopes[:, None, None] * (np.abs(delta) * dil)[None]).astype(np.float32)
    s = s - jnp.asarray(penalty)[None, None]
    s = jnp.where(jnp.asarray(valid)[None, :, None], s, NEG_INF)
    m = jnp.max(s, axis=-1, keepdims=True)
    e = jnp.exp(s - m)
    l = jnp.sum(e, axis=-1, keepdims=True)
    o = jnp.einsum('nqhij,nqjhd->nqihd', (e / l).astype(v.dtype), vb).reshape(n, lp, nh, dh)[:, :length]
    lse = (m + jnp.log(l))[..., 0].transpose(0, 1, 3, 2).reshape(n, lp, nh)[:, :length]
    o = o.reshape(bsz, dil, length, nh, dh).transpose(0, 2, 1, 3, 4).reshape(bsz, seq, nh, dh)
    lse = lse.reshape(bsz, dil, length, nh).transpose(0, 2, 1, 3).reshape(bsz, seq, nh)
    return o, lse


def dilated_attention(q, k, v):
    bsz, seq, nh, dh = q.shape
    slopes = alibi_slopes(nh)
    outs, lses = [], []
    for window, dil in DIL_PATTERNS:
        o, lse = dilated_branch(q, k, v, dil, window // (2 * dil), slopes)
        outs.append(o)
        lses.append(lse)
    alpha = jax.nn.softmax(jnp.stack(lses), axis=0)
    out = jnp.einsum('pbsh,pbshd->bshd', alpha.astype(q.dtype), jnp.stack(outs))
    return out.reshape(bsz, seq, nh * dh)


def gated_short_conv(b_gate, c_gate, xin, taps):
    z = c_gate * xin
    y = lax.conv_general_dilated(z, taps[:, None, :], window_strides=(1,),
                                 padding=((CONV_W // 2, CONV_W // 2),),
                                 dimension_numbers=('NWC', 'WIO', 'NWC'),
                                 feature_group_count=C_WIDTH)
    return b_gate * y


def expert_choice_moe(h, router, w_gate, w_up, w_down):
    bsz, seq, d = h.shape
    cap = EC_CAPACITY_FACTOR * seq // N_EXPERTS
    aff = jax.nn.softmax(jnp.einsum('bsd,de->bse', h, router).astype(jnp.float32), axis=-1)
    gate, idx = lax.top_k(aff.transpose(0, 2, 1), cap)
    xe = jax.vmap(lambda hb, ib: hb[ib])(h, idx)
    hid = jax.nn.silu(jnp.einsum('becd,edf->becf', xe, w_gate)) * jnp.einsum('becd,edf->becf', xe, w_up)
    ye = jnp.einsum('becf,efd->becd', hid, w_down) * gate[..., None].astype(h.dtype)
    return jax.vmap(lambda ib, yb: jnp.zeros((seq, d), yb.dtype).at[ib.reshape(-1)].add(yb.reshape(-1, d)))(idx, ye)


def setup_inputs(seed: int = 0) -> dict:
    key = jax.random.key(seed)
    ks = jax.random.split(key, 17)
    nrm = jax.random.normal
    f32 = jnp.float32
    return {
        'x': nrm(ks[0], (BATCH, SEQ, D_MODEL), f32),
        'norm_mix': 1.0 + 0.05 * nrm(ks[1], (DEPTH, D_MODEL), f32),
        'norm_ffn': 1.0 + 0.05 * nrm(ks[2], (DEPTH, D_MODEL), f32),
        'norm_final': 1.0 + 0.05 * nrm(ks[3], (D_MODEL,), f32),
        'w_in_ab': nrm(ks[4], (N_EVEN, D_MODEL, IN_AB), f32) * D_MODEL ** -0.5,
        'a_v_norm': 1.0 + 0.05 * nrm(ks[5], (N_EVEN, A_WIDTH), f32),
        'a_spatial_w': nrm(ks[6], (N_EVEN, A_GROUPS, CHUNK, CHUNK), f32) * CHUNK ** -0.5,
        'a_spatial_b': 1.0 + 0.05 * nrm(ks[7], (N_EVEN, A_GROUPS, CHUNK), f32),
        'b_rpb': 0.1 * nrm(ks[8], (N_EVEN, B_HEADS, 2 * NA_ROWS - 1, 2 * NA_COLS - 1), f32),
        'w_out_ab': nrm(ks[9], (N_EVEN, MIX_WIDTH, D_MODEL), f32) * MIX_WIDTH ** -0.5,
        'w_in_cd': nrm(ks[10], (N_ODD, D_MODEL, IN_CD), f32) * D_MODEL ** -0.5,
        'c_conv': nrm(ks[11], (N_ODD, CONV_W, C_WIDTH), f32) * CONV_W ** -0.5,
        'w_out_cd': nrm(ks[12], (N_ODD, MIX_WIDTH, D_MODEL), f32) * MIX_WIDTH ** -0.5,
        'router': nrm(ks[13], (DEPTH, D_MODEL, N_EXPERTS), f32) * D_MODEL ** -0.5,
        'w_gate': nrm(ks[14], (DEPTH, N_EXPERTS, D_MODEL, D_EXPERT), f32) * D_MODEL ** -0.5,
        'w_up': nrm(ks[15], (DEPTH, N_EXPERTS, D_MODEL, D_EXPERT), f32) * D_MODEL ** -0.5,
        'w_down': nrm(ks[16], (DEPTH, N_EXPERTS, D_EXPERT, D_MODEL), f32) * D_EXPERT ** -0.5,
    }


def reference(x, norm_mix, norm_ffn, norm_final, w_in_ab, a_v_norm, a_spatial_w, a_spatial_b,
              b_rpb, w_out_ab, w_in_cd, c_conv, w_out_cd, router, w_gate, w_up, w_down):
    bsz, seq, _ = x.shape
    for layer in range(DEPTH):
        h = rms_norm(x, norm_mix[layer])
        i = layer // 2
        if layer % 2 == 0:
            p = h @ w_in_ab[i]
            a_u = p[..., :A_WIDTH]
            a_v = p[..., A_WIDTH:2 * A_WIDTH]
            o = 2 * A_WIDTH
            b_q = p[..., o:o + B_WIDTH].reshape(bsz, seq, B_HEADS, HEAD_DIM)
            b_k = p[..., o + B_WIDTH:o + 2 * B_WIDTH].reshape(bsz, seq, B_HEADS, HEAD_DIM)
            b_v = p[..., o + 2 * B_WIDTH:o + 3 * B_WIDTH].reshape(bsz, seq, B_HEADS, HEAD_DIM)
            y_a = spatial_gating_unit(a_u, a_v, a_v_norm[i], a_spatial_w[i], a_spatial_b[i])
            y_b = neighbourhood_attention(b_q, b_k, b_v, b_rpb[i])
            x = x + jnp.concatenate([y_a, y_b], axis=-1) @ w_out_ab[i]
        else:
            p = h @ w_in_cd[i]
            c_b = p[..., :C_WIDTH]
            c_c = p[..., C_WIDTH:2 * C_WIDTH]
            c_x = p[..., 2 * C_WIDTH:3 * C_WIDTH]
            o = 3 * C_WIDTH
            d_q = p[..., o:o + D_WIDTH].reshape(bsz, seq, D_HEADS, HEAD_DIM)
            d_k = p[..., o + D_WIDTH:o + 2 * D_WIDTH].reshape(bsz, seq, D_HEADS, HEAD_DIM)
            d_v = p[..., o + 2 * D_WIDTH:o + 3 * D_WIDTH].reshape(bsz, seq, D_HEADS, HEAD_DIM)
            y_c = gated_short_conv(c_b, c_c, c_x, c_conv[i])
            y_d = dilated_attention(d_q, d_k, d_v)
            x = x + jnp.concatenate([y_c, y_d], axis=-1) @ w_out_cd[i]
        x = x + expert_choice_moe(rms_norm(x, norm_ffn[layer]), router[layer], w_gate[layer], w_up[layer], w_down[layer])
    return rms_norm(x, norm_final)
```

```cpp
#include <hip/hip_runtime.h>
#include <cstdio>
#include <cstdint>
#ifndef MK_N_LAUNCHES
#define MK_N_LAUNCHES 1
#endif
#ifndef MK_REPEAT
#define MK_REPEAT (-1)
#endif
#ifndef MK_DIL_REPS
#define MK_DIL_REPS 1
#endif
#ifndef MK_CONV_PROBE
#define MK_CONV_PROBE 0
#endif
#ifndef MK_SP2
#define MK_SP2 true
#endif
#ifndef MK_ALIGN
#define MK_ALIGN true
#endif
#ifndef MK_PROBE_PHASE
#define MK_PROBE_PHASE (-1)
#endif
#ifndef MK_PROBE_NOSTORE
#define MK_PROBE_NOSTORE 0
#endif
#ifndef MK_CONV_SKEW
#define MK_CONV_SKEW 0
#endif
#ifndef MK_CVF1
#define MK_CVF1 52
#endif
#ifndef MK_CVF3
#define MK_CVF3 54
#endif
namespace pg8 {
#define PG8_LAS __attribute__((address_space(3)))
typedef unsigned short bf16_t;
typedef short bf16x8 __attribute__((ext_vector_type(8)));
typedef float f32x4 __attribute__((ext_vector_type(4)));
typedef int i32x8 __attribute__((ext_vector_type(8)));
typedef short bf16x16 __attribute__((ext_vector_type(16)));
typedef unsigned u32x4 __attribute__((ext_vector_type(4)));
constexpr int BM = 256, BK = 64, HALF = 128, HTB = HALF * BK * 2  , STAGE_BYTES = 8 * HTB, NXCD = 8, WGM = 8;

__host__ __device__ __forceinline__ int lds_byte(int r, int c) { const int st = (r >> 4) * 2 + (c >> 5), rr = r & 15, cc = c & 31, ob = rr * 64 + cc * 2; return st * 1024 + (ob ^ (((ob >> 9) & 1) << 5)); }
__host__ __device__ __forceinline__ void stage_rc(int b, int& R, int& C) { const int st = b / 1024, sb = b % 1024, swz = sb ^ (((sb >> 9) & 1) << 5); R = (st >> 1) * 16 + swz / 64; C = (st & 1) * 32 + (swz % 64) / 2; }
__host__ __device__ __forceinline__ int perm32(int rho) { const int n = rho >> 4, i = rho & 15; return 8 * (i >> 2) + 4 * n + (i & 3); }


struct Unit { int pm, pn, pb; };
struct Gemm { const bf16_t* A; const bf16_t* Bt; int M, N, K; };

struct Order {
    int nM, nN, nwg, G, c, moe; const PG8_LAS int* tab;
    __host__ __device__ __forceinline__ void init(int M, int N, int G_, int c_, int moe_) { nM = M / BM; nN = N / BM; nwg = nM * nN; G = G_; c = c_; moe = moe_; tab = nullptr; }
    __host__ __device__ __forceinline__ bool next(int i, Unit& u) const {
        const long L = (long)i * G + c; if (L >= nwg) return false;
        int wgid = (int)L; { const int q = nwg / NXCD, r = nwg % NXCD, xcd = wgid % NXCD, off = wgid / NXCD; wgid = (xcd < r ? xcd * (q + 1) : r * (q + 1) + (xcd - r) * q) + off; }
        const int nig = WGM * nN, gid = wgid / nig, fm = gid * WGM, gsz = (nM - fm) < WGM ? (nM - fm) : WGM;
        u.pm = fm + ((wgid % nig) % gsz); u.pn = (wgid % nig) / gsz; u.pb = moe ? (u.pm >> 3) * nN + u.pn : u.pn; return true;
    }
    __device__ __forceinline__ void a_ready(const Unit&) const {}
    __device__ __forceinline__ void done(const Unit&) const {}
};

typedef float f32x2_t __attribute__((ext_vector_type(2))); typedef __bf16 bf16x2_t __attribute__((ext_vector_type(2)));
__device__ __forceinline__ unsigned cvt_pk_bf16(float lo, float hi) { f32x2_t v = {lo, hi}; bf16x2_t b = __builtin_convertvector(v, bf16x2_t); return __builtin_bit_cast(unsigned, b); }
__device__ __forceinline__ float gelu_tanh(float x) {
    const float t = x * (1.5957691216057308f + 0.07135481282636639f * x * x);
    return x * __builtin_amdgcn_rcpf(1.0f + __builtin_amdgcn_exp2f(-1.4426950408889634f * t));
}
__device__ __forceinline__ float silu_f(float x) { return x * __builtin_amdgcn_rcpf(1.0f + __builtin_amdgcn_exp2f(-1.4426950408889634f * x)); }

#if MK_PROBE_NOSTORE
#define PG8_ST(x) do { if (nost != 1) { x; } } while (0)
#else
#define PG8_ST(x) do { x; } while (0)
#endif
struct EpiBf16 {
    static constexpr bool PERM = true, AFTER_DRAIN = false;
    bf16_t* O; int ldc; int gelu_tiles; int qkv_tile0; bf16_t* QKV; size_t qkv_stride; float sc; int nost;
    __device__ __forceinline__ void operator()(const f32x4 (&acc)[2][2][4][2], const Unit& u, int wr, int wc, int fr, int fq) const {
        const int row0 = u.pm * BM + wr * 64 + fr, col0 = u.pn * BM + wc * 32 + 8 * fq; const bool act = u.pn < gelu_tiles, hm = u.pn >= qkv_tile0;
        const int t = u.pn - qkv_tile0, which = t >> 2, hp = t & 3;
#pragma unroll
        for (int ai = 0; ai < 2; ++ai)
#pragma unroll
            for (int m = 0; m < 4; ++m) { const int row = row0 + ai * HALF + m * 16;
                bf16_t* rowp = O + (size_t)row * ldc + col0; size_t bjstep = HALF;
                if (hm) { rowp = QKV + (size_t)which * qkv_stride + ((size_t)((row >> 11) * 8 + 2 * hp) * 2048 + (row & 2047)) * 128 + wc * 32 + 8 * fq; bjstep = (size_t)2048 * 128; }
#pragma unroll
                for (int bj = 0; bj < 2; ++bj) { f32x4 v0 = acc[ai][bj][m][0] * sc, v1 = acc[ai][bj][m][1] * sc;
                    if (act) {
#pragma unroll
                        for (int j = 0; j < 4; ++j) { v0[j] = gelu_tanh(v0[j]); v1[j] = gelu_tanh(v1[j]); } }
                    u32x4 w; w.x = cvt_pk_bf16(v0[0], v0[1]); w.y = cvt_pk_bf16(v0[2], v0[3]); w.z = cvt_pk_bf16(v1[0], v1[1]); w.w = cvt_pk_bf16(v1[2], v1[3]);
                    PG8_ST(*(u32x4*)(rowp + bj * bjstep) = w); } }
    }
};
struct EpiResid {
    static constexpr bool PERM = false, AFTER_DRAIN = false;
    const float* base; float* out; int ldc;
    __device__ __forceinline__ void operator()(const f32x4 (&acc)[2][2][4][2], const Unit& u, int wr, int wc, int fr, int fq) const {
        const int row0 = u.pm * BM + wr * 64 + fr, col0 = u.pn * BM + wc * 32 + 4 * fq;
#pragma unroll
        for (int ai = 0; ai < 2; ++ai)
#pragma unroll
            for (int m = 0; m < 4; ++m) { const size_t off = (size_t)(row0 + ai * HALF + m * 16) * ldc + col0;
                f32x4 bs[2][2];
#pragma unroll
                for (int bj = 0; bj < 2; ++bj)
#pragma unroll
                    for (int n = 0; n < 2; ++n) bs[bj][n] = *(const f32x4*)(base + off + bj * HALF + n * 16);
#pragma unroll
                for (int bj = 0; bj < 2; ++bj)
#pragma unroll
                    for (int n = 0; n < 2; ++n) *(f32x4*)(out + off + bj * HALF + n * 16) = bs[bj][n] + acc[ai][bj][m][n];
                asm volatile("" ::: "memory"); }
    }
};
struct EpiResidB {
    static constexpr bool PERM = true, AFTER_DRAIN = false;
    const void* base; bf16_t* out; int ldc; int base_f32; int nost = 0;
    __device__ __forceinline__ void operator()(const f32x4 (&acc)[2][2][4][2], const Unit& u, int wr, int wc, int fr, int fq) const {
        const int row0 = u.pm * BM + wr * 64 + fr, col0 = u.pn * BM + wc * 32 + 8 * fq;
#pragma unroll
        for (int ai = 0; ai < 2; ++ai)
#pragma unroll
            for (int m = 0; m < 4; ++m) { const size_t off = (size_t)(row0 + ai * HALF + m * 16) * ldc + col0;
                f32x4 b0[2], b1[2];
                if (base_f32) {
#pragma unroll
                    for (int bj = 0; bj < 2; ++bj) { b0[bj] = *(const f32x4*)((const float*)base + off + bj * HALF); b1[bj] = *(const f32x4*)((const float*)base + off + bj * HALF + 4); }
                } else {
#pragma unroll
                    for (int bj = 0; bj < 2; ++bj) { const u32x4 w = *(const u32x4*)((const bf16_t*)base + off + bj * HALF);
                        b0[bj] = (f32x4){__uint_as_float(w.x << 16), __uint_as_float(w.x & 0xffff0000u), __uint_as_float(w.y << 16), __uint_as_float(w.y & 0xffff0000u)};
                        b1[bj] = (f32x4){__uint_as_float(w.z << 16), __uint_as_float(w.z & 0xffff0000u), __uint_as_float(w.w << 16), __uint_as_float(w.w & 0xffff0000u)}; }
                }
#pragma unroll
                for (int bj = 0; bj < 2; ++bj) { const f32x4 v0 = b0[bj] + acc[ai][bj][m][0], v1 = b1[bj] + acc[ai][bj][m][1];
                    u32x4 w; w.x = cvt_pk_bf16(v0[0], v0[1]); w.y = cvt_pk_bf16(v0[2], v0[3]); w.z = cvt_pk_bf16(v1[0], v1[1]); w.w = cvt_pk_bf16(v1[2], v1[3]);
                    *(u32x4*)(out + off + bj * HALF) = w; }
                asm volatile("" ::: "memory"); }
    }
};
struct EpiSwiglu {
    static constexpr bool PERM = true, AFTER_DRAIN = false;
    unsigned char* O; int ldc; float sc; int nost;
    __device__ __forceinline__ void operator()(const f32x4 (&acc)[2][2][4][2], const Unit& u, int wr, int wc, int fr, int fq) const {
        const int row0 = u.pm * BM + wr * 64 + fr, col0 = u.pn * HALF + wc * 32 + 8 * fq;
#pragma unroll
        for (int ai = 0; ai < 2; ++ai)
#pragma unroll
            for (int m = 0; m < 4; ++m) { unsigned char* rowp = O + (size_t)(row0 + ai * HALF + m * 16) * ldc + col0;
                f32x4 h0, h1;
#pragma unroll
                for (int j = 0; j < 4; ++j) { h0[j] = __builtin_amdgcn_fmed3f(silu_f(acc[ai][0][m][0][j] * sc) * (acc[ai][1][m][0][j] * sc), -448.f, 448.f); h1[j] = __builtin_amdgcn_fmed3f(silu_f(acc[ai][0][m][1][j] * sc) * (acc[ai][1][m][1][j] * sc), -448.f, 448.f); }
                int p0 = 0, p1 = 0;
                p0 = __builtin_amdgcn_cvt_pk_fp8_f32(h0[0], h0[1], p0, false); p0 = __builtin_amdgcn_cvt_pk_fp8_f32(h0[2], h0[3], p0, true);
                p1 = __builtin_amdgcn_cvt_pk_fp8_f32(h1[0], h1[1], p1, false); p1 = __builtin_amdgcn_cvt_pk_fp8_f32(h1[2], h1[3], p1, true);
                typedef unsigned u32x2v __attribute__((ext_vector_type(2))); u32x2v w; w.x = (unsigned)p0; w.y = (unsigned)p1;
                PG8_ST(*(u32x2v*)rowp = w); }
    }
};
struct EpiDown {
    static constexpr bool PERM = true, AFTER_DRAIN = false;
    unsigned char* O; int ldc; const float* gate; float sc; int nost;
    __device__ __forceinline__ void operator()(const f32x4 (&acc)[2][2][4][2], const Unit& u, int wr, int wc, int fr, int fq) const {
        const int row0 = u.pm * BM + wr * 64 + fr, col0 = u.pn * BM + wc * 32 + 8 * fq;
#pragma unroll
        for (int ai = 0; ai < 2; ++ai)
#pragma unroll
            for (int m = 0; m < 4; ++m) { const int row = row0 + ai * HALF + m * 16; const float gt = gate[row] * sc; unsigned char* rowp = O + (size_t)row * ldc + col0;
#pragma unroll
                for (int bj = 0; bj < 2; ++bj) { f32x4 v0 = acc[ai][bj][m][0] * gt, v1 = acc[ai][bj][m][1] * gt;
#pragma unroll
                    for (int j = 0; j < 4; ++j) { v0[j] = __builtin_amdgcn_fmed3f(v0[j], -448.f, 448.f); v1[j] = __builtin_amdgcn_fmed3f(v1[j], -448.f, 448.f); }
                    int p0 = 0, p1 = 0;
                    p0 = __builtin_amdgcn_cvt_pk_fp8_f32(v0[0], v0[1], p0, false); p0 = __builtin_amdgcn_cvt_pk_fp8_f32(v0[2], v0[3], p0, true);
                    p1 = __builtin_amdgcn_cvt_pk_fp8_f32(v1[0], v1[1], p1, false); p1 = __builtin_amdgcn_cvt_pk_fp8_f32(v1[2], v1[3], p1, true);
                    typedef unsigned u32x2v __attribute__((ext_vector_type(2))); u32x2v w; w.x = (unsigned)p0; w.y = (unsigned)p1;
                    PG8_ST(*(u32x2v*)(rowp + bj * HALF) = w); }
                asm volatile("" ::: "memory"); }
    }
};

template <class Epi, class Sched, bool ALIGN_EPI = false, bool SP2 = false, bool GATHER = false, bool FP8 = false, int PV = 0>
__device__ __forceinline__ void gemm_phase(PG8_LAS unsigned char* lds, const Gemm g, const Sched& S, const Epi& E, int tid_) {
    asm volatile("" : "+v"(tid_));
    const int tid = tid_, wid = __builtin_amdgcn_readfirstlane(tid >> 6), lane = tid & 63, wr = wid >> 2, wc = wid & 3, fr = lane & 15, fq = lane >> 4;
    constexpr int ES = FP8 ? 1 : 2;
#if MK_PROBE_NOSTORE
    const int K = g.K, nt = (K * ES / (BK * 2)) >> (E.nost == 3 ? 1 : 0);
#else
    const int K = g.K, nt = K * ES / (BK * 2);
#endif
    unsigned voffA[2], voffB[2];
#pragma unroll
    for (int i = 0; i < 2; ++i) { int R, C; stage_rc(tid * 16 + i * 8192, R, C); const int Rb = Epi::PERM ? ((R & ~31) + perm32(R & 31)) : R;
        voffA[i] = (unsigned)(R * K * ES + C * 2); voffB[i] = (unsigned)(Rb * K * ES + C * 2); }
    static_assert(!GATHER || SP2, "the gathered A operand is wired into the SP2 loop only");
    unsigned gofA[2][2] = {{0u, 0u}, {0u, 0u}};
#define PG8_GOFF(dst, ord) do { _Pragma("unroll") for (int _h = 0; _h < 2; ++_h) _Pragma("unroll") for (int _i = 0; _i < 2; ++_i) { int _R, _C; stage_rc(tid * 16 + _i * 8192, _R, _C); \
        dst[_h][_i] = (unsigned)(S.tab[(ord) * 256 + _h * 128 + _R] * K * ES + _C * 2); } } while (0)
#define PG8_STAGE_A(bufoff, gbase, h) do { if constexpr (GATHER) PG8_STAGE(bufoff, gbase, gofA[h]); else PG8_STAGE(bufoff, (gbase) + (h) * hstep, voffA); } while (0)
    const size_t kstep = (size_t)(BK * 2);
    const size_t hstep = (size_t)HALF * K * ES;
    const size_t tstep = 2 * hstep;
    const unsigned ldsw = (unsigned)wid * 1024u;
    const int aoff = lds_byte(wr * 64 + fr, fq * 8), boff = lds_byte(wc * 32 + fr, fq * 8);
#define PG8_SA(b, h) (((b) * 2 + (h)) * HTB)
#define PG8_SB(b, h) ((4 + (b) * 2 + (h)) * HTB)
#if MK_PROBE_NOSTORE
#define PG8_PV(v) (PV != (v))
#else
#define PG8_PV(v) true
#endif
#define PG8_STAGE(bufoff, gbase, voff) do { if constexpr (PG8_PV(4)) _Pragma("unroll") for (int _i = 0; _i < 2; ++_i) \
        __builtin_amdgcn_global_load_lds((const unsigned*)((const char*)(gbase) + (voff)[_i]), (PG8_LAS unsigned*)(lds + (bufoff) + ldsw + _i * 8192), 16, 0, 0); } while (0)
#define PG8_LDA(dst, b, h) do { if constexpr (PG8_PV(5)) _Pragma("unroll") for (int m = 0; m < 4; ++m) _Pragma("unroll") for (int k = 0; k < 2; ++k) dst[m][k] = *(const PG8_LAS bf16x8*)(lds + PG8_SA(b, h) + aoff + m * 2048 + k * 1024); } while (0)
#define PG8_LDB(dst, b, h) do { if constexpr (PG8_PV(5)) _Pragma("unroll") for (int n = 0; n < 2; ++n) _Pragma("unroll") for (int k = 0; k < 2; ++k) dst[n][k] = *(const PG8_LAS bf16x8*)(lds + PG8_SB(b, h) + boff + n * 2048 + k * 1024); } while (0)
#define PG8_MMA(ai, bj, At, Bt) do { __builtin_amdgcn_s_setprio(1); if constexpr (PV == 6) { _Pragma("unroll") for (int ks = 0; ks < 2; ++ks) _Pragma("unroll") for (int mp = 0; mp < 2; ++mp) { \
            const i32x8 _a = __builtin_bit_cast(i32x8, __builtin_shufflevector(Bt[ks][0], Bt[ks][1], 0, 1, 2, 3, 4, 5, 6, 7, 8, 9, 10, 11, 12, 13, 14, 15)); \
            const i32x8 _b = __builtin_bit_cast(i32x8, __builtin_shufflevector(At[2 * mp + ks][0], At[2 * mp + ks][1], 0, 1, 2, 3, 4, 5, 6, 7, 8, 9, 10, 11, 12, 13, 14, 15)); \
            acc16[ai][bj][mp] = __builtin_amdgcn_mfma_scale_f32_32x32x64_f8f6f4(_a, _b, acc16[ai][bj][mp], 0, 0, 0, 0x7f7f7f7f, 0, 0x7f7f7f7f); } } \
        else if constexpr (FP8) { _Pragma("unroll") for (int m = 0; m < 4; ++m) _Pragma("unroll") for (int n = 0; n < 2; ++n) { \
            const i32x8 _a = __builtin_bit_cast(i32x8, __builtin_shufflevector(Bt[n][0], Bt[n][1], 0, 1, 2, 3, 4, 5, 6, 7, 8, 9, 10, 11, 12, 13, 14, 15)); \
            const i32x8 _b = __builtin_bit_cast(i32x8, __builtin_shufflevector(At[m][0], At[m][1], 0, 1, 2, 3, 4, 5, 6, 7, 8, 9, 10, 11, 12, 13, 14, 15)); \
            acc[ai][bj][m][n] = __builtin_amdgcn_mfma_scale_f32_16x16x128_f8f6f4(_a, _b, acc[ai][bj][m][n], 0, 0, 0, 0x7f7f7f7f, 0, 0x7f7f7f7f); } } \
        else { _Pragma("unroll") for (int m = 0; m < 4; ++m) _Pragma("unroll") for (int n = 0; n < 2; ++n) _Pragma("unroll") for (int k = 0; k < 2; ++k) \
        acc[ai][bj][m][n] = __builtin_amdgcn_mfma_f32_16x16x32_bf16(Bt[n][k], At[m][k], acc[ai][bj][m][n], 0, 0, 0); } __builtin_amdgcn_s_setprio(0); } while (0)
#define PG8_WAIT_V(n) asm volatile("s_waitcnt vmcnt(" #n ")" ::: "memory")
#define PG8_WAIT_L(n) asm volatile("s_waitcnt lgkmcnt(" #n ")" ::: "memory")
#define PG8_BAR __builtin_amdgcn_s_barrier()
#define PG8_SCHED __builtin_amdgcn_sched_barrier(0)
    Unit cur, nxt; int ui = 0;
    if (!S.next(0, cur)) return;
    f32x4 acc[2][2][4][2];
#pragma unroll
    for (int a = 0; a < 2; ++a)
#pragma unroll
        for (int b = 0; b < 2; ++b)
#pragma unroll
            for (int m = 0; m < 4; ++m)
#pragma unroll
                for (int n = 0; n < 2; ++n) acc[a][b][m][n] = (f32x4){0.f, 0.f, 0.f, 0.f};
    bf16x8 At[4][2], B0[2][2], B1[2][2];
    typedef float f32x16_t __attribute__((ext_vector_type(16)));
    f32x16_t acc16[2][2][2];
    if constexpr (PV == 6) {
#pragma unroll
        for (int a = 0; a < 2; ++a)
#pragma unroll
            for (int b = 0; b < 2; ++b)
#pragma unroll
                for (int m = 0; m < 2; ++m)
#pragma unroll
                    for (int j = 0; j < 16; ++j) acc16[a][b][m][j] = 0.f; }
    const char* cA = (const char*)g.A + (GATHER ? (size_t)0 : (size_t)cur.pm * tstep); const char* cB = (const char*)g.Bt + (size_t)cur.pb * tstep;
    S.a_ready(cur);
    if constexpr (GATHER) PG8_GOFF(gofA, 0);
    if constexpr (SP2) {
        PG8_STAGE(PG8_SB(0, 0), cB, voffB); PG8_STAGE(PG8_SB(0, 1), cB + hstep, voffB); PG8_STAGE_A(PG8_SA(0, 0), cA, 0); PG8_STAGE_A(PG8_SA(0, 1), cA, 1);
        if (wr == 1) PG8_BAR;
        PG8_WAIT_V(2); PG8_BAR;
        PG8_STAGE(PG8_SB(1, 0), cB + kstep, voffB); PG8_STAGE_A(PG8_SA(1, 0), cA + kstep, 0); PG8_STAGE(PG8_SB(1, 1), cB + hstep + kstep, voffB);
        PG8_WAIT_V(6); PG8_BAR;
    } else {
        PG8_STAGE(PG8_SB(0, 0), cB, voffB); PG8_STAGE(PG8_SA(0, 0), cA, voffA); PG8_STAGE(PG8_SB(0, 1), cB + hstep, voffB); PG8_STAGE(PG8_SA(0, 1), cA + hstep, voffA);
        if (wr == 1) PG8_BAR;
        PG8_WAIT_V(4); PG8_BAR;
        PG8_STAGE(PG8_SB(1, 0), cB + kstep, voffB); PG8_STAGE(PG8_SA(1, 0), cA + kstep, voffA); PG8_STAGE(PG8_SB(1, 1), cB + hstep + kstep, voffB);
        PG8_WAIT_V(6); PG8_BAR;
    }
    for (;;) {
        const bool has_next = S.next(ui + 1, nxt);
        const char* nA = (has_next && !GATHER) ? (const char*)g.A + (size_t)nxt.pm * tstep : cA; const char* nB = has_next ? (const char*)g.Bt + (size_t)nxt.pb * tstep : cB;
        for (int t = 0; t < nt; t += 2) {
            const bool last = (t == nt - 2);
            const char* a1 = cA + (size_t)(t + 1) * kstep;
            const char* a2 = last ? nA : cA + (size_t)(t + 2) * kstep; const char* b2 = last ? nB : cB + (size_t)(t + 2) * kstep;
            const char* a3 = a2 + kstep; const char* b3 = b2 + kstep;
            if (last && has_next) S.a_ready(nxt);
            if constexpr (SP2) {
            PG8_LDB(B0, 0, 0); PG8_LDB(B1, 0, 1); PG8_SCHED; PG8_LDA(At, 0, 0); PG8_STAGE_A(PG8_SA(1, 1), a1, 1);
            if constexpr (GATHER) { if (last && has_next) PG8_GOFF(gofA, ui + 1); }
            PG8_WAIT_V(8); PG8_WAIT_L(0); PG8_BAR; PG8_MMA(0, 0, At, B0); PG8_MMA(0, 1, At, B1); PG8_BAR; PG8_SCHED;
            PG8_LDA(At, 0, 1); PG8_STAGE(PG8_SB(0, 0), b2, voffB); PG8_STAGE(PG8_SB(0, 1), b2 + hstep, voffB); PG8_STAGE_A(PG8_SA(0, 0), a2, 0);
            PG8_WAIT_V(8); PG8_WAIT_L(0); PG8_BAR; PG8_MMA(1, 0, At, B0); PG8_MMA(1, 1, At, B1); PG8_BAR; PG8_SCHED;
            PG8_LDB(B0, 1, 0); PG8_LDB(B1, 1, 1); PG8_SCHED; PG8_LDA(At, 1, 0); PG8_STAGE_A(PG8_SA(0, 1), a2, 1);
            PG8_WAIT_V(8); PG8_WAIT_L(0); PG8_BAR; PG8_MMA(0, 0, At, B0); PG8_MMA(0, 1, At, B1); PG8_BAR; PG8_SCHED;
            PG8_LDA(At, 1, 1); PG8_STAGE(PG8_SB(1, 0), b3, voffB); PG8_STAGE(PG8_SB(1, 1), b3 + hstep, voffB); PG8_STAGE_A(PG8_SA(1, 0), a3, 0);
            PG8_WAIT_V(8); PG8_WAIT_L(0); PG8_BAR; PG8_MMA(1, 0, At, B0); PG8_MMA(1, 1, At, B1); PG8_BAR; PG8_SCHED;
            } else {
            PG8_LDB(B0, 0, 0); PG8_SCHED; PG8_LDA(At, 0, 0); PG8_STAGE(PG8_SA(1, 1), a1 + hstep, voffA);
            PG8_WAIT_L(8); PG8_BAR; PG8_WAIT_L(0); PG8_MMA(0, 0, At, B0); PG8_BAR; PG8_SCHED;
            PG8_LDB(B1, 0, 1); PG8_STAGE(PG8_SB(0, 0), b2, voffB);
            PG8_BAR; PG8_WAIT_L(0); PG8_MMA(0, 1, At, B1); PG8_BAR;
            PG8_LDA(At, 0, 1); PG8_STAGE(PG8_SA(0, 0), a2, voffA);
            PG8_BAR; PG8_WAIT_L(0); PG8_MMA(1, 0, At, B0); PG8_BAR; PG8_SCHED;
            PG8_STAGE(PG8_SB(0, 1), b2 + hstep, voffB);
            PG8_WAIT_V(6); PG8_BAR; PG8_MMA(1, 1, At, B1); PG8_BAR;
            PG8_LDB(B0, 1, 0); PG8_SCHED; PG8_LDA(At, 1, 0); PG8_STAGE(PG8_SA(0, 1), a2 + hstep, voffA);
            PG8_WAIT_L(8); PG8_BAR; PG8_WAIT_L(0); PG8_MMA(0, 0, At, B0); PG8_BAR; PG8_SCHED;
            PG8_LDB(B1, 1, 1); PG8_STAGE(PG8_SB(1, 0), b3, voffB);
            PG8_BAR; PG8_WAIT_L(0); PG8_MMA(0, 1, At, B1); PG8_BAR;
            PG8_LDA(At, 1, 1); PG8_STAGE(PG8_SA(1, 0), a3, voffA);
            PG8_BAR; PG8_WAIT_L(0); PG8_MMA(1, 0, At, B0); PG8_BAR; PG8_SCHED;
            PG8_STAGE(PG8_SB(1, 1), b3 + hstep, voffB);
            PG8_WAIT_V(6); PG8_BAR; PG8_MMA(1, 1, At, B1); PG8_BAR;
            }
        }
        if constexpr (ALIGN_EPI) { if (wr == 0) PG8_BAR; }
        if constexpr (PV == 6) {
#pragma unroll
            for (int a = 0; a < 2; ++a)
#pragma unroll
                for (int b = 0; b < 2; ++b)
#pragma unroll
                    for (int m = 0; m < 2; ++m) asm volatile("" :: "v"(acc16[a][b][m])); }
        else
#if MK_PROBE_NOSTORE
        if (E.nost != 2)
#endif
        if constexpr (!Epi::AFTER_DRAIN) { E(acc, cur, wr, wc, fr, fq); S.done(cur); }
        if (!has_next) break;
#pragma unroll
        for (int a = 0; a < 2; ++a)
#pragma unroll
            for (int b = 0; b < 2; ++b)
#pragma unroll
                for (int m = 0; m < 4; ++m)
#pragma unroll
                    for (int n = 0; n < 2; ++n) acc[a][b][m][n] = (f32x4){0.f, 0.f, 0.f, 0.f};
        cur = nxt; cA = nA; cB = nB; ++ui;
        if constexpr (ALIGN_EPI) { if (wr == 1) PG8_BAR; }
    }
    PG8_WAIT_V(0);
    if constexpr (!ALIGN_EPI) { if (wr == 0) PG8_BAR; }
    PG8_BAR;
    if constexpr (Epi::AFTER_DRAIN) { E.fused(acc, cur, wr, wc, fr, fq, lds, wid, lane); S.done(cur); }
#undef PG8_SA
#undef PG8_GOFF
#undef PG8_STAGE_A
#undef PG8_SB
#undef PG8_STAGE
#undef PG8_LDA
#undef PG8_LDB
#undef PG8_MMA
#undef PG8_WAIT_V
#undef PG8_WAIT_L
#undef PG8_BAR
#undef PG8_SCHED
}
}

#ifndef PG8_SP2
#define PG8_SP2 true
#endif
#ifndef PG8_ALIGN
#define PG8_ALIGN true
#endif

constexpr int BATCH = 8, SEQ = 2048, DM = 2048, M = BATCH * SEQ;
constexpr int NE = 16, CAP = 256, DE = 2048, MOE_ROWS = BATCH * NE * CAP;
constexpr int IN_AB = 5120, IN_CD = 6144;
constexpr float RMS_EPS = 1e-6f, LN_EPS = 1e-5f;
constexpr float LOG2E = 1.4426950408889634f, LN2 = 0.6931471805599453f;
constexpr float ATT_SCALE = 0.08838834764831845f;
constexpr int NWAVES = 8, NTHR = 512;

constexpr size_t MiB = 1ull << 20;
constexpr size_t WS_CTL = 0, CTL_ZERO_BYTES = 1 * MiB;
constexpr size_t WS_AFF = 1 * MiB;
constexpr size_t WS_SEL = 2 * MiB;
constexpr size_t WS_GATE = 3 * MiB;
constexpr size_t WS_IDX = 3 * MiB + 512 * 1024;
constexpr size_t WS_LSE = 4 * MiB;
constexpr size_t WS_WIN0 = 8 * MiB, WS_WOUT0 = 28 * MiB, WS_WIN1 = 36 * MiB, WS_WOUT1 = 60 * MiB;
constexpr size_t WS_WGU = 68 * MiB;
constexpr size_t WS_WDN = 580 * MiB;
constexpr size_t WS_XRES = 836 * MiB;
constexpr size_t WS_H = 964 * MiB;
constexpr size_t WS_P = 1028 * MiB;
constexpr size_t WS_YCAT = 1220 * MiB;
constexpr size_t WS_OP = 1764 * MiB;
constexpr size_t OP_STRIDE = (size_t)16384 * 1024 + 4096 + 512;
constexpr size_t QKV_STRIDE = (size_t)64 * 2048 * 128 + 4096 + 512;
constexpr size_t WS_XE = 1380 * MiB;
constexpr size_t WS_QKV = WS_XE;
constexpr size_t WS_HID = 1508 * MiB;
constexpr size_t WS_YE = 1636 * MiB;
constexpr size_t WS_WIN8 = 1896 * MiB;
constexpr size_t WS_H8 = 1864 * MiB;
constexpr size_t WS_END = 1908 * MiB;
constexpr float YE_SCALE = 64.0f;
constexpr float W8_SCALE = 64.0f;

constexpr int RING_BYTES = 131072;
constexpr int LDSCTL_OFF = 147328, MISC_OFF = LDSCTL_OFF;
constexpr int LDS_BYTES = 147456;

#define GAS __attribute__((address_space(1)))
#define LAS __attribute__((address_space(3)))
typedef unsigned short bf16;
typedef unsigned u32x4 __attribute__((ext_vector_type(4)));
typedef unsigned u32x2 __attribute__((ext_vector_type(2)));
typedef float f32x4 __attribute__((ext_vector_type(4)));
typedef short bf16x8 __attribute__((ext_vector_type(8)));
typedef short s16x4 __attribute__((ext_vector_type(4)));
typedef GAS unsigned gu32;
#define RLX_AGENT __ATOMIC_RELAXED, __HIP_MEMORY_SCOPE_AGENT
#define LDS_WAIT() asm volatile("s_waitcnt lgkmcnt(0)" ::: "memory")
#define VM_WAIT() asm volatile("s_waitcnt vmcnt(0)" ::: "memory")
using pg8::cvt_pk_bf16;
__device__ __forceinline__ float bf_lo(unsigned w) { return __uint_as_float(w << 16); }
__device__ __forceinline__ float bf_hi(unsigned w) { return __uint_as_float(w & 0xffff0000u); }
__device__ __forceinline__ int lane_now() { int l; asm volatile("v_mbcnt_lo_u32_b32 %0, -1, 0\n\tv_mbcnt_hi_u32_b32 %0, -1, %0" : "=v"(l)); return l; }
__device__ __forceinline__ int shx(int v, int o, int lane) { return __builtin_amdgcn_ds_bpermute((lane ^ o) << 2, v); }
__device__ __forceinline__ unsigned shx(unsigned v, int o, int lane) { return (unsigned)__builtin_amdgcn_ds_bpermute((lane ^ o) << 2, (int)v); }
__device__ __forceinline__ float shx(float v, int o, int lane) { return __int_as_float(__builtin_amdgcn_ds_bpermute((lane ^ o) << 2, __float_as_int(v))); }
__device__ __forceinline__ unsigned shup(unsigned v, int o, int lane) { return (unsigned)__builtin_amdgcn_ds_bpermute((lane - o) << 2, (int)v); }
__device__ __forceinline__ float wave_sum(float v, int lane) {
#pragma unroll
    for (int o = 1; o < 64; o <<= 1) v += shx(v, o, lane);
    return v;
}
__device__ __forceinline__ s16x4 vtr(const LAS unsigned char* p) { return __builtin_bit_cast(s16x4, __builtin_amdgcn_ds_read_tr16_b64_v4i16((LAS s16x4*)p)); }

#define XB_TMO      128
#define XB_XCNT(j)  (256  + 64 * (j))
#define XB_XSUB(j)  (1280 + 64 * (j))
#define XB_XGEN(j)  (2304 + 64 * (j))
#define XB_TOP      3328
#define XB_TOPGEN   3392
#define XCD_BAR_WORDS 3456
#define XB_SPIN_CAP (1u << 18)

__device__ __forceinline__ unsigned xb_ld(unsigned* p)              { return __hip_atomic_load(p, __ATOMIC_RELAXED, __HIP_MEMORY_SCOPE_AGENT); }
__device__ __forceinline__ unsigned xb_add(unsigned* p, unsigned v) { return __hip_atomic_fetch_add(p, v, __ATOMIC_RELAXED, __HIP_MEMORY_SCOPE_AGENT); }
__device__ __forceinline__ unsigned xb_xcc_id() { return (unsigned)__builtin_amdgcn_s_getreg((3 << 11) | 20) & 0xFu; }
#define XB_SPIN(cond, bar) do { unsigned _sp = 0; while (cond) { __builtin_amdgcn_s_sleep(1); \
    if ((++_sp & 255u) == 0u) { if (xb_ld(&(bar)[XB_TMO])) break; if (_sp > XB_SPIN_CAP) { atomicAdd(&(bar)[XB_TMO], 1u); break; } } } } while (0)

struct XcdBarrier {
    unsigned* bar; unsigned x; int wave;
    volatile LAS unsigned* st;
};

__device__ __forceinline__ XcdBarrier xcd_barrier_post(unsigned* bar, volatile LAS unsigned* st, int wave) {
    XcdBarrier b; b.bar = bar; b.x = xb_xcc_id(); b.st = st; b.wave = wave;
    if (b.wave == 0 && lane_now() == 0) (void)xb_add(&bar[XB_XCNT(b.x)], 1u);
    return b;
}
__device__ __forceinline__ void xcd_barrier_complete(unsigned* bar, unsigned x, unsigned& nloc, unsigned& nx) {
    const unsigned G = gridDim.x * gridDim.y * gridDim.z;
    unsigned sum, cnt, mine, sp = 0u;
    for (;;) {
        sum = 0u; cnt = 0u; mine = 0u;
#pragma unroll
        for (unsigned j = 0; j < 16; ++j) { const unsigned c = xb_ld(&bar[XB_XCNT(j)]); sum += c; cnt += (c > 0u) ? 1u : 0u; mine = (j == x) ? c : mine; }
        if (sum == G) break;
        __builtin_amdgcn_s_sleep(1);
        if ((++sp & 255u) == 0u) { if (xb_ld(&bar[XB_TMO])) break; if (sp > XB_SPIN_CAP) { atomicAdd(&bar[XB_TMO], 1u); break; } }
    }
    nloc = mine > 0u ? mine : 1u; nx = cnt > 0u ? cnt : 1u;
}

__device__ __forceinline__ void xcd_barrier(const XcdBarrier& b) {
    asm volatile("s_waitcnt vmcnt(0)" ::: "memory");
    __syncthreads();
    if (b.wave == 0 && lane_now() == 0) {
        unsigned* bar = b.bar;
        __builtin_amdgcn_s_waitcnt(0);
        unsigned nloc = b.st[0], nx = b.st[1];
        if (nloc == 0u) { xcd_barrier_complete(bar, b.x, nloc, nx); b.st[0] = nloc; b.st[1] = nx; }
        const unsigned old = xb_add(&bar[XB_XSUB(b.x)], 1u);
        const unsigned gen = old / nloc;
        if (old + 1u == (gen + 1u) * nloc) {
            __builtin_amdgcn_fence(__ATOMIC_RELEASE, "agent");
            asm volatile("s_waitcnt vmcnt(0)" ::: "memory");
            const unsigned og = xb_add(&bar[XB_TOP], 1u);
            const unsigned tg = og / nx;
            if (og + 1u == (tg + 1u) * nx) xb_add(&bar[XB_TOPGEN], 1u);
            else XB_SPIN(xb_ld(&bar[XB_TOPGEN]) == tg, bar);
            __builtin_amdgcn_fence(__ATOMIC_ACQUIRE, "agent");
            xb_add(&bar[XB_XGEN(b.x)], 1u);
            asm volatile("s_waitcnt vmcnt(0)" ::: "memory");
        } else {
            XB_SPIN(xb_ld(&bar[XB_XGEN(b.x)]) == gen, bar);
            __builtin_amdgcn_fence(__ATOMIC_ACQUIRE, "agent");
            asm volatile("s_waitcnt vmcnt(0)" ::: "memory");
        }
    }
    __syncthreads();
}

struct Ctx {
    const float *x, *norm_mix, *norm_ffn, *norm_final, *w_in_ab, *a_v_norm, *a_sw, *a_sb, *b_rpb, *w_out_ab, *w_in_cd, *c_conv, *w_out_cd, *router, *w_gate, *w_up, *w_down;
    float* out; unsigned char* ws;
    LAS unsigned char* lds;
    int tid, lane, wave, wave0, G, bid;
};

__device__ __forceinline__ void tr_load(const float* src, int N, f32x4 (&v)[16], int lane) {
    const int cc = lane & 15, rg = lane >> 4;
#pragma unroll
    for (int i = 0; i < 16; ++i) { const int k = (i & 1) + 2 * rg + 8 * (i >> 1); v[i] = *(const f32x4*)(src + (size_t)k * N + 4 * cc); }
}
__device__ __forceinline__ void tr_store(const f32x4 (&v)[16], bf16* dst, LAS unsigned* scr, int lane) {
    const int cc = lane & 15, rg = lane >> 4;
#pragma unroll
    for (int j = 0; j < 8; ++j)
#pragma unroll
        for (int q = 0; q < 4; ++q) scr[(4 * cc + q) * 33 + rg + 4 * j] = cvt_pk_bf16(v[2 * j][q], v[2 * j + 1][q]);
    LDS_WAIT(); asm volatile("" ::: "memory");
    const int ch = lane & 7;
#pragma unroll
    for (int jj = 0; jj < 8; ++jj) { const int n = (lane >> 3) + 8 * jj; const LAS unsigned* s = scr + n * 33 + 4 * ch;
        u32x4 o; o.x = s[0]; o.y = s[1]; o.z = s[2]; o.w = s[3];
        *(u32x4*)(dst + (size_t)n * DM + 8 * ch) = o; }
    LDS_WAIT(); asm volatile("" ::: "memory");
}
__device__ __forceinline__ void rms_row_load(const float* xrow, f32x4 (&v)[8], int lane) {
#pragma unroll
    for (int j = 0; j < 4; ++j) { v[2 * j] = *(const f32x4*)(xrow + 512 * j + 8 * lane); v[2 * j + 1] = *(const f32x4*)(xrow + 512 * j + 8 * lane + 4); }
}
__device__ __forceinline__ void rms_row_to_bf16(const f32x4 (&v)[8], const float* gw, bf16* orow, unsigned char* orow8, int lane) {
    float ss = 0.f;
#pragma unroll
    for (int j = 0; j < 8; ++j) ss += (v[j].x * v[j].x + v[j].y * v[j].y) + (v[j].z * v[j].z + v[j].w * v[j].w);
    const float rstd = 1.0f / sqrtf(wave_sum(ss, lane) * (1.0f / DM) + RMS_EPS);
#pragma unroll
    for (int j = 0; j < 4; ++j) { const f32x4 g0 = *(const f32x4*)(gw + 512 * j + 8 * lane), g1 = *(const f32x4*)(gw + 512 * j + 8 * lane + 4);
        const f32x4 a = v[2 * j] * rstd * g0, b2 = v[2 * j + 1] * rstd * g1;
        u32x4 o; o.x = cvt_pk_bf16(a.x, a.y); o.y = cvt_pk_bf16(a.z, a.w); o.z = cvt_pk_bf16(b2.x, b2.y); o.w = cvt_pk_bf16(b2.z, b2.w);
        *(u32x4*)(orow + 512 * j + 8 * lane) = o;
        { int p0 = 0, p1 = 0;
          p0 = __builtin_amdgcn_cvt_pk_fp8_f32(__builtin_amdgcn_fmed3f(a.x, -448.f, 448.f), __builtin_amdgcn_fmed3f(a.y, -448.f, 448.f), p0, false); p0 = __builtin_amdgcn_cvt_pk_fp8_f32(__builtin_amdgcn_fmed3f(a.z, -448.f, 448.f), __builtin_amdgcn_fmed3f(a.w, -448.f, 448.f), p0, true);
          p1 = __builtin_amdgcn_cvt_pk_fp8_f32(__builtin_amdgcn_fmed3f(b2.x, -448.f, 448.f), __builtin_amdgcn_fmed3f(b2.y, -448.f, 448.f), p1, false); p1 = __builtin_amdgcn_cvt_pk_fp8_f32(__builtin_amdgcn_fmed3f(b2.z, -448.f, 448.f), __builtin_amdgcn_fmed3f(b2.w, -448.f, 448.f), p1, true);
          u32x2 w8; w8.x = (unsigned)p0; w8.y = (unsigned)p1; *(u32x2*)(orow8 + 512 * j + 8 * lane) = w8; } }
}
__device__ __forceinline__ int conv_job_items(int job) { return job == 0 ? 32 * 80 : job == 2 ? 32 * 96 : job < 4 ? 32 * 32 : ((job - 4) & 1) ? 16 * 1024 : 32 * 1024; }
struct ConvItem { const float* src; int N; bf16* dst; int fp8; };
__device__ __forceinline__ ConvItem conv_decode(const Ctx& c, int job, int r) {
    ConvItem t;
    if (job < 4) {
        const float* W = job == 0 ? c.w_in_ab : job == 1 ? c.w_out_ab : job == 2 ? c.w_in_cd : c.w_out_cd;
        const int N = job == 0 ? IN_AB : job == 2 ? IN_CD : DM;
        bf16* WT = (bf16*)(c.ws + (job == 0 ? WS_WIN0 : job == 1 ? WS_WOUT0 : job == 2 ? WS_WIN1 : WS_WOUT1));
        const int nsb = N / 128, sub = r & 7, sup = r >> 3, kb = 4 * (sup / nsb) + (sub & 3), nb = 2 * (sup % nsb) + (sub >> 2);
        t.src = W + (size_t)(64 * kb) * N + 64 * nb; t.N = N; t.dst = WT + (size_t)(64 * nb) * DM + 64 * kb; t.fp8 = 0;
        const int q0 = job == 0 ? 32 : job == 2 ? 48 : 1 << 30;
        if (nb >= q0) { t.fp8 = 1; t.dst = (bf16*)(c.ws + WS_WIN8 + (job == 2 ? 6 * MiB : 0) + (size_t)(64 * (nb - q0)) * DM + 64 * kb); }
    } else {
        const int l = (job - 4) >> 1, isdn = (job - 4) & 1, mat = r >> 10, w = r & 1023, sub = w & 7, sup = w >> 3, kb = 4 * (sup >> 4) + (sub & 3), n0 = 64 * (2 * (sup & 15) + (sub >> 2));
        const int e = isdn ? mat : mat >> 1, which = isdn ? 2 : (mat & 1);
        t.src = (which == 0 ? c.w_gate : which == 1 ? c.w_up : c.w_down) + ((size_t)(l * NE + e) * 2048 + 64 * kb) * 2048 + n0; t.N = 2048;
        t.fp8 = 1;
        if (which < 2) t.dst = (bf16*)(c.ws + WS_WGU + (size_t)l * 128 * MiB + (size_t)(e * 4096 + (n0 >> 7) * 256 + which * 128 + (n0 & 127)) * 2048 + 64 * kb);
        else t.dst = (bf16*)(c.ws + WS_WDN + (size_t)l * 64 * MiB + (size_t)(e * 2048 + n0) * 2048 + 64 * kb);
    }
    return t;
}
__device__ __forceinline__ void conv_job(const Ctx& c, int job, int lo, int hi, int icu, int ncu) {
    LAS unsigned* scr = (LAS unsigned*)(c.lds + c.wave * 8704);
    const int step = ncu * NWAVES; int it = lo + icu * NWAVES + c.wave;
    if (it >= hi) return;
    f32x4 va[16], vb[16];
    ConvItem ta = conv_decode(c, job, it), tb = ta;
    tr_load(ta.src, ta.N, va, c.lane);
    for (;;) {
        if (it + step < hi) { tb = conv_decode(c, job, it + step); tr_load(tb.src, tb.N, vb, c.lane); }
        tr_store(va, ta.dst, scr, c.lane);
        it += step; if (it >= hi) break;
        if (it + step < hi) { ta = conv_decode(c, job, it + step); tr_load(ta.src, ta.N, va, c.lane); }
        tr_store(vb, tb.dst, scr, c.lane);
        it += step; if (it >= hi) break;
    }
}
constexpr int DMA_PIECE = 1040, DMA_BUF = 8 * DMA_PIECE;
__device__ __forceinline__ void dma_issue(const float* src, int N, LAS unsigned char* buf, int lane) {
    const float* p = src + (size_t)(lane >> 3) * N + 4 * (lane & 7);
#pragma unroll
    for (int j = 0; j < 8; ++j) __builtin_amdgcn_global_load_lds((const unsigned*)(p + (size_t)(8 * j) * N), (LAS unsigned*)(buf + j * DMA_PIECE), 16, 0, 2);
}
__device__ __forceinline__ void dma_drain_store(const LAS unsigned char* buf, bf16* dst, int lane) {
    const int ch = lane & 7, nr = lane >> 3;
#pragma unroll
    for (int pass = 0; pass < 4; ++pass) { const int n = nr + 8 * pass; const LAS float* s = (const LAS float*)(buf + ch * DMA_PIECE) + n;
        float f[8];
#pragma unroll
        for (int q = 0; q < 8; ++q) f[q] = s[q * 32];
        u32x4 o; o.x = cvt_pk_bf16(f[0], f[1]); o.y = cvt_pk_bf16(f[2], f[3]); o.z = cvt_pk_bf16(f[4], f[5]); o.w = cvt_pk_bf16(f[6], f[7]);
        __builtin_nontemporal_store(o, (u32x4*)(dst + (size_t)n * DM + 8 * ch)); }
}
__device__ __forceinline__ void dma_drain_store_fp8(const LAS unsigned char* buf, unsigned char* dst8, int lane) {
    const int ch = lane & 3, nr = lane >> 2;
#pragma unroll
    for (int pass = 0; pass < 2; ++pass) { const int n = nr + 16 * pass; const LAS float* s = (const LAS float*)(buf + 2 * ch * DMA_PIECE) + n;
        float f[16];
#pragma unroll
        for (int q = 0; q < 16; ++q) f[q] = s[(q >> 3) * (DMA_PIECE / 4) + (q & 7) * 32] * W8_SCALE;
        u32x4 o;
#pragma unroll
        for (int w = 0; w < 4; ++w) { int p = 0; p = __builtin_amdgcn_cvt_pk_fp8_f32(f[4 * w], f[4 * w + 1], p, false); p = __builtin_amdgcn_cvt_pk_fp8_f32(f[4 * w + 2], f[4 * w + 3], p, true); o[w] = (unsigned)p; }
        __builtin_nontemporal_store(o, (u32x4*)(dst8 + (size_t)n * DM + 16 * ch)); }
}
__device__ __forceinline__ void conv_job_dma(const Ctx& c, int job, int lo, int hi, int icu, int ncu) {
    LAS unsigned char* b0 = c.lds + c.wave * (2 * DMA_BUF); LAS unsigned char* b1 = b0 + DMA_BUF;
    const int step = ncu * NWAVES; int it = lo + icu * NWAVES + c.wave;
    if (it >= hi) return;
    ConvItem t = conv_decode(c, job, it);
    dma_issue(t.src, t.N, b0, c.lane);
    for (;;) {
        dma_issue(t.src + 32, t.N, b1, c.lane);
        asm volatile("s_waitcnt vmcnt(8)" ::: "memory");
        if (t.fp8) dma_drain_store_fp8(b0, (unsigned char*)t.dst, c.lane); else dma_drain_store(b0, t.dst, c.lane);
        asm volatile("s_waitcnt lgkmcnt(0)" ::: "memory");
        const int nit = it + step; ConvItem tn = t;
        if (nit < hi) { tn = conv_decode(c, job, nit); dma_issue(tn.src, tn.N, b0, c.lane); asm volatile("s_waitcnt vmcnt(8)" ::: "memory"); }
        else asm volatile("s_waitcnt vmcnt(0)" ::: "memory");
        if (t.fp8) dma_drain_store_fp8(b1, (unsigned char*)t.dst + (size_t)32 * DM, c.lane); else dma_drain_store(b1, t.dst + (size_t)32 * DM, c.lane);
        asm volatile("s_waitcnt lgkmcnt(0)" ::: "memory");
        if (nit >= hi) break;
        it = nit; t = tn;
    }
}
constexpr int WT_PITCH = 1040, WT_BYTES = 64 * WT_PITCH;
__device__ __forceinline__ int conv_job_tiles(int job) { return job == 0 ? 32 * 20 : job == 2 ? 32 * 24 : job < 4 ? 32 * 8 : ((job - 4) & 1) ? 16 * 256 : 32 * 256; }
struct ConvTile { const float* src; int N; int rowbase  ; int k0; int kind  ; unsigned char* dstb; };
__device__ __forceinline__ ConvTile conv_tile_decode(const Ctx& c, int job, int tt) {
    ConvTile t;
    if (job < 4) {
        const float* W = job == 0 ? c.w_in_ab : job == 1 ? c.w_out_ab : job == 2 ? c.w_in_cd : c.w_out_cd;
        const int N = job == 0 ? IN_AB : job == 2 ? IN_CD : DM, nT = N / 256, kb = tt / nT, nt = tt % nT;
        t.src = W + (size_t)(64 * kb) * N + 256 * nt; t.N = N; t.rowbase = 256 * nt; t.k0 = 64 * kb; t.kind = 0;
        t.dstb = c.ws + (job == 0 ? WS_WIN0 : job == 1 ? WS_WOUT0 : job == 2 ? WS_WIN1 : WS_WOUT1);
        const int q0 = job == 0 ? 8 : job == 2 ? 12 : 1 << 30;
        if (nt >= q0) { t.kind = 2; t.rowbase = 256 * (nt - q0); t.dstb = c.ws + WS_WIN8 + (job == 2 ? 6 * MiB : 0); }
    } else {
        const int l = (job - 4) >> 1, isdn = (job - 4) & 1, mat = tt >> 8, w = tt & 255, kb = w >> 3, nt = w & 7;
        const int e = isdn ? mat : mat >> 1, which = isdn ? 2 : (mat & 1);
        t.src = (which == 0 ? c.w_gate : which == 1 ? c.w_up : c.w_down) + ((size_t)(l * NE + e) * 2048 + 64 * kb) * 2048 + 256 * nt; t.N = 2048; t.k0 = 64 * kb;
        if (which < 2) { t.kind = 1; t.rowbase = e * 4096 + (2 * nt) * 256 + which * 128; t.dstb = c.ws + WS_WGU + (size_t)l * 128 * MiB; }
        else { t.kind = 2; t.rowbase = e * 2048 + 256 * nt; t.dstb = c.ws + WS_WDN + (size_t)l * 64 * MiB; }
    }
    return t;
}
__device__ __forceinline__ void wt_issue(const Ctx& c, const ConvTile& t, LAS unsigned char* buf) {
    const float* p = t.src + (size_t)(8 * c.wave) * t.N + 4 * c.lane;
#pragma unroll
    for (int j = 0; j < 8; ++j) __builtin_amdgcn_global_load_lds((const unsigned*)(p + (size_t)j * t.N), (LAS unsigned*)(buf + (8 * c.wave + j) * WT_PITCH), 16, 0, 2);
}
__device__ __forceinline__ void wt_drain(const Ctx& c, const ConvTile& t, const LAS unsigned char* buf) {
    if (t.kind == 0) {
#pragma unroll
        for (int j = 0; j < 4; ++j) { const int id = c.tid + 512 * j, n = id >> 3, ch = id & 7; const LAS float* s = (const LAS float*)(buf + (8 * ch) * WT_PITCH) + n;
            float f[8];
#pragma unroll
            for (int q = 0; q < 8; ++q) f[q] = s[q * (WT_PITCH / 4)];
            u32x4 o; o.x = cvt_pk_bf16(f[0], f[1]); o.y = cvt_pk_bf16(f[2], f[3]); o.z = cvt_pk_bf16(f[4], f[5]); o.w = cvt_pk_bf16(f[6], f[7]);
            __builtin_nontemporal_store(o, (u32x4*)((bf16*)t.dstb + (size_t)(t.rowbase + n) * DM + t.k0 + 8 * ch)); }
    } else {
#pragma unroll
        for (int j = 0; j < 2; ++j) { const int id = c.tid + 512 * j, n = id >> 2, ch = id & 3; const LAS float* s = (const LAS float*)(buf + (16 * ch) * WT_PITCH) + n;
            float f[16];
#pragma unroll
            for (int q = 0; q < 16; ++q) f[q] = s[q * (WT_PITCH / 4)] * W8_SCALE;
            u32x4 o;
#pragma unroll
            for (int w = 0; w < 4; ++w) { int p = 0; p = __builtin_amdgcn_cvt_pk_fp8_f32(f[4 * w], f[4 * w + 1], p, false); p = __builtin_amdgcn_cvt_pk_fp8_f32(f[4 * w + 2], f[4 * w + 3], p, true); o[w] = (unsigned)p; }
            const int row = t.kind == 1 ? t.rowbase + (n >> 7) * 256 + (n & 127) : t.rowbase + n;
            __builtin_nontemporal_store(o, (u32x4*)(t.dstb + (size_t)row * DM + t.k0 + 16 * ch)); }
    }
}
__device__ __forceinline__ void conv_job_wg(const Ctx& c, int job, int lo, int hi, int icu, int ncu) {
    int tt = lo + icu; if (tt >= hi) return;
    LAS unsigned char* b0 = c.lds; LAS unsigned char* b1 = c.lds + WT_BYTES;
    ConvTile t = conv_tile_decode(c, job, tt);
    wt_issue(c, t, b0);
    for (int b = 0;; b ^= 1) {
        const int nx = tt + ncu; ConvTile tn = t;
        asm volatile("" ::: "memory"); __builtin_amdgcn_s_barrier(); asm volatile("" ::: "memory");
        if (nx < hi) { tn = conv_tile_decode(c, job, nx); wt_issue(c, tn, b ? b0 : b1); asm volatile("s_waitcnt vmcnt(8)" ::: "memory"); }
        else asm volatile("s_waitcnt vmcnt(0)" ::: "memory");
        __builtin_amdgcn_s_barrier(); asm volatile("" ::: "memory");
        wt_drain(c, t, b ? b1 : b0);
        asm volatile("s_waitcnt lgkmcnt(0)" ::: "memory");
        if (nx >= hi) break;
        tt = nx; t = tn;
    }
}
__device__ __forceinline__ void conv_job_loads(const Ctx& c, int job, int lo, int hi, int icu, int ncu) {
    const int step = ncu * NWAVES;
    for (int it = lo + icu * NWAVES + c.wave; it < hi; it += step) { f32x4 v[16]; const ConvItem t = conv_decode(c, job, it); tr_load(t.src, t.N, v, c.lane);
#pragma unroll
        for (int k = 0; k < 16; ++k) asm volatile("" :: "v"(v[k])); }
}
__device__ __forceinline__ void conv_job_half(const Ctx& c, int job, int when  ) {
#if MK_CONV_SKEW
    const int n = conv_job_items(job), pass = c.G * NWAVES, per = (n + pass - 1) / pass, j = c.bid >> 3, q = ((j >> 1) * per) / (((c.G + 7) >> 3) * 2);
    const int s = (j & 1) ? q : per - q, cut = s * pass < n ? s * pass : n;
    if (when == 0) { if (cut > 0) conv_job_dma(c, job, 0, cut, c.bid, c.G); }
    else if (cut < n) conv_job_dma(c, job, cut, n, c.bid, c.G);
#else
    const int hg = c.G >> 1, half = c.bid >= hg ? 1 : 0, n = conv_job_items(job), mid = (n >> 1);
    if (half != when) return;
    conv_job_dma(c, job, half ? mid : 0, half ? n : mid, half ? c.bid - hg : c.bid, half ? c.G - hg : hg);
#endif
}
__device__ __forceinline__ void p_prologue(const Ctx& c) {
    conv_job_dma(c, 0, 0, conv_job_items(0), c.bid, c.G); __syncthreads();
    const int gw = c.bid * NWAVES + c.wave, NGW = c.G * NWAVES;
    bf16* H = (bf16*)(c.ws + WS_H);
    f32x4 va[8], vb[8]; int m = gw;
    if (m < M) rms_row_load(c.x + (size_t)m * DM, va, c.lane);
    for (; m < M; m += NGW) { const int mn = m + NGW;
        if (mn < M) rms_row_load(c.x + (size_t)mn * DM, vb, c.lane);
        rms_row_to_bf16(va, c.norm_mix, H + (size_t)m * DM, c.ws + WS_H8 + (size_t)m * DM, c.lane);
#pragma unroll
        for (int j = 0; j < 8; ++j) va[j] = vb[j]; }
}
constexpr int KP = 272, VP = 288, ATT_K_OFF = 0, ATT_V_OFF = 256 * KP, ATT_RP_OFF = ATT_V_OFF + 256 * VP;
__device__ __forceinline__ void att_write_lds(const Ctx& c, const u32x4 (&kr)[8], const u32x4 (&vr)[8], int rot) {
#pragma unroll
    for (int j = 0; j < 8; ++j) { const int id = c.tid + 512 * j, row = ((id >> 4) & 128) | (((id >> 4) + rot) & 127), c16 = id & 15;
        *(LAS u32x4*)(c.lds + ATT_K_OFF + row * KP + 16 * c16) = kr[j]; *(LAS u32x4*)(c.lds + ATT_V_OFF + row * VP + 16 * c16) = vr[j]; }
}
template <int NB, class Fn>
__device__ __forceinline__ void attn_blocks(const LAS unsigned char* lds, const int (&krow)[NB], const bf16x8 (&qf)[4], f32x4 (&O)[8], float& m, float& l, int i, int g, const Fn (&fn)[NB]) {
    const LAS unsigned char* kbp[NB]; const LAS unsigned char* vbp[NB];
#pragma unroll
    for (int nb = 0; nb < NB; ++nb) { const unsigned ko = (unsigned)(ATT_K_OFF + (krow[nb] + i) * KP + 16 * g), vo = (unsigned)(ATT_V_OFF + (krow[nb] + 4 * g + (i >> 2)) * VP + 8 * (i & 3));
        kbp[nb] = lds + ko; vbp[nb] = lds + vo; }
    f32x4 S[NB][2];
#pragma unroll
    for (int nb = 0; nb < NB; ++nb) { S[nb][0] = (f32x4){0.f, 0.f, 0.f, 0.f}; S[nb][1] = (f32x4){0.f, 0.f, 0.f, 0.f}; }
#pragma unroll
    for (int kh = 0; kh < 2; ++kh) {
        bf16x8 kf[2][NB][2];
#pragma unroll
        for (int kk = 0; kk < 2; ++kk)
#pragma unroll
            for (int nb = 0; nb < NB; ++nb)
#pragma unroll
                for (int t = 0; t < 2; ++t) kf[kk][nb][t] = *(const LAS bf16x8*)(kbp[nb] + 16 * t * KP + 64 * (2 * kh + kk));
#pragma unroll
        for (int kk = 0; kk < 2; ++kk)
#pragma unroll
            for (int nb = 0; nb < NB; ++nb)
#pragma unroll
                for (int t = 0; t < 2; ++t) S[nb][t] = __builtin_amdgcn_mfma_f32_16x16x32_bf16(kf[kk][nb][t], qf[2 * kh + kk], S[nb][t], 0, 0, 0);
    }
    s16x4 vlo[8][NB], vhi[8][NB];
#pragma unroll
    for (int dn = 0; dn < 2; ++dn)
#pragma unroll
        for (int nb = 0; nb < NB; ++nb) { const LAS unsigned char* vb = vbp[nb] + 32 * dn; vlo[dn][nb] = vtr(vb); vhi[dn][nb] = vtr(vb + 16 * VP); }
    float sc[NB][8]; float mx = -INFINITY;
#pragma unroll
    for (int nb = 0; nb < NB; ++nb)
#pragma unroll
        for (int r = 0; r < 4; ++r) { sc[nb][r] = fn[nb](0, r, S[nb][0][r]); sc[nb][4 + r] = fn[nb](1, r, S[nb][1][r]); mx = fmaxf(mx, fmaxf(sc[nb][r], sc[nb][4 + r])); }
    { const int ln = (g << 4) | i; mx = fmaxf(mx, shx(mx, 16, ln)); mx = fmaxf(mx, shx(mx, 32, ln)); }
    const float mn = fmaxf(m, mx), alpha = __builtin_amdgcn_exp2f(m - mn);
    float ps = 0.f; bf16x8 pf[NB];
#pragma unroll
    for (int nb = 0; nb < NB; ++nb) { float p[8];
#pragma unroll
        for (int j = 0; j < 8; ++j) { p[j] = __builtin_amdgcn_exp2f(sc[nb][j] - mn); ps += p[j]; }
        u32x4 pw; pw.x = cvt_pk_bf16(p[0], p[1]); pw.y = cvt_pk_bf16(p[2], p[3]); pw.z = cvt_pk_bf16(p[4], p[5]); pw.w = cvt_pk_bf16(p[6], p[7]);
        pf[nb] = __builtin_bit_cast(bf16x8, pw); }
    l = l * alpha + ps; m = mn;
#pragma unroll
    for (int dn = 2; dn < 8; ++dn)
#pragma unroll
        for (int nb = 0; nb < NB; ++nb) { const LAS unsigned char* vb = vbp[nb] + 32 * dn; vlo[dn][nb] = vtr(vb); vhi[dn][nb] = vtr(vb + 16 * VP); }
#pragma unroll
    for (int dn = 0; dn < 8; ++dn) O[dn] = O[dn] * alpha;
#pragma unroll
    for (int dn = 0; dn < 8; ++dn)
#pragma unroll
        for (int nb = 0; nb < NB; ++nb) {
            const bf16x8 vf = {vlo[dn][nb][0], vlo[dn][nb][1], vlo[dn][nb][2], vlo[dn][nb][3], vhi[dn][nb][0], vhi[dn][nb][1], vhi[dn][nb][2], vhi[dn][nb][3]};
            O[dn] = __builtin_amdgcn_mfma_f32_16x16x32_bf16(vf, pf[nb], O[dn], 0, 0, 0); }
}

__device__ __forceinline__ void sgu_unit(const Ctx& c, int u) {
    const int b = u >> 5, chn = (u >> 1) & 15, half = u & 1, tok0 = b * SEQ + chn * 128;
    const bf16* P = (const bf16*)(c.ws + WS_P); bf16* Y = (bf16*)(c.ws + WS_YCAT);
    LAS unsigned char* Vs = c.lds; LAS float* stat = (LAS float*)(c.lds + 128 * 272);
    const int lane = c.lane, wave = c.wave, i = lane & 15, g = lane >> 4;
    __syncthreads();
#pragma unroll
    for (int it = 0; it < 2; ++it) {
        u32x4 raw[2][8];
#pragma unroll
        for (int ps = 0; ps < 2; ++ps) { const bf16* row = P + (size_t)(tok0 + 16 * wave + 8 * it + 4 * ps + g) * IN_AB + 1024 + 8 * i;
#pragma unroll
            for (int j = 0; j < 8; ++j) raw[ps][j] = *(const u32x4*)(row + 128 * j); }
#pragma unroll
        for (int ps = 0; ps < 2; ++ps) { float s = 0.f;
#pragma unroll
            for (int j = 0; j < 8; ++j)
#pragma unroll
                for (int k = 0; k < 4; ++k) s += bf_lo(raw[ps][j][k]) + bf_hi(raw[ps][j][k]);
#pragma unroll
            for (int o = 1; o < 16; o <<= 1) s += shx(s, o, lane);
            const float mean = s * (1.0f / 1024.0f); float q2 = 0.f;
#pragma unroll
            for (int j = 0; j < 8; ++j)
#pragma unroll
                for (int k = 0; k < 4; ++k) { const float d0 = bf_lo(raw[ps][j][k]) - mean, d1 = bf_hi(raw[ps][j][k]) - mean; q2 += d0 * d0 + d1 * d1; }
#pragma unroll
            for (int o = 1; o < 16; o <<= 1) q2 += shx(q2, o, lane);
            const float rstd = 1.0f / sqrtf(q2 * (1.0f / 1024.0f) + LN_EPS);
            if (i == 0) { const int tk = 16 * wave + 8 * it + 4 * ps + g; stat[2 * tk] = mean; stat[2 * tk + 1] = rstd; } }
    }
    u32x4 rawv[4];
#pragma unroll
    for (int j = 0; j < 4; ++j) { const int id = c.tid + 512 * j, tok = id >> 4, c16 = id & 15; rawv[j] = *(const u32x4*)(P + (size_t)(tok0 + tok) * IN_AB + 1024 + (4 * half) * 128 + 8 * c16); }
    __syncthreads();
    for (int gi = 0; gi < 4; ++gi) {
        const int gidx = 4 * half + gi;
#pragma unroll
        for (int j = 0; j < 4; ++j) { const int id = c.tid + 512 * j, tok = id >> 4, c16 = id & 15;
            const u32x4 raw = rawv[j];
            const float mean = stat[2 * tok], rstd = stat[2 * tok + 1];
            const f32x4 g0 = *(const f32x4*)(c.a_v_norm + gidx * 128 + 8 * c16), g1 = *(const f32x4*)(c.a_v_norm + gidx * 128 + 8 * c16 + 4);
            u32x4 w;
            w.x = cvt_pk_bf16((bf_lo(raw.x) - mean) * rstd * g0.x, (bf_hi(raw.x) - mean) * rstd * g0.y);
            w.y = cvt_pk_bf16((bf_lo(raw.y) - mean) * rstd * g0.z, (bf_hi(raw.y) - mean) * rstd * g0.w);
            w.z = cvt_pk_bf16((bf_lo(raw.z) - mean) * rstd * g1.x, (bf_hi(raw.z) - mean) * rstd * g1.y);
            w.w = cvt_pk_bf16((bf_lo(raw.w) - mean) * rstd * g1.z, (bf_hi(raw.w) - mean) * rstd * g1.w);
            *(LAS u32x4*)(Vs + tok * 272 + 16 * c16) = w; }
        const int t = 16 * wave + i;
        const float* wrow = c.a_sw + (size_t)(gidx * 128 + t) * 128;
        bf16x8 bw[4];
#pragma unroll
        for (int kk = 0; kk < 4; ++kk) { const f32x4 lo = *(const f32x4*)(wrow + 32 * kk + 4 * g), hi = *(const f32x4*)(wrow + 32 * kk + 16 + 4 * g);
            u32x4 w; w.x = cvt_pk_bf16(lo.x, lo.y); w.y = cvt_pk_bf16(lo.z, lo.w); w.z = cvt_pk_bf16(hi.x, hi.y); w.w = cvt_pk_bf16(hi.z, hi.w); bw[kk] = __builtin_bit_cast(bf16x8, w); }
        const float bias = c.a_sb[gidx * 128 + t];
        if (gi < 3) {
#pragma unroll
            for (int j = 0; j < 4; ++j) { const int id = c.tid + 512 * j, tok = id >> 4, c16 = id & 15; rawv[j] = *(const u32x4*)(P + (size_t)(tok0 + tok) * IN_AB + 1024 + (gidx + 1) * 128 + 8 * c16); } }
        u32x2 uu[8];
#pragma unroll
        for (int mt = 0; mt < 8; ++mt) uu[mt] = *(const u32x2*)(P + (size_t)(tok0 + t) * IN_AB + gidx * 128 + 16 * mt + 4 * g);
        __syncthreads();
        f32x4 acc[8];
#pragma unroll
        for (int mt = 0; mt < 8; ++mt) { acc[mt] = (f32x4){0.f, 0.f, 0.f, 0.f};
#pragma unroll
            for (int kk = 0; kk < 4; ++kk) {
                const s16x4 lo = vtr(Vs + (32 * kk + 4 * g + (i >> 2)) * 272 + 32 * mt + 8 * (i & 3)), hi = vtr(Vs + (32 * kk + 16 + 4 * g + (i >> 2)) * 272 + 32 * mt + 8 * (i & 3));
                const bf16x8 af = {lo[0], lo[1], lo[2], lo[3], hi[0], hi[1], hi[2], hi[3]};
                acc[mt] = __builtin_amdgcn_mfma_f32_16x16x32_bf16(af, bw[kk], acc[mt], 0, 0, 0);
            } }
#pragma unroll
        for (int mt = 0; mt < 8; ++mt) { const int col = gidx * 128 + 16 * mt + 4 * g;
            u32x2 o; o.x = cvt_pk_bf16(bf_lo(uu[mt].x) * (acc[mt][0] + bias), bf_hi(uu[mt].x) * (acc[mt][1] + bias)); o.y = cvt_pk_bf16(bf_lo(uu[mt].y) * (acc[mt][2] + bias), bf_hi(uu[mt].y) * (acc[mt][3] + bias));
            *(u32x2*)(Y + (size_t)(tok0 + t) * DM + col) = o; }
        __syncthreads();
    }
}
struct NattenFn { const LAS float* rp; int brow, band0, cs, qc, g;
    __device__ __forceinline__ float operator()(int t, int reg, float s) const {
        const int kc = band0 + 16 * t + 4 * g + reg, rel = kc - cs; int bi = kc - qc + 15; bi = bi < 0 ? 0 : (bi > 30 ? 30 : bi);
        const float v = (s * ATT_SCALE + rp[brow + bi]) * LOG2E;
        return ((unsigned)rel < 16u) ? v : -INFINITY; } };
__device__ __forceinline__ void nat_issue(const Ctx& c, int item, u32x4 (&kr)[8], u32x4 (&vr)[8], bf16x8 (&qn)[4], int rot) {
    const int unit = item >> 2, chunk = item & 3, hp = unit & 3, r = (unit >> 2) & 31, b = unit >> 7;
    const int rs = r - 4 < 0 ? 0 : (r - 4 > 24 ? 24 : r - 4);
    const bf16* QKV = (const bf16*)(c.ws + WS_QKV); constexpr size_t WSTEP = QKV_STRIDE;
#pragma unroll
    for (int j = 0; j < 8; ++j) { const int id = c.tid + 512 * j, hh = id >> 11, row = ((id >> 4) + rot) & 127, c16 = id & 15;
        const bf16* src = QKV + WSTEP + ((size_t)(b * 8 + 2 * hp + hh) * SEQ + rs * 64 + chunk * 128 + row) * 128 + 8 * c16;
        kr[j] = *(const u32x4*)src; vr[j] = *(const u32x4*)(src + WSTEP); }
    if (chunk == 0) { const int i = c.lane & 15, g = c.lane >> 4, hh = c.wave >> 2, cb = c.wave & 3;
#pragma unroll
        for (int kk = 0; kk < 4; ++kk) qn[kk] = *(const bf16x8*)(QKV + ((size_t)(b * 8 + 2 * hp + hh) * SEQ + r * 64 + cb * 16 + i) * 128 + 32 * kk + 8 * g); }
}
__device__ __forceinline__ int nat_unit(const Ctx& c, int k) {
    if (c.G == 256) { const int x = c.bid & 7, ci = c.bid >> 3, set = 4 * x + k; return ((set >> 2) << 7) | (ci << 2) | (set & 3); }
    return c.bid + k * c.G;
}
__device__ __forceinline__ void p_natten(const Ctx& c) {
    const int NK = (1024 - c.bid + c.G - 1) / c.G, NITEM = NK * 4;
    const int lane = c.lane, wave = c.wave, i = lane & 15, g = lane >> 4, hh = wave >> 2, cb = wave & 3;
    LAS float* rp = (LAS float*)(c.lds + ATT_RP_OFF);
    u32x4 kr[8], vr[8]; bf16x8 qn[4], qf[4]; f32x4 O[8]; float m = -1e30f, l = 0.f;
#pragma unroll
    for (int kk = 0; kk < 4; ++kk) { qn[kk] = (bf16x8){0, 0, 0, 0, 0, 0, 0, 0}; qf[kk] = qn[kk]; }
#pragma unroll
    for (int dn = 0; dn < 8; ++dn) O[dn] = (f32x4){0.f, 0.f, 0.f, 0.f};
    const int band0 = cb * 16 - 8 < 0 ? 0 : (cb * 16 - 8 > 32 ? 32 : cb * 16 - 8), qc = cb * 16 + i, cs = qc - 8 < 0 ? 0 : (qc - 8 > 48 ? 48 : qc - 8);
    int item = 0;
    const int rot = (c.bid * 13) & 127;
    if (item < NITEM) nat_issue(c, nat_unit(c, 0) * 4, kr, vr, qn, rot);
    while (item < NITEM) {
        const int unit = nat_unit(c, item >> 2), chunk = item & 3, hp = unit & 3, r = (unit >> 2) & 31, b = unit >> 7;
        const int rs = r - 4 < 0 ? 0 : (r - 4 > 24 ? 24 : r - 4);
        __syncthreads();
        att_write_lds(c, kr, vr, rot);
        if (chunk == 0) {
            for (int k = c.tid; k < 930; k += NTHR) rp[k] = c.b_rpb[(2 * hp) * 465 + k];
#pragma unroll
            for (int kk = 0; kk < 4; ++kk) qf[kk] = qn[kk];
        }
        __syncthreads();
        const int nitem = item + 1;
        if (nitem < NITEM) nat_issue(c, nat_unit(c, nitem >> 2) * 4 + (nitem & 3), kr, vr, qn, rot);
        {
            const int a0 = 2 * chunk;
            const NattenFn fn[2] = {{rp + hh * 465, (rs + a0 - r + 7) * 31, band0, cs, qc, g}, {rp + hh * 465, (rs + a0 + 1 - r + 7) * 31, band0, cs, qc, g}};
            const int krow[2] = {hh * 128 + band0, hh * 128 + 64 + band0};
            attn_blocks<2, NattenFn>(c.lds, krow, qf, O, m, l, i, g, fn);
        }
        if (chunk == 3) {
            float lt = l; lt += shx(lt, 16, lane); lt += shx(lt, 32, lane);
            const float inv = 1.0f / lt;
            bf16* Y = (bf16*)(c.ws + WS_YCAT) + (size_t)(b * SEQ + r * 64 + qc) * DM + 1024 + (2 * hp + hh) * 128 + 4 * g;
#pragma unroll
            for (int dn = 0; dn < 8; ++dn) { u32x2 o; o.x = cvt_pk_bf16(O[dn][0] * inv, O[dn][1] * inv); o.y = cvt_pk_bf16(O[dn][2] * inv, O[dn][3] * inv);
                *(u32x2*)(Y + 16 * dn) = o; O[dn] = (f32x4){0.f, 0.f, 0.f, 0.f}; }
            m = -1e30f; l = 0.f;
        }
        item = nitem;
    }
}

struct ConvRegs { u32x4 cbv[2], cc[2][3], cx[2][3]; float wt[2][3]; };
__device__ __forceinline__ void conv_load(const Ctx& c, int u, int j, ConvRegs& r) {
    const bf16* P = (const bf16*)(c.ws + WS_P);
#pragma unroll
    for (int k = 0; k < 2; ++k) { const int id = c.tid + 512 * (j + k), tok = 64 * u + (id >> 7), c8 = id & 127, s = tok & (SEQ - 1);
        const bf16* row = P + (size_t)tok * IN_CD + 8 * c8; r.cbv[k] = *(const u32x4*)row;
#pragma unroll
        for (int w = 0; w < 3; ++w) { const int ss = s + w - 1; const bool in = ss >= 0 && ss < SEQ; r.wt[k][w] = in ? 1.f : 0.f;
            const bf16* rr = row + (ptrdiff_t)(in ? w - 1 : 0) * IN_CD; r.cc[k][w] = *(const u32x4*)(rr + 1024); r.cx[k][w] = *(const u32x4*)(rr + 2048); } }
}
__device__ __forceinline__ void conv_finish(const Ctx& c, int u, int j, const ConvRegs& r) {
    bf16* Y = (bf16*)(c.ws + WS_YCAT);
#pragma unroll
    for (int k = 0; k < 2; ++k) { const int id = c.tid + 512 * (j + k), tok = 64 * u + (id >> 7), c8 = id & 127;
        f32x4 acc0 = {0.f, 0.f, 0.f, 0.f}, acc1 = {0.f, 0.f, 0.f, 0.f};
#pragma unroll
        for (int w = 0; w < 3; ++w) { const f32x4 t0 = *(const f32x4*)(c.c_conv + w * 1024 + 8 * c8) * r.wt[k][w], t1 = *(const f32x4*)(c.c_conv + w * 1024 + 8 * c8 + 4) * r.wt[k][w];
            const u32x4 a = r.cc[k][w], x = r.cx[k][w];
            acc0.x += t0.x * bf_lo(a.x) * bf_lo(x.x); acc0.y += t0.y * bf_hi(a.x) * bf_hi(x.x); acc0.z += t0.z * bf_lo(a.y) * bf_lo(x.y); acc0.w += t0.w * bf_hi(a.y) * bf_hi(x.y);
            acc1.x += t1.x * bf_lo(a.z) * bf_lo(x.z); acc1.y += t1.y * bf_hi(a.z) * bf_hi(x.z); acc1.z += t1.z * bf_lo(a.w) * bf_lo(x.w); acc1.w += t1.w * bf_hi(a.w) * bf_hi(x.w); }
        const u32x4 b = r.cbv[k];
        u32x4 o; o.x = cvt_pk_bf16(bf_lo(b.x) * acc0.x, bf_hi(b.x) * acc0.y); o.y = cvt_pk_bf16(bf_lo(b.y) * acc0.z, bf_hi(b.y) * acc0.w);
        o.z = cvt_pk_bf16(bf_lo(b.z) * acc1.x, bf_hi(b.z) * acc1.y); o.w = cvt_pk_bf16(bf_lo(b.w) * acc1.z, bf_hi(b.w) * acc1.w);
        *(u32x4*)(Y + (size_t)tok * DM + 8 * c8) = o; }
}
__device__ __forceinline__ void conv_unit(const Ctx& c, int u) {
    ConvRegs ra, rb;
    conv_load(c, u, 0, ra);
#pragma unroll 1
    for (int j = 0; j < 16; j += 4) {
        conv_load(c, u, j + 2, rb);
        conv_finish(c, u, j, ra);
        if (j + 4 < 16) conv_load(c, u, j + 4, ra);
        conv_finish(c, u, j + 2, rb);
    }
}
struct DilFn { float slope_dil; int qi, g, klbase, length, rowb;
    __device__ __forceinline__ float operator()(int t, int reg, float s) const {
        const int jj = rowb + 16 * t + 4 * g + reg, delta = jj - 64 - qi, ad = delta < 0 ? -delta : delta, kl = klbase + jj;
        const float v = (s * ATT_SCALE - slope_dil * (float)ad) * LOG2E;
        return (ad <= 64 && kl >= 0 && kl < length) ? v : -INFINITY; } };
struct DilDec { int pat, h, b, dil, L, qc, res; };
__device__ __forceinline__ DilDec dil_decode(int u) { DilDec d; d.pat = u >> 10; d.h = u & 7; d.b = (u >> 3) & 7; const int sub = (u >> 6) & 15; d.dil = 1 << (2 * d.pat); const int nch = 16 >> (2 * d.pat);
    d.L = SEQ >> (2 * d.pat); d.qc = sub % nch; d.res = sub / nch; return d; }
__device__ __forceinline__ void dil_issue(const Ctx& c, int u, u32x4 (&kr)[8], u32x4 (&vr)[8], bf16x8 (&qn)[4], int rot) {
    const DilDec d = dil_decode(u);
    const bf16* QKV = (const bf16*)(c.ws + WS_QKV) + (size_t)(d.b * 8 + d.h) * SEQ * 128; constexpr size_t WSTEP = QKV_STRIDE;
#pragma unroll
    for (int j = 0; j < 8; ++j) { const int id = c.tid + 512 * j, row = ((id >> 4) & 128) | (((id >> 4) + rot) & 127), c16 = id & 15; int kl = 128 * d.qc - 64 + row;
        kl = kl < 0 ? 0 : (kl > d.L - 1 ? d.L - 1 : kl);
        const bf16* src = QKV + WSTEP + (size_t)(kl * d.dil + d.res) * 128 + 8 * c16; kr[j] = *(const u32x4*)src; vr[j] = *(const u32x4*)(src + WSTEP); }
    const int i = c.lane & 15, g = c.lane >> 4;
#pragma unroll
    for (int kk = 0; kk < 4; ++kk) qn[kk] = *(const bf16x8*)(QKV + (size_t)((128 * d.qc + 16 * c.wave + i) * d.dil + d.res) * 128 + 32 * kk + 8 * g);
}
__device__ __forceinline__ int dil_unit(const Ctx& c, int k) {
    if (c.G == 256) { const int x = c.bid & 7, ci = c.bid >> 3, lu = (k % 3) * 32 + ci, bh = 8 * x + 2 * (k / 3) + lu / 48, v = lu % 48;
        return ((v / 16) << 10) | ((v % 16) << 6) | bh; }
    return c.bid + k * c.G;
}
__device__ __forceinline__ void p_dilated(const Ctx& c) {
    const int NU = (3072 - c.bid + c.G - 1) / c.G;
    const int lane = c.lane, wave = c.wave, i = lane & 15, g = lane >> 4;
    u32x4 kr[8], vr[8]; bf16x8 qn[4], qf[4];
    const int rot = (c.bid * 13) & 127;
    if (0 < NU) dil_issue(c, dil_unit(c, 0), kr, vr, qn, rot);
    for (int k = 0; k < NU; ++k) {
        const int u = dil_unit(c, k);
        const DilDec d = dil_decode(u);
        __syncthreads();
        att_write_lds(c, kr, vr, rot);
#pragma unroll
        for (int kk = 0; kk < 4; ++kk) qf[kk] = qn[kk];
        __syncthreads();
        if (k + 1 < NU) dil_issue(c, dil_unit(c, k + 1), kr, vr, qn, rot);
        f32x4 O[8]; float m = -1e30f, l = 0.f;
        const int qi = 16 * wave + i, klbase = 128 * d.qc - 64, kb0 = wave >> 1;
#pragma unroll 1
        for (int crep = 0; crep < MK_DIL_REPS; ++crep) {
        m = -1e30f; l = 0.f;
#pragma unroll
        for (int dn = 0; dn < 8; ++dn) O[dn] = (f32x4){0.f, 0.f, 0.f, 0.f};
        const int lo_row = klbase < 0 ? -klbase : 0, hi_row = d.L - klbase < 256 ? d.L - klbase : 256;
        const float slope_dil = __builtin_amdgcn_exp2f(-(float)(d.h + 1)) * (float)d.dil;
#pragma unroll 1
        for (int pr = 0; pr < 2; ++pr) { const int r0 = 32 * (kb0 + 2 * pr);
            if (r0 + 64 > lo_row && r0 < hi_row) {
                const DilFn fn[2] = {{slope_dil, qi, g, klbase, d.L, r0}, {slope_dil, qi, g, klbase, d.L, r0 + 32}};
                const int krow[2] = {r0, r0 + 32};
                attn_blocks<2, DilFn>(c.lds, krow, qf, O, m, l, i, g, fn); } }
        { const int r0 = 32 * (kb0 + 4);
            if (r0 + 32 > lo_row && r0 < hi_row) {
                const DilFn fn[1] = {{slope_dil, qi, g, klbase, d.L, r0}};
                const int krow[1] = {r0};
                attn_blocks<1, DilFn>(c.lds, krow, qf, O, m, l, i, g, fn); } }
        }
        float lt = l; lt += shx(lt, 16, lane); lt += shx(lt, 32, lane);
        const float inv = 1.0f / lt;
        const int tokq = d.b * SEQ + (128 * d.qc + qi) * d.dil + d.res;
        bf16* OP = (bf16*)(c.ws + WS_OP) + (size_t)d.pat * OP_STRIDE + (size_t)tokq * 1024 + d.h * 128 + 4 * g;
#pragma unroll
        for (int dn = 0; dn < 8; ++dn) { u32x2 o; o.x = cvt_pk_bf16(O[dn][0] * inv, O[dn][1] * inv); o.y = cvt_pk_bf16(O[dn][2] * inv, O[dn][3] * inv); *(u32x2*)(OP + 16 * dn) = o; }
        if (g == 0) ((float*)(c.ws + WS_LSE))[((size_t)d.pat * M + tokq) * 8 + d.h] = (m + __builtin_amdgcn_logf(lt)) * LN2;
    }
}
__device__ __forceinline__ void p_merge(const Ctx& c) {
    const bf16* OP = (const bf16*)(c.ws + WS_OP); const float* LSE = (const float*)(c.ws + WS_LSE); bf16* Y = (bf16*)(c.ws + WS_YCAT);
    const int stride = c.G * NTHR;
    for (int id0 = c.bid * NTHR + c.tid; id0 < M * 128; id0 += 4 * stride) {
        float l[4][3]; u32x4 a[4][3]; bool ok[4];
#pragma unroll
        for (int k = 0; k < 4; ++k) { const int id = id0 + k * stride; ok[k] = id < M * 128; const int idc = ok[k] ? id : id0, tok = idc >> 7, c8 = idc & 127, h = c8 >> 4;
#pragma unroll
            for (int p = 0; p < 3; ++p) { l[k][p] = LSE[((size_t)p * M + tok) * 8 + h]; a[k][p] = *(const u32x4*)(OP + (size_t)p * OP_STRIDE + (size_t)tok * 1024 + 8 * c8); } }
#pragma unroll
        for (int k = 0; k < 4; ++k) { const int id = id0 + k * stride, tok = id >> 7, c8 = id & 127;
            const float mx = fmaxf(l[k][0], fmaxf(l[k][1], l[k][2])); float w0 = __expf(l[k][0] - mx), w1 = __expf(l[k][1] - mx), w2 = __expf(l[k][2] - mx); const float inv = 1.0f / (w0 + w1 + w2); w0 *= inv; w1 *= inv; w2 *= inv;
            u32x4 o;
#pragma unroll
            for (int q = 0; q < 4; ++q) o[q] = cvt_pk_bf16(w0 * bf_lo(a[k][0][q]) + w1 * bf_lo(a[k][1][q]) + w2 * bf_lo(a[k][2][q]), w0 * bf_hi(a[k][0][q]) + w1 * bf_hi(a[k][1][q]) + w2 * bf_hi(a[k][2][q]));
            if (ok[k]) *(u32x4*)(Y + (size_t)tok * DM + 1024 + 8 * c8) = o; }
    }
}

__device__ __forceinline__ void p_router(const Ctx& c, int layer) {
    const int lane = c.lane, wave = c.wave, i = lane & 15, g = lane >> 4, NU = M / 16;
    constexpr int XP = 4112, XBUF = 16 * XP;
    LAS float* red = (LAS float*)(c.lds + 2 * XBUF); LAS float* ssq = red + 2048;
    const float* gnf = c.norm_ffn + layer * DM;
    const float* gn = gnf + 256 * wave + 4 * g;
    const float* R = c.router + (size_t)layer * DM * NE + (size_t)(256 * wave + 4 * g) * NE + i;
    float rg[64];
#pragma unroll
    for (int kk = 0; kk < 16; ++kk) { const f32x4 g4 = *(const f32x4*)(gn + 16 * kk);
#pragma unroll
        for (int s = 0; s < 4; ++s) rg[4 * kk + s] = R[(size_t)(16 * kk + s) * NE] * g4[s]; }
    const unsigned char* XR = c.ws + WS_XRES;
#define RT_ISSUE(uu, bb) do { _Pragma("unroll") for (int _j = 0; _j < 8; ++_j) { const int _p = 8 * wave + _j; \
        __builtin_amdgcn_global_load_lds((const unsigned*)(XR + ((size_t)(uu) * 16 + (_p >> 2)) * 4096 + (_p & 3) * 1024 + lane * 16), (LAS unsigned*)(c.lds + (bb) * XBUF + (_p >> 2) * XP + (_p & 3) * 1024), 16, 0, 0); } } while (0)
    __syncthreads();
    int u = c.bid, b = 0;
    if (u < NU) RT_ISSUE(u, 0);
    for (; u < NU; u += c.G, b ^= 1) {
        const int row0 = u * 16;
        asm volatile("s_waitcnt vmcnt(0)" ::: "memory"); __syncthreads();
        if (u + c.G < NU) RT_ISSUE(u + c.G, b ^ 1);
        const LAS unsigned char* xb = c.lds + b * XBUF + i * XP + (256 * wave + 4 * g) * 2;
        float ss = 0.f; f32x4 acc0 = {0.f, 0.f, 0.f, 0.f}, acc1 = {0.f, 0.f, 0.f, 0.f};
#pragma unroll
        for (int kk = 0; kk < 16; ++kk) { const u32x2 w = *(const LAS u32x2*)(xb + 32 * kk); const float x0 = bf_lo(w.x), x1 = bf_hi(w.x), x2 = bf_lo(w.y), x3 = bf_hi(w.y);
            ss += (x0 * x0 + x1 * x1) + (x2 * x2 + x3 * x3);
            acc0 = __builtin_amdgcn_mfma_f32_16x16x4f32(x0, rg[4 * kk + 0], acc0, 0, 0, 0); acc1 = __builtin_amdgcn_mfma_f32_16x16x4f32(x1, rg[4 * kk + 1], acc1, 0, 0, 0);
            acc0 = __builtin_amdgcn_mfma_f32_16x16x4f32(x2, rg[4 * kk + 2], acc0, 0, 0, 0); acc1 = __builtin_amdgcn_mfma_f32_16x16x4f32(x3, rg[4 * kk + 3], acc1, 0, 0, 0); }
        const f32x4 acc = acc0 + acc1;
        ss += shx(ss, 16, lane); ss += shx(ss, 32, lane);
#pragma unroll
        for (int r = 0; r < 4; ++r) red[wave * 256 + (4 * g + r) * 16 + i] = acc[r];
        if (g == 0) ssq[wave * 16 + i] = ss;
        __syncthreads();
#pragma unroll
        for (int j = 0; j < 4; ++j) { const int cid = c.tid + 512 * j, row = cid >> 7, c16 = cid & 127; float tot = 0.f;
#pragma unroll
            for (int w = 0; w < 8; ++w) tot += ssq[w * 16 + row];
            const float rstd = 1.0f / sqrtf(tot * (1.0f / DM) + RMS_EPS);
            const LAS unsigned char* xs = c.lds + b * XBUF + row * XP + c16 * 32;
            const u32x4 wa = *(const LAS u32x4*)xs, wb = *(const LAS u32x4*)(xs + 16);
            u32x4 o;
#pragma unroll
            for (int q = 0; q < 4; ++q) { const unsigned wq0 = q < 2 ? wa[2 * q] : wb[2 * q - 4], wq1 = q < 2 ? wa[2 * q + 1] : wb[2 * q - 3];
                const f32x4 g4 = *(const f32x4*)(gnf + 16 * c16 + 4 * q) * rstd; int p = 0;
                p = __builtin_amdgcn_cvt_pk_fp8_f32(__builtin_amdgcn_fmed3f(bf_lo(wq0) * g4.x, -448.f, 448.f), __builtin_amdgcn_fmed3f(bf_hi(wq0) * g4.y, -448.f, 448.f), p, false);
                p = __builtin_amdgcn_cvt_pk_fp8_f32(__builtin_amdgcn_fmed3f(bf_lo(wq1) * g4.z, -448.f, 448.f), __builtin_amdgcn_fmed3f(bf_hi(wq1) * g4.w, -448.f, 448.f), p, true);
                o[q] = (unsigned)p; }
            *(u32x4*)(c.ws + WS_H8 + (size_t)(row0 + row) * DM + 16 * c16) = o; }
        if (wave == 0) {
            float* AFF = (float*)(c.ws + WS_AFF);
#pragma unroll
            for (int r = 0; r < 4; ++r) { const int row = 4 * g + r; float t2 = 0.f, lg = 0.f;
#pragma unroll
                for (int w = 0; w < 8; ++w) { t2 += ssq[w * 16 + row]; lg += red[w * 256 + row * 16 + i]; }
                lg *= 1.0f / sqrtf(t2 * (1.0f / DM) + RMS_EPS);
                float mx = lg;
#pragma unroll
                for (int o = 1; o < 16; o <<= 1) mx = fmaxf(mx, shx(mx, o, lane));
                const float ex = __expf(lg - mx); float sm = ex;
#pragma unroll
                for (int o = 1; o < 16; o <<= 1) sm += shx(sm, o, lane);
                const int grow = row0 + row;
                AFF[((size_t)(grow >> 11) * NE + i) * SEQ + (grow & (SEQ - 1))] = ex / sm; }
        }
    }
#undef RT_ISSUE
    asm volatile("s_waitcnt vmcnt(0)" ::: "memory");
}

__device__ __forceinline__ void topk_unit(const Ctx& c, int w) {
    const int be = w, e = be >> 3, b = be & 7, lane = c.lane, wave = c.wave, tid = c.tid;
    LAS unsigned* wsum = (LAS unsigned*)c.lds;
    const u32x4 mine = *(const u32x4*)((const unsigned*)(c.ws + WS_AFF) + (size_t)(b * NE + e) * SEQ + 4 * tid);
    __syncthreads();
    unsigned T = 0u;
    for (int bit = 30; bit >= 0; --bit) {
        const unsigned cand = T | (1u << bit);
        int cnt = (int)(mine.x >= cand) + (int)(mine.y >= cand) + (int)(mine.z >= cand) + (int)(mine.w >= cand);
#pragma unroll
        for (int o = 1; o < 64; o <<= 1) cnt += shx(cnt, o, lane);
        if (lane == 0) wsum[(bit & 1) * 8 + wave] = (unsigned)cnt;
        __syncthreads();
        unsigned tot = 0u;
#pragma unroll
        for (int k = 0; k < 8; ++k) tot += wsum[(bit & 1) * 8 + k];
        if (tot >= (unsigned)CAP) T = cand;
    }
    unsigned gt[4], eq[4]; unsigned val = 0u;
#pragma unroll
    for (int k = 0; k < 4; ++k) { gt[k] = mine[k] > T ? 1u : 0u; eq[k] = mine[k] == T ? 1u : 0u; val += gt[k] + (eq[k] << 16); }
    unsigned incl = val;
#pragma unroll
    for (int o = 1; o < 64; o <<= 1) { const unsigned t = shup(incl, o, lane); if (lane >= o) incl += t; }
    if (lane == 63) wsum[16 + wave] = incl;
    __syncthreads();
    unsigned base = 0u, total = 0u;
#pragma unroll
    for (int k = 0; k < 8; ++k) { const unsigned t = wsum[16 + k]; total += t; if (k < wave) base += t; }
    const unsigned excl = base + incl - val, need = (unsigned)CAP - (total & 0xffffu);
    unsigned gtb = excl & 0xffffu, eqb = excl >> 16;
    int* SEL = (int*)(c.ws + WS_SEL); float* GATE = (float*)(c.ws + WS_GATE); int* IDX = (int*)(c.ws + WS_IDX);
#pragma unroll
    for (int k = 0; k < 4; ++k) { const int s = 4 * tid + k; const bool sel = gt[k] || (eq[k] && eqb < need); const unsigned slot = gtb + (eqb < need ? eqb : need);
        if (sel) { IDX[be * CAP + slot] = b * SEQ + s; GATE[be * CAP + slot] = __uint_as_float(mine[k]); }
        SEL[((size_t)b * SEQ + s) * NE + e] = sel ? (int)slot : -1;
        gtb += gt[k]; eqb += eq[k]; }
}

template <int FINAL>
__device__ __forceinline__ void p_combine(const Ctx& c, const float* gw) {
    const int lane = c.lane, stride = c.G * NWAVES; int m = c.bid * NWAVES + c.wave;
    if (m >= M) return;
    const unsigned char* YE = c.ws + WS_YE; const int* SEL = (const int*)(c.ws + WS_SEL);
    u32x4 xw[4], xn[4]; int selv, seln;
    { const bf16* xr = (const bf16*)(c.ws + WS_XRES) + (size_t)m * DM;
#pragma unroll
      for (int j = 0; j < 4; ++j) xw[j] = *(const u32x4*)(xr + 512 * j + 8 * lane);
      selv = SEL[(size_t)m * NE + (lane & 15)]; }
    for (;;) {
        const int mn = m + stride; const bool more = mn < M;
        if (more) { const bf16* xr = (const bf16*)(c.ws + WS_XRES) + (size_t)mn * DM;
#pragma unroll
            for (int j = 0; j < 4; ++j) xn[j] = *(const u32x4*)(xr + 512 * j + 8 * lane);
            seln = SEL[(size_t)mn * NE + (lane & 15)]; }
        const int b = m >> 11;
        f32x4 v[8];
#pragma unroll
        for (int j = 0; j < 4; ++j) { const u32x4 w = xw[j];
            v[2 * j] = (f32x4){bf_lo(w.x), bf_hi(w.x), bf_lo(w.y), bf_hi(w.y)}; v[2 * j + 1] = (f32x4){bf_lo(w.z), bf_hi(w.z), bf_lo(w.w), bf_hi(w.w)}; }
        unsigned mask = (unsigned)__builtin_amdgcn_ballot_w64(selv >= 0) & 0xffffu;
        while (mask) {
            u32x2 y[4][4]; int have[4];
#pragma unroll
            for (int t = 0; t < 4; ++t) { have[t] = mask != 0u;
                if (have[t]) { const int e = __builtin_ctz(mask); mask &= mask - 1u; const int slot = __builtin_amdgcn_readlane(selv, e);
                    const unsigned char* yr = YE + (size_t)((e * 8 + b) * CAP + slot) * DM + 8 * lane;
#pragma unroll
                    for (int j = 0; j < 4; ++j) y[t][j] = *(const u32x2*)(yr + 512 * j); } }
#pragma unroll
            for (int t = 0; t < 4; ++t) if (have[t]) {
#pragma unroll
                for (int j = 0; j < 4; ++j) { const u32x2 yy = y[t][j]; constexpr float YI = 1.0f / YE_SCALE;
                    const auto a0 = __builtin_amdgcn_cvt_pk_f32_fp8((int)yy.x, false), a1 = __builtin_amdgcn_cvt_pk_f32_fp8((int)yy.x, true), a2 = __builtin_amdgcn_cvt_pk_f32_fp8((int)yy.y, false), a3 = __builtin_amdgcn_cvt_pk_f32_fp8((int)yy.y, true);
                    v[2 * j].x += a0[0] * YI; v[2 * j].y += a0[1] * YI; v[2 * j].z += a1[0] * YI; v[2 * j].w += a1[1] * YI;
                    v[2 * j + 1].x += a2[0] * YI; v[2 * j + 1].y += a2[1] * YI; v[2 * j + 1].z += a3[0] * YI; v[2 * j + 1].w += a3[1] * YI; } }
        }
        float ss = 0.f;
#pragma unroll
        for (int j = 0; j < 8; ++j) ss += (v[j].x * v[j].x + v[j].y * v[j].y) + (v[j].z * v[j].z + v[j].w * v[j].w);
        const float rstd = 1.0f / sqrtf(wave_sum(ss, lane) * (1.0f / DM) + RMS_EPS);
#pragma unroll
        for (int j = 0; j < 4; ++j) {
            const f32x4 g0 = *(const f32x4*)(gw + 512 * j + 8 * lane), g1 = *(const f32x4*)(gw + 512 * j + 8 * lane + 4);
            const f32x4 a = v[2 * j] * rstd * g0, b2 = v[2 * j + 1] * rstd * g1;
            if (FINAL) { float* orow = c.out + (size_t)m * DM + 512 * j + 8 * lane; *(f32x4*)orow = a; *(f32x4*)(orow + 4) = b2; }
            else { { u32x4 xo; xo.x = cvt_pk_bf16(v[2 * j].x, v[2 * j].y); xo.y = cvt_pk_bf16(v[2 * j].z, v[2 * j].w); xo.z = cvt_pk_bf16(v[2 * j + 1].x, v[2 * j + 1].y); xo.w = cvt_pk_bf16(v[2 * j + 1].z, v[2 * j + 1].w);
                    *(u32x4*)((bf16*)(c.ws + WS_XRES) + (size_t)m * DM + 512 * j + 8 * lane) = xo; }
                u32x4 o; o.x = cvt_pk_bf16(a.x, a.y); o.y = cvt_pk_bf16(a.z, a.w); o.z = cvt_pk_bf16(b2.x, b2.y); o.w = cvt_pk_bf16(b2.z, b2.w);
                *(u32x4*)((bf16*)(c.ws + WS_H) + (size_t)m * DM + 512 * j + 8 * lane) = o;
                int p0 = 0, p1 = 0;
                p0 = __builtin_amdgcn_cvt_pk_fp8_f32(__builtin_amdgcn_fmed3f(a.x, -448.f, 448.f), __builtin_amdgcn_fmed3f(a.y, -448.f, 448.f), p0, false); p0 = __builtin_amdgcn_cvt_pk_fp8_f32(__builtin_amdgcn_fmed3f(a.z, -448.f, 448.f), __builtin_amdgcn_fmed3f(a.w, -448.f, 448.f), p0, true);
                p1 = __builtin_amdgcn_cvt_pk_fp8_f32(__builtin_amdgcn_fmed3f(b2.x, -448.f, 448.f), __builtin_amdgcn_fmed3f(b2.y, -448.f, 448.f), p1, false); p1 = __builtin_amdgcn_cvt_pk_fp8_f32(__builtin_amdgcn_fmed3f(b2.z, -448.f, 448.f), __builtin_amdgcn_fmed3f(b2.w, -448.f, 448.f), p1, true);
                u32x2 w8; w8.x = (unsigned)p0; w8.y = (unsigned)p1; *(u32x2*)(c.ws + WS_H8 + (size_t)m * DM + 512 * j + 8 * lane) = w8; } }
        if (!more) break;
        m = mn; selv = seln;
#pragma unroll
        for (int j = 0; j < 4; ++j) xw[j] = xn[j];
    }
}

__device__ __forceinline__ void conv_job_part(const Ctx& c, int job, int flo, int fhi, int icu, int ncu) {
    const int n64 = conv_job_items(job) >> 6;
    conv_job_dma(c, job, n64 * flo, n64 * fhi, icu, ncu);
}
typedef __attribute__((address_space(4))) const unsigned char* kaptr_t;
__device__ __forceinline__ bool phase_enter(Ctx& c) { const int ln = lane_now(); int w = c.wave0; asm volatile("" : "+s"(w)); c.wave = w; c.lane = ln; c.tid = w * 64 + ln;
    kaptr_t ka = (kaptr_t)__builtin_amdgcn_kernarg_segment_ptr(); asm volatile("" : "+s"(ka));
    typedef const float* fptr_t; typedef float* mfptr_t; typedef unsigned char* ucptr_t; typedef __attribute__((address_space(4))) const fptr_t* inptr_t; inptr_t in = (inptr_t)ka;
    c.x = in[0]; c.norm_mix = in[1]; c.norm_ffn = in[2]; c.norm_final = in[3]; c.w_in_ab = in[4]; c.a_v_norm = in[5]; c.a_sw = in[6]; c.a_sb = in[7];
    c.b_rpb = in[8]; c.w_out_ab = in[9]; c.w_in_cd = in[10]; c.c_conv = in[11]; c.w_out_cd = in[12]; c.router = in[13]; c.w_gate = in[14]; c.w_up = in[15]; c.w_down = in[16];
    c.out = *(__attribute__((address_space(4))) const mfptr_t*)(ka + 136); c.ws = *(__attribute__((address_space(4))) const ucptr_t*)(ka + 144);
    return true; }
constexpr int NPH = 18;
struct Args { const float* in[17]; float* out; unsigned char* ws; int ph_lo, ph_hi; };
__global__ void __launch_bounds__(NTHR, 2) mk_fwd(Args args) {
    extern __shared__ __attribute__((aligned(16))) unsigned char lds_raw[];
    Ctx c;
    c.lds = (LAS unsigned char*)lds_raw;
    c.tid = threadIdx.x; c.lane = c.tid & 63; c.wave = __builtin_amdgcn_readfirstlane(c.tid >> 6); c.wave0 = c.wave; c.G = gridDim.x; c.bid = blockIdx.x;
    c.ws = args.ws;
    static_assert(sizeof(Args) == 160, "phase_enter reads the kernarg segment by offset");
    volatile LAS unsigned* MISC = (volatile LAS unsigned*)(c.lds + MISC_OFF);
    for (int u = c.tid; u < (LDS_BYTES - LDSCTL_OFF) / 4; u += NTHR) ((LAS unsigned*)(c.lds + LDSCTL_OFF))[u] = 0u;
    __syncthreads();
    unsigned* barw = (unsigned*)(c.ws + WS_CTL) + 1024;
    XcdBarrier bar; bar.bar = barw; bar.x = 0; bar.st = nullptr; bar.wave = c.wave0;
    const int lo = args.ph_lo, hi = args.ph_hi;
#define NOST ((hi - lo == 1) ? (MK_PROBE_NOSTORE) : 0)
    if (hi - lo > 1) bar = xcd_barrier_post(barw, MISC + 8, c.wave0);
#define IN(k) (lo <= (k) && (k) < hi && phase_enter(c))
#define PH(k) for (int rep_ = 0; rep_ < (((k) == MK_REPEAT) ? 2 : 1); ++rep_) if (IN(k))
#define INR(k) (lo <= (k) && (k) < hi)
#define SEAM(k) do { if (INR(k) && INR((k) + 1)) xcd_barrier(bar); } while (0)
#define H ((bf16*)(c.ws + WS_H))
#define P ((bf16*)(c.ws + WS_P))
#define YC ((bf16*)(c.ws + WS_YCAT))
#define XRES ((bf16*)(c.ws + WS_XRES))

    PH(0) { p_prologue(c); } SEAM(0);
    for (int layer = 0; layer < 2; ++layer) {
        const int pb = 1 + 8 * layer;
        if (layer == 0) {
            PH(1) { const int NCV = c.G >> 2, Gc = c.G - NCV, cc = c.bid - NCV; constexpr int CVF1 = MK_CVF1;
                if (c.bid < NCV) { conv_job_part(c, 1, 0, CVF1, c.bid, NCV); conv_job_part(c, 4, 0, CVF1, c.bid, NCV); }
                else {
                { pg8::Gemm g{H, (const bf16*)(c.ws + WS_WIN0), M, 2048, DM}; pg8::Order S; S.init(M, 2048, Gc, cc, 0);
                  pg8::EpiBf16 E{P, IN_AB, 8, 1 << 30, (bf16*)(c.ws + WS_QKV), QKV_STRIDE, 1.0f, NOST}; pg8::gemm_phase<pg8::EpiBf16, pg8::Order, MK_ALIGN, MK_SP2>(c.lds, g, S, E, c.tid); }
                { pg8::Gemm g{(const bf16*)(c.ws + WS_H8), (const bf16*)(c.ws + WS_WIN8), M, 3072, DM}; pg8::Order S; S.init(M, 3072, Gc, cc, 0);
                  { LAS int* tab = (LAS int*)(c.lds + RING_BYTES); S.tab = tab; pg8::Unit uu;
#pragma unroll 1
                    for (int kq = 0; kq < 15 && S.next(kq, uu); ++kq) if (c.tid < 256) tab[kq * 256 + c.tid] = uu.pm * 256 + c.tid;
                    __syncthreads(); }
                  pg8::EpiBf16 E{P, IN_AB, 0, 0, (bf16*)(c.ws + WS_QKV), QKV_STRIDE, 1.0f / W8_SCALE, NOST}; pg8::gemm_phase<pg8::EpiBf16, pg8::Order, MK_ALIGN, MK_SP2, true, true>(c.lds, g, S, E, c.tid); }
                if (cc >= Gc - NCV) { __syncthreads(); conv_job_part(c, 1, CVF1, 64, cc - (Gc - NCV), NCV); conv_job_part(c, 4, CVF1, 64, cc - (Gc - NCV), NCV); }
                } } SEAM(1);
            PH(2) { for (int rp2 = 0; rp2 < (MK_REPEAT == 20 ? 2 : 1); ++rp2) for (int u = c.bid; u < 256; u += c.G) sgu_unit(c, u); for (int rp2 = 0; rp2 < (MK_REPEAT == 21 ? 2 : 1); ++rp2) p_natten(c); } SEAM(2);
            PH(3) { const int NCV = c.G >> 2, Gc = c.G - NCV, cc = c.bid - NCV; constexpr int CVF3 = MK_CVF3;
                if (c.bid < NCV) conv_job_part(c, 5, 0, CVF3, c.bid, NCV);
                else { pg8::Gemm g{YC, (const bf16*)(c.ws + WS_WOUT0), M, DM, DM}; pg8::Order S; S.init(M, DM, Gc, cc, 0);
                    pg8::EpiResidB E{c.x, XRES, DM, 1}; pg8::gemm_phase<pg8::EpiResidB, pg8::Order, MK_ALIGN, MK_SP2>(c.lds, g, S, E, c.tid);
                    if (cc >= Gc - NCV) { __syncthreads(); conv_job_part(c, 5, CVF3, 64, cc - (Gc - NCV), NCV); } } } SEAM(3);
        } else {
            PH(8) { p_combine<0>(c, c.norm_mix + DM); } SEAM(8);
            PH(9) { { pg8::Gemm g{H, (const bf16*)(c.ws + WS_WIN1), M, 3072, DM}; pg8::Order S; S.init(M, 3072, c.G, c.bid, 0);
                  pg8::EpiBf16 E{P, IN_CD, 0, 1 << 30, (bf16*)(c.ws + WS_QKV), QKV_STRIDE, 1.0f, NOST}; pg8::gemm_phase<pg8::EpiBf16, pg8::Order, MK_ALIGN, MK_SP2>(c.lds, g, S, E, c.tid); }
                { pg8::Gemm g{(const bf16*)(c.ws + WS_H8), (const bf16*)(c.ws + WS_WIN8 + 6 * MiB), M, 3072, DM}; pg8::Order S; S.init(M, 3072, c.G, c.bid, 0);
                  { LAS int* tab = (LAS int*)(c.lds + RING_BYTES); S.tab = tab; pg8::Unit uu;
#pragma unroll 1
                    for (int kq = 0; kq < 15 && S.next(kq, uu); ++kq) if (c.tid < 256) tab[kq * 256 + c.tid] = uu.pm * 256 + c.tid;
                    __syncthreads(); }
                  pg8::EpiBf16 E{P, IN_CD, 0, 0, (bf16*)(c.ws + WS_QKV), QKV_STRIDE, 1.0f / W8_SCALE, NOST}; pg8::gemm_phase<pg8::EpiBf16, pg8::Order, MK_ALIGN, MK_SP2, true, true>(c.lds, g, S, E, c.tid); } } SEAM(9);
            PH(10) { for (int rp2 = 0; rp2 < (MK_REPEAT == 100 ? 2 : 1); ++rp2) for (int u = c.bid; u < 256; u += c.G) conv_unit(c, u); for (int rp2 = 0; rp2 < (MK_REPEAT == 101 ? 2 : 1); ++rp2) p_dilated(c); } SEAM(10);
            PH(11) { p_merge(c); } SEAM(11);
            PH(12) { pg8::Gemm g{YC, (const bf16*)(c.ws + WS_WOUT1), M, DM, DM}; pg8::Order S; S.init(M, DM, c.G, c.bid, 0);
                pg8::EpiResidB E{XRES, XRES, DM, 0}; pg8::gemm_phase<pg8::EpiResidB, pg8::Order, MK_ALIGN, MK_SP2>(c.lds, g, S, E, c.tid); } SEAM(12);
        }
        const int pr = layer == 0 ? 4 : 13;
        PH(pr) { p_router(c, layer); } SEAM(pr);
        PH(pr + 1) { for (int u = c.bid; u < 128; u += c.G) topk_unit(c, u); } SEAM(pr + 1);
        PH(pr + 2) { if (layer == 0) { conv_job_half(c, 2, 0); conv_job_half(c, 3, 0); conv_job_half(c, 6, 0); } __syncthreads();
            pg8::Gemm g{(const bf16*)(c.ws + WS_H8), (const bf16*)(c.ws + WS_WGU + (size_t)layer * 128 * MiB), MOE_ROWS, 4096, DM};     pg8::Order S; S.init(MOE_ROWS, 4096, c.G, c.bid, 1);
            { LAS int* tab = (LAS int*)(c.lds + RING_BYTES); S.tab = tab; const int* IDX = (const int*)(c.ws + WS_IDX); pg8::Unit uu;
#pragma unroll 1
                for (int k = c.wave; k < 15 && S.next(k, uu); k += NWAVES) {
                    typedef int i32x4 __attribute__((ext_vector_type(4))); const i32x4 v = *(const i32x4*)(IDX + uu.pm * 256 + 4 * c.lane); *(LAS i32x4*)(tab + k * 256 + 4 * c.lane) = v; }
                __syncthreads(); }
            pg8::EpiSwiglu E{c.ws + WS_HID, DE, 1.0f / W8_SCALE, NOST};
#if MK_PROBE_NOSTORE >= 4
            if (hi - lo == 1) pg8::gemm_phase<pg8::EpiSwiglu, pg8::Order, MK_ALIGN, MK_SP2, true, true, MK_PROBE_NOSTORE>(c.lds, g, S, E, c.tid); else
#endif
            pg8::gemm_phase<pg8::EpiSwiglu, pg8::Order, MK_ALIGN, MK_SP2, true, true>(c.lds, g, S, E, c.tid); if (layer == 0) { conv_job_half(c, 2, 1); conv_job_half(c, 3, 1); conv_job_half(c, 6, 1); } } SEAM(pr + 2);
        PH(pr + 3) { if (layer == 0) conv_job_half(c, 7, 0); __syncthreads(); pg8::Gemm g{(const bf16*)(c.ws + WS_HID), (const bf16*)(c.ws + WS_WDN + (size_t)layer * 64 * MiB), MOE_ROWS, DM, DE};   pg8::Order S; S.init(MOE_ROWS, DM, c.G, c.bid, 1);
            { LAS int* tab = (LAS int*)(c.lds + RING_BYTES); S.tab = tab; pg8::Unit uu;
#pragma unroll 1
                for (int k = 0; k < 15 && S.next(k, uu); ++k) if (c.tid < 256) tab[k * 256 + c.tid] = uu.pm * 256 + c.tid;
                __syncthreads(); }
            pg8::EpiDown E{c.ws + WS_YE, DM, (const float*)(c.ws + WS_GATE), YE_SCALE / W8_SCALE, NOST}; pg8::gemm_phase<pg8::EpiDown, pg8::Order, MK_ALIGN, MK_SP2, true, true>(c.lds, g, S, E, c.tid); if (layer == 0) conv_job_half(c, 7, 1); } SEAM(pr + 3);
        (void)pb;
    }
    PH(17) { p_combine<1>(c, c.norm_final); }
#undef IN
#undef H
#undef P
#undef YC
#undef XRES
#undef PH
#undef INR
#undef SEAM
}

extern "C" void kernel_launch(void* const* d_in, const int* in_sizes, int n_in, void* d_out, int out_size, void* d_ws, size_t ws_size, hipStream_t stream) {
    static int grid = 0;
    if (grid == 0) {
        if (n_in != 17 || out_size != M * DM || ws_size < WS_END) { fprintf(stderr, "kernel_launch: unexpected shapes (n_in %d out %d ws %zu)\n", n_in, out_size, ws_size); grid = -1; return; }
        int dev = 0, cus = 0, per_cu = 0;
        if (hipGetDevice(&dev) != hipSuccess || hipDeviceGetAttribute(&cus, hipDeviceAttributeMultiprocessorCount, dev) != hipSuccess) { grid = -1; return; }
        if (hipFuncSetAttribute((const void*)mk_fwd, hipFuncAttributeMaxDynamicSharedMemorySize, LDS_BYTES) != hipSuccess) { fprintf(stderr, "kernel_launch: hipFuncSetAttribute failed\n"); grid = -1; return; }
        if (hipOccupancyMaxActiveBlocksPerMultiprocessor(&per_cu, (const void*)mk_fwd, NTHR, LDS_BYTES) != hipSuccess || per_cu < 1) { fprintf(stderr, "kernel_launch: occupancy query says %d\n", per_cu); (void)hipGetLastError(); }
        grid = cus;
    }
    if (grid < 0) return;
    (void)hipMemsetAsync((char*)d_ws + WS_CTL, 0, CTL_ZERO_BYTES, stream);
    Args a{};
    for (int i = 0; i < 17; ++i) a.in[i] = (const float*)d_in[i];
    a.out = (float*)d_out; a.ws = (unsigned char*)d_ws;
#if MK_N_LAUNCHES == 1
    a.ph_lo = 0; a.ph_hi = NPH;
    hipLaunchKernelGGL(mk_fwd, dim3(grid), dim3(NTHR), LDS_BYTES, stream, a);
#if MK_PROBE_PHASE >= 0
    a.ph_lo = MK_PROBE_PHASE; a.ph_hi = MK_PROBE_PHASE + 1;
    hipLaunchKernelGGL(mk_fwd, dim3(grid), dim3(NTHR), LDS_BYTES, stream, a);
#endif
#else
    for (int p = 0; p < NPH; ++p) { a.ph_lo = p; a.ph_hi = p + 1; hipLaunchKernelGGL(mk_fwd, dim3(grid), dim3(NTHR), LDS_BYTES, stream, a); }
#endif
}
```

```cpp
#include <hip/hip_runtime.h>
#include <cstdio>
#include <cstdint>
#ifndef MK_N_LAUNCHES
#define MK_N_LAUNCHES 1
#endif
#ifndef MK_REPEAT
#define MK_REPEAT (-1)
#endif
#ifndef MK_DIL_REPS
#define MK_DIL_REPS 1
#endif
#ifndef MK_CONV_PROBE
#define MK_CONV_PROBE 0
#endif
#ifndef MK_SP2
#define MK_SP2 true
#endif
#ifndef MK_ALIGN
#define MK_ALIGN true
#endif
#ifndef MK_EARLY_INV
#define MK_EARLY_INV 1
#endif
#ifndef MK_DOUBLE_BAR
#define MK_DOUBLE_BAR 0
#endif
#ifndef MK_PROBE_PHASE
#define MK_PROBE_PHASE (-1)
#endif
#ifndef MK_PROBE_NOSTORE
#define MK_PROBE_NOSTORE 0
#endif
#ifndef MK_CONV_SKEW
#define MK_CONV_SKEW 0
#endif
namespace pg8 {
#define PG8_LAS __attribute__((address_space(3)))
typedef unsigned short bf16_t;
typedef short bf16x8 __attribute__((ext_vector_type(8)));
typedef float f32x4 __attribute__((ext_vector_type(4)));
typedef int i32x8 __attribute__((ext_vector_type(8)));
typedef short bf16x16 __attribute__((ext_vector_type(16)));
typedef unsigned u32x4 __attribute__((ext_vector_type(4)));
constexpr int BM = 256, BK = 64, HALF = 128, HTB = HALF * BK * 2  , STAGE_BYTES = 8 * HTB, NXCD = 8, WGM = 8;

__host__ __device__ __forceinline__ int lds_byte(int r, int c) { const int st = (r >> 4) * 2 + (c >> 5), rr = r & 15, cc = c & 31, ob = rr * 64 + cc * 2; return st * 1024 + (ob ^ (((ob >> 9) & 1) << 5)); }
__host__ __device__ __forceinline__ void stage_rc(int b, int& R, int& C) { const int st = b / 1024, sb = b % 1024, swz = sb ^ (((sb >> 9) & 1) << 5); R = (st >> 1) * 16 + swz / 64; C = (st & 1) * 32 + (swz % 64) / 2; }
__host__ __device__ __forceinline__ int perm32(int rho) { const int n = rho >> 4, i = rho & 15; return 8 * (i >> 2) + 4 * n + (i & 3); }


struct Unit { int pm, pn, pb; };
struct Gemm { const bf16_t* A; const bf16_t* Bt; int M, N, K; };

struct Order {
    int nM, nN, nwg, G, c, moe; const PG8_LAS int* tab;
    __host__ __device__ __forceinline__ void init(int M, int N, int G_, int c_, int moe_) { nM = M / BM; nN = N / BM; nwg = nM * nN; G = G_; c = c_; moe = moe_; tab = nullptr; }
    __host__ __device__ __forceinline__ bool next(int i, Unit& u) const {
        const long L = (long)i * G + c; if (L >= nwg) return false;
        int wgid = (int)L; { const int q = nwg / NXCD, r = nwg % NXCD, xcd = wgid % NXCD, off = wgid / NXCD; wgid = (xcd < r ? xcd * (q + 1) : r * (q + 1) + (xcd - r) * q) + off; }
        const int nig = WGM * nN, gid = wgid / nig, fm = gid * WGM, gsz = (nM - fm) < WGM ? (nM - fm) : WGM;
        u.pm = fm + ((wgid % nig) % gsz); u.pn = (wgid % nig) / gsz; u.pb = moe ? (u.pm >> 3) * nN + u.pn : u.pn; return true;
    }
    __device__ __forceinline__ void a_ready(const Unit&) const {}
    __device__ __forceinline__ void done(const Unit&) const {}
};

typedef float f32x2_t __attribute__((ext_vector_type(2))); typedef __bf16 bf16x2_t __attribute__((ext_vector_type(2)));
__device__ __forceinline__ unsigned cvt_pk_bf16(float lo, float hi) { f32x2_t v = {lo, hi}; bf16x2_t b = __builtin_convertvector(v, bf16x2_t); return __builtin_bit_cast(unsigned, b); }
__device__ __forceinline__ float gelu_tanh(float x) {
    const float t = x * (1.5957691216057308f + 0.07135481282636639f * x * x);
    return x * __builtin_amdgcn_rcpf(1.0f + __builtin_amdgcn_exp2f(-1.4426950408889634f * t));
}
__device__ __forceinline__ float silu_f(float x) { return x * __builtin_amdgcn_rcpf(1.0f + __builtin_amdgcn_exp2f(-1.4426950408889634f * x)); }

#if MK_PROBE_NOSTORE
#define PG8_ST(x) do { if (nost != 1) { x; } } while (0)
#else
#define PG8_ST(x) do { x; } while (0)
#endif
struct EpiBf16 {
    static constexpr bool PERM = true, AFTER_DRAIN = false;
    bf16_t* O; int ldc; int gelu_tiles; int qkv_tile0; bf16_t* QKV; size_t qkv_stride; float sc; int nost;
    __device__ __forceinline__ void operator()(const f32x4 (&acc)[2][2][4][2], const Unit& u, int wr, int wc, int fr, int fq) const {
        const int row0 = u.pm * BM + wr * 64 + fr, col0 = u.pn * BM + wc * 32 + 8 * fq; const bool act = u.pn < gelu_tiles, hm = u.pn >= qkv_tile0;
        const int t = u.pn - qkv_tile0, which = t >> 2, hp = t & 3;
#pragma unroll
        for (int ai = 0; ai < 2; ++ai)
#pragma unroll
            for (int m = 0; m < 4; ++m) { const int row = row0 + ai * HALF + m * 16;
                bf16_t* rowp = O + (size_t)row * ldc + col0; size_t bjstep = HALF;
                if (hm) { rowp = QKV + (size_t)which * qkv_stride + ((size_t)((row >> 11) * 8 + 2 * hp) * 2048 + (row & 2047)) * 128 + wc * 32 + 8 * fq; bjstep = (size_t)2048 * 128; }
#pragma unroll
                for (int bj = 0; bj < 2; ++bj) { f32x4 v0 = acc[ai][bj][m][0] * sc, v1 = acc[ai][bj][m][1] * sc;
                    if (act) {
#pragma unroll
                        for (int j = 0; j < 4; ++j) { v0[j] = gelu_tanh(v0[j]); v1[j] = gelu_tanh(v1[j]); } }
                    u32x4 w; w.x = cvt_pk_bf16(v0[0], v0[1]); w.y = cvt_pk_bf16(v0[2], v0[3]); w.z = cvt_pk_bf16(v1[0], v1[1]); w.w = cvt_pk_bf16(v1[2], v1[3]);
                    PG8_ST(*(u32x4*)(rowp + bj * bjstep) = w); } }
    }
};
struct EpiResid {
    static constexpr bool PERM = false, AFTER_DRAIN = false;
    const float* base; float* out; int ldc;
    __device__ __forceinline__ void operator()(const f32x4 (&acc)[2][2][4][2], const Unit& u, int wr, int wc, int fr, int fq) const {
        const int row0 = u.pm * BM + wr * 64 + fr, col0 = u.pn * BM + wc * 32 + 4 * fq;
#pragma unroll
        for (int ai = 0; ai < 2; ++ai)
#pragma unroll
            for (int m = 0; m < 4; ++m) { const size_t off = (size_t)(row0 + ai * HALF + m * 16) * ldc + col0;
                f32x4 bs[2][2];
#pragma unroll
                for (int bj = 0; bj < 2; ++bj)
#pragma unroll
                    for (int n = 0; n < 2; ++n) bs[bj][n] = *(const f32x4*)(base + off + bj * HALF + n * 16);
#pragma unroll
                for (int bj = 0; bj < 2; ++bj)
#pragma unroll
                    for (int n = 0; n < 2; ++n) *(f32x4*)(out + off + bj * HALF + n * 16) = bs[bj][n] + acc[ai][bj][m][n];
                asm volatile("" ::: "memory"); }
    }
};
struct EpiResidB {
    static constexpr bool PERM = true, AFTER_DRAIN = false;
    const void* base; bf16_t* out; int ldc; int base_f32; int nost = 0;
    __device__ __forceinline__ void operator()(const f32x4 (&acc)[2][2][4][2], const Unit& u, int wr, int wc, int fr, int fq) const {
        const int row0 = u.pm * BM + wr * 64 + fr, col0 = u.pn * BM + wc * 32 + 8 * fq;
#pragma unroll
        for (int ai = 0; ai < 2; ++ai)
#pragma unroll
            for (int m = 0; m < 4; ++m) { const size_t off = (size_t)(row0 + ai * HALF + m * 16) * ldc + col0;
                f32x4 b0[2], b1[2];
                if (base_f32) {
#pragma unroll
                    for (int bj = 0; bj < 2; ++bj) { b0[bj] = *(const f32x4*)((const float*)base + off + bj * HALF); b1[bj] = *(const f32x4*)((const float*)base + off + bj * HALF + 4); }
                } else {
#pragma unroll
                    for (int bj = 0; bj < 2; ++bj) { const u32x4 w = *(const u32x4*)((const bf16_t*)base + off + bj * HALF);
                        b0[bj] = (f32x4){__uint_as_float(w.x << 16), __uint_as_float(w.x & 0xffff0000u), __uint_as_float(w.y << 16), __uint_as_float(w.y & 0xffff0000u)};
                        b1[bj] = (f32x4){__uint_as_float(w.z << 16), __uint_as_float(w.z & 0xffff0000u), __uint_as_float(w.w << 16), __uint_as_float(w.w & 0xffff0000u)}; }
                }
#pragma unroll
                for (int bj = 0; bj < 2; ++bj) { const f32x4 v0 = b0[bj] + acc[ai][bj][m][0], v1 = b1[bj] + acc[ai][bj][m][1];
                    u32x4 w; w.x = cvt_pk_bf16(v0[0], v0[1]); w.y = cvt_pk_bf16(v0[2], v0[3]); w.z = cvt_pk_bf16(v1[0], v1[1]); w.w = cvt_pk_bf16(v1[2], v1[3]);
                    *(u32x4*)(out + off + bj * HALF) = w; }
                asm volatile("" ::: "memory"); }
    }
};
struct EpiSwiglu {
    static constexpr bool PERM = true, AFTER_DRAIN = false;
    unsigned char* O; int ldc; float sc; int nost;
    __device__ __forceinline__ void operator()(const f32x4 (&acc)[2][2][4][2], const Unit& u, int wr, int wc, int fr, int fq) const {
        const int row0 = u.pm * BM + wr * 64 + fr, col0 = u.pn * HALF + wc * 32 + 8 * fq;
#pragma unroll
        for (int ai = 0; ai < 2; ++ai)
#pragma unroll
            for (int m = 0; m < 4; ++m) { unsigned char* rowp = O + (size_t)(row0 + ai * HALF + m * 16) * ldc + col0;
                f32x4 h0, h1;
#pragma unroll
                for (int j = 0; j < 4; ++j) { h0[j] = __builtin_amdgcn_fmed3f(silu_f(acc[ai][0][m][0][j] * sc) * (acc[ai][1][m][0][j] * sc), -448.f, 448.f); h1[j] = __builtin_amdgcn_fmed3f(silu_f(acc[ai][0][m][1][j] * sc) * (acc[ai][1][m][1][j] * sc), -448.f, 448.f); }
                int p0 = 0, p1 = 0;
                p0 = __builtin_amdgcn_cvt_pk_fp8_f32(h0[0], h0[1], p0, false); p0 = __builtin_amdgcn_cvt_pk_fp8_f32(h0[2], h0[3], p0, true);
                p1 = __builtin_amdgcn_cvt_pk_fp8_f32(h1[0], h1[1], p1, false); p1 = __builtin_amdgcn_cvt_pk_fp8_f32(h1[2], h1[3], p1, true);
                typedef unsigned u32x2v __attribute__((ext_vector_type(2))); u32x2v w; w.x = (unsigned)p0; w.y = (unsigned)p1;
                PG8_ST(*(u32x2v*)rowp = w); }
    }
};
struct EpiDown {
    static constexpr bool PERM = true, AFTER_DRAIN = false;
    unsigned char* O; int ldc; const float* gate; float sc; int nost;
    __device__ __forceinline__ void operator()(const f32x4 (&acc)[2][2][4][2], const Unit& u, int wr, int wc, int fr, int fq) const {
        const int row0 = u.pm * BM + wr * 64 + fr, col0 = u.pn * BM + wc * 32 + 8 * fq;
#pragma unroll
        for (int ai = 0; ai < 2; ++ai)
#pragma unroll
            for (int m = 0; m < 4; ++m) { const int row = row0 + ai * HALF + m * 16; const float gt = gate[row] * sc; unsigned char* rowp = O + (size_t)row * ldc + col0;
#pragma unroll
                for (int bj = 0; bj < 2; ++bj) { f32x4 v0 = acc[ai][bj][m][0] * gt, v1 = acc[ai][bj][m][1] * gt;
#pragma unroll
                    for (int j = 0; j < 4; ++j) { v0[j] = __builtin_amdgcn_fmed3f(v0[j], -448.f, 448.f); v1[j] = __builtin_amdgcn_fmed3f(v1[j], -448.f, 448.f); }
                    int p0 = 0, p1 = 0;
                    p0 = __builtin_amdgcn_cvt_pk_fp8_f32(v0[0], v0[1], p0, false); p0 = __builtin_amdgcn_cvt_pk_fp8_f32(v0[2], v0[3], p0, true);
                    p1 = __builtin_amdgcn_cvt_pk_fp8_f32(v1[0], v1[1], p1, false); p1 = __builtin_amdgcn_cvt_pk_fp8_f32(v1[2], v1[3], p1, true);
                    typedef unsigned u32x2v __attribute__((ext_vector_type(2))); u32x2v w; w.x = (unsigned)p0; w.y = (unsigned)p1;
                    PG8_ST(*(u32x2v*)(rowp + bj * HALF) = w); }
                asm volatile("" ::: "memory"); }
    }
};

template <class Epi, class Sched, bool ALIGN_EPI = false, bool SP2 = false, bool GATHER = false, bool FP8 = false, int PV = 0>
__device__ __forceinline__ void gemm_phase(PG8_LAS unsigned char* lds, const Gemm g, const Sched& S, const Epi& E, int tid_) {
    asm volatile("" : "+v"(tid_));
    const int tid = tid_, wid = __builtin_amdgcn_readfirstlane(tid >> 6), lane = tid & 63, wr = wid >> 2, wc = wid & 3, fr = lane & 15, fq = lane >> 4;
    constexpr int ES = FP8 ? 1 : 2;
#if MK_PROBE_NOSTORE
    const int K = g.K, nt = (K * ES / (BK * 2)) >> (E.nost == 3 ? 1 : 0);
#else
    const int K = g.K, nt = K * ES / (BK * 2);
#endif
    unsigned voffA[2], voffB[2];
#pragma unroll
    for (int i = 0; i < 2; ++i) { int R, C; stage_rc(tid * 16 + i * 8192, R, C); const int Rb = Epi::PERM ? ((R & ~31) + perm32(R & 31)) : R;
        voffA[i] = (unsigned)(R * K * ES + C * 2); voffB[i] = (unsigned)(Rb * K * ES + C * 2); }
    static_assert(!GATHER || SP2, "the gathered A operand is wired into the SP2 loop only");
    unsigned gofA[2][2] = {{0u, 0u}, {0u, 0u}};
#define PG8_GOFF(dst, ord) do { _Pragma("unroll") for (int _h = 0; _h < 2; ++_h) _Pragma("unroll") for (int _i = 0; _i < 2; ++_i) { int _R, _C; stage_rc(tid * 16 + _i * 8192, _R, _C); \
        dst[_h][_i] = (unsigned)(S.tab[(ord) * 256 + _h * 128 + _R] * K * ES + _C * 2); } } while (0)
#define PG8_STAGE_A(bufoff, gbase, h) do { if constexpr (GATHER) PG8_STAGE(bufoff, gbase, gofA[h]); else PG8_STAGE(bufoff, (gbase) + (h) * hstep, voffA); } while (0)
    const size_t kstep = (size_t)(BK * 2);
    const size_t hstep = (size_t)HALF * K * ES;
    const size_t tstep = 2 * hstep;
    const unsigned ldsw = (unsigned)wid * 1024u;
    const int aoff = lds_byte(wr * 64 + fr, fq * 8), boff = lds_byte(wc * 32 + fr, fq * 8);
#define PG8_SA(b, h) (((b) * 2 + (h)) * HTB)
#define PG8_SB(b, h) ((4 + (b) * 2 + (h)) * HTB)
#if MK_PROBE_NOSTORE
#define PG8_PV(v) (PV != (v))
#else
#define PG8_PV(v) true
#endif
#define PG8_STAGE(bufoff, gbase, voff) do { if constexpr (PG8_PV(4)) _Pragma("unroll") for (int _i = 0; _i < 2; ++_i) \
        __builtin_amdgcn_global_load_lds((const unsigned*)((const char*)(gbase) + (voff)[_i]), (PG8_LAS unsigned*)(lds + (bufoff) + ldsw + _i * 8192), 16, 0, 0); } while (0)
#define PG8_LDA(dst, b, h) do { if constexpr (PG8_PV(5)) _Pragma("unroll") for (int m = 0; m < 4; ++m) _Pragma("unroll") for (int k = 0; k < 2; ++k) dst[m][k] = *(const PG8_LAS bf16x8*)(lds + PG8_SA(b, h) + aoff + m * 2048 + k * 1024); } while (0)
#define PG8_LDB(dst, b, h) do { if constexpr (PG8_PV(5)) _Pragma("unroll") for (int n = 0; n < 2; ++n) _Pragma("unroll") for (int k = 0; k < 2; ++k) dst[n][k] = *(const PG8_LAS bf16x8*)(lds + PG8_SB(b, h) + boff + n * 2048 + k * 1024); } while (0)
#define PG8_MMA(ai, bj, At, Bt) do { __builtin_amdgcn_s_setprio(1); if constexpr (PV == 6) { _Pragma("unroll") for (int ks = 0; ks < 2; ++ks) _Pragma("unroll") for (int mp = 0; mp < 2; ++mp) { \
            const i32x8 _a = __builtin_bit_cast(i32x8, __builtin_shufflevector(Bt[ks][0], Bt[ks][1], 0, 1, 2, 3, 4, 5, 6, 7, 8, 9, 10, 11, 12, 13, 14, 15)); \
            const i32x8 _b = __builtin_bit_cast(i32x8, __builtin_shufflevector(At[2 * mp + ks][0], At[2 * mp + ks][1], 0, 1, 2, 3, 4, 5, 6, 7, 8, 9, 10, 11, 12, 13, 14, 15)); \
            acc16[ai][bj][mp] = __builtin_amdgcn_mfma_scale_f32_32x32x64_f8f6f4(_a, _b, acc16[ai][bj][mp], 0, 0, 0, 0x7f7f7f7f, 0, 0x7f7f7f7f); } } \
        else if constexpr (FP8) { _Pragma("unroll") for (int m = 0; m < 4; ++m) _Pragma("unroll") for (int n = 0; n < 2; ++n) { \
            const i32x8 _a = __builtin_bit_cast(i32x8, __builtin_shufflevector(Bt[n][0], Bt[n][1], 0, 1, 2, 3, 4, 5, 6, 7, 8, 9, 10, 11, 12, 13, 14, 15)); \
            const i32x8 _b = __builtin_bit_cast(i32x8, __builtin_shufflevector(At[m][0], At[m][1], 0, 1, 2, 3, 4, 5, 6, 7, 8, 9, 10, 11, 12, 13, 14, 15)); \
            acc[ai][bj][m][n] = __builtin_amdgcn_mfma_scale_f32_16x16x128_f8f6f4(_a, _b, acc[ai][bj][m][n], 0, 0, 0, 0x7f7f7f7f, 0, 0x7f7f7f7f); } } \
        else { _Pragma("unroll") for (int m = 0; m < 4; ++m) _Pragma("unroll") for (int n = 0; n < 2; ++n) _Pragma("unroll") for (int k = 0; k < 2; ++k) \
        acc[ai][bj][m][n] = __builtin_amdgcn_mfma_f32_16x16x32_bf16(Bt[n][k], At[m][k], acc[ai][bj][m][n], 0, 0, 0); } __builtin_amdgcn_s_setprio(0); } while (0)
#define PG8_WAIT_V(n) asm volatile("s_waitcnt vmcnt(" #n ")" ::: "memory")
#define PG8_WAIT_L(n) asm volatile("s_waitcnt lgkmcnt(" #n ")" ::: "memory")
#define PG8_BAR __builtin_amdgcn_s_barrier()
#define PG8_SCHED __builtin_amdgcn_sched_barrier(0)
    Unit cur, nxt; int ui = 0;
    if (!S.next(0, cur)) return;
    f32x4 acc[2][2][4][2];
#pragma unroll
    for (int a = 0; a < 2; ++a)
#pragma unroll
        for (int b = 0; b < 2; ++b)
#pragma unroll
            for (int m = 0; m < 4; ++m)
#pragma unroll
                for (int n = 0; n < 2; ++n) acc[a][b][m][n] = (f32x4){0.f, 0.f, 0.f, 0.f};
    bf16x8 At[4][2], B0[2][2], B1[2][2];
    typedef float f32x16_t __attribute__((ext_vector_type(16)));
    f32x16_t acc16[2][2][2];
    if constexpr (PV == 6) {
#pragma unroll
        for (int a = 0; a < 2; ++a)
#pragma unroll
            for (int b = 0; b < 2; ++b)
#pragma unroll
                for (int m = 0; m < 2; ++m)
#pragma unroll
                    for (int j = 0; j < 16; ++j) acc16[a][b][m][j] = 0.f; }
    const char* cA = (const char*)g.A + (GATHER ? (size_t)0 : (size_t)cur.pm * tstep); const char* cB = (const char*)g.Bt + (size_t)cur.pb * tstep;
    S.a_ready(cur);
    if constexpr (GATHER) PG8_GOFF(gofA, 0);
    if constexpr (SP2) {
        PG8_STAGE(PG8_SB(0, 0), cB, voffB); PG8_STAGE(PG8_SB(0, 1), cB + hstep, voffB); PG8_STAGE_A(PG8_SA(0, 0), cA, 0); PG8_STAGE_A(PG8_SA(0, 1), cA, 1);
        if (wr == 1) PG8_BAR;
        PG8_WAIT_V(2); PG8_BAR;
        PG8_STAGE(PG8_SB(1, 0), cB + kstep, voffB); PG8_STAGE_A(PG8_SA(1, 0), cA + kstep, 0); PG8_STAGE(PG8_SB(1, 1), cB + hstep + kstep, voffB);
        PG8_WAIT_V(6); PG8_BAR;
    } else {
        PG8_STAGE(PG8_SB(0, 0), cB, voffB); PG8_STAGE(PG8_SA(0, 0), cA, voffA); PG8_STAGE(PG8_SB(0, 1), cB + hstep, voffB); PG8_STAGE(PG8_SA(0, 1), cA + hstep, voffA);
        if (wr == 1) PG8_BAR;
        PG8_WAIT_V(4); PG8_BAR;
        PG8_STAGE(PG8_SB(1, 0), cB + kstep, voffB); PG8_STAGE(PG8_SA(1, 0), cA + kstep, voffA); PG8_STAGE(PG8_SB(1, 1), cB + hstep + kstep, voffB);
        PG8_WAIT_V(6); PG8_BAR;
    }
    for (;;) {
        const bool has_next = S.next(ui + 1, nxt);
        const char* nA = (has_next && !GATHER) ? (const char*)g.A + (size_t)nxt.pm * tstep : cA; const char* nB = has_next ? (const char*)g.Bt + (size_t)nxt.pb * tstep : cB;
        for (int t = 0; t < nt; t += 2) {
            const bool last = (t == nt - 2);
            const char* a1 = cA + (size_t)(t + 1) * kstep;
            const char* a2 = last ? nA : cA + (size_t)(t + 2) * kstep; const char* b2 = last ? nB : cB + (size_t)(t + 2) * kstep;
            const char* a3 = a2 + kstep; const char* b3 = b2 + kstep;
            if (last && has_next) S.a_ready(nxt);
            if constexpr (SP2) {
            PG8_LDB(B0, 0, 0); PG8_LDB(B1, 0, 1); PG8_SCHED; PG8_LDA(At, 0, 0); PG8_STAGE_A(PG8_SA(1, 1), a1, 1);
            if constexpr (GATHER) { if (last && has_next) PG8_GOFF(gofA, ui + 1); }
            PG8_WAIT_V(8); PG8_WAIT_L(0); PG8_BAR; PG8_MMA(0, 0, At, B0); PG8_MMA(0, 1, At, B1); PG8_BAR; PG8_SCHED;
            PG8_LDA(At, 0, 1); PG8_STAGE(PG8_SB(0, 0), b2, voffB); PG8_STAGE(PG8_SB(0, 1), b2 + hstep, voffB); PG8_STAGE_A(PG8_SA(0, 0), a2, 0);
            PG8_WAIT_V(8); PG8_WAIT_L(0); PG8_BAR; PG8_MMA(1, 0, At, B0); PG8_MMA(1, 1, At, B1); PG8_BAR; PG8_SCHED;
            PG8_LDB(B0, 1, 0); PG8_LDB(B1, 1, 1); PG8_SCHED; PG8_LDA(At, 1, 0); PG8_STAGE_A(PG8_SA(0, 1), a2, 1);
            PG8_WAIT_V(8); PG8_WAIT_L(0); PG8_BAR; PG8_MMA(0, 0, At, B0); PG8_MMA(0, 1, At, B1); PG8_BAR; PG8_SCHED;
            PG8_LDA(At, 1, 1); PG8_STAGE(PG8_SB(1, 0), b3, voffB); PG8_STAGE(PG8_SB(1, 1), b3 + hstep, voffB); PG8_STAGE_A(PG8_SA(1, 0), a3, 0);
            PG8_WAIT_V(8); PG8_WAIT_L(0); PG8_BAR; PG8_MMA(1, 0, At, B0); PG8_MMA(1, 1, At, B1); PG8_BAR; PG8_SCHED;
            } else {
            PG8_LDB(B0, 0, 0); PG8_SCHED; PG8_LDA(At, 0, 0); PG8_STAGE(PG8_SA(1, 1), a1 + hstep, voffA);
            PG8_WAIT_L(8); PG8_BAR; PG8_WAIT_L(0); PG8_MMA(0, 0, At, B0); PG8_BAR; PG8_SCHED;
            PG8_LDB(B1, 0, 1); PG8_STAGE(PG8_SB(0, 0), b2, voffB);
            PG8_BAR; PG8_WAIT_L(0); PG8_MMA(0, 1, At, B1); PG8_BAR;
            PG8_LDA(At, 0, 1); PG8_STAGE(PG8_SA(0, 0), a2, voffA);
            PG8_BAR; PG8_WAIT_L(0); PG8_MMA(1, 0, At, B0); PG8_BAR; PG8_SCHED;
            PG8_STAGE(PG8_SB(0, 1), b2 + hstep, voffB);
            PG8_WAIT_V(6); PG8_BAR; PG8_MMA(1, 1, At, B1); PG8_BAR;
            PG8_LDB(B0, 1, 0); PG8_SCHED; PG8_LDA(At, 1, 0); PG8_STAGE(PG8_SA(0, 1), a2 + hstep, voffA);
            PG8_WAIT_L(8); PG8_BAR; PG8_WAIT_L(0); PG8_MMA(0, 0, At, B0); PG8_BAR; PG8_SCHED;
            PG8_LDB(B1, 1, 1); PG8_STAGE(PG8_SB(1, 0), b3, voffB);
            PG8_BAR; PG8_WAIT_L(0); PG8_MMA(0, 1, At, B1); PG8_BAR;
            PG8_LDA(At, 1, 1); PG8_STAGE(PG8_SA(1, 0), a3, voffA);
            PG8_BAR; PG8_WAIT_L(0); PG8_MMA(1, 0, At, B0); PG8_BAR; PG8_SCHED;
            PG8_STAGE(PG8_SB(1, 1), b3 + hstep, voffB);
            PG8_WAIT_V(6); PG8_BAR; PG8_MMA(1, 1, At, B1); PG8_BAR;
            }
        }
        if constexpr (ALIGN_EPI) { if (wr == 0) PG8_BAR; }
        if constexpr (PV == 6) {
#pragma unroll
            for (int a = 0; a < 2; ++a)
#pragma unroll
                for (int b = 0; b < 2; ++b)
#pragma unroll
                    for (int m = 0; m < 2; ++m) asm volatile("" :: "v"(acc16[a][b][m])); }
        else
#if MK_PROBE_NOSTORE
        if (E.nost != 2)
#endif
        if constexpr (!Epi::AFTER_DRAIN) { E(acc, cur, wr, wc, fr, fq); S.done(cur); }
        if (!has_next) break;
#pragma unroll
        for (int a = 0; a < 2; ++a)
#pragma unroll
            for (int b = 0; b < 2; ++b)
#pragma unroll
                for (int m = 0; m < 4; ++m)
#pragma unroll
                    for (int n = 0; n < 2; ++n) acc[a][b][m][n] = (f32x4){0.f, 0.f, 0.f, 0.f};
        cur = nxt; cA = nA; cB = nB; ++ui;
        if constexpr (ALIGN_EPI) { if (wr == 1) PG8_BAR; }
    }
    PG8_WAIT_V(0);
    if constexpr (!ALIGN_EPI) { if (wr == 0) PG8_BAR; }
    PG8_BAR;
    if constexpr (Epi::AFTER_DRAIN) { E.fused(acc, cur, wr, wc, fr, fq, lds, wid, lane); S.done(cur); }
#undef PG8_SA
#undef PG8_GOFF
#undef PG8_STAGE_A
#undef PG8_SB
#undef PG8_STAGE
#undef PG8_LDA
#undef PG8_LDB
#undef PG8_MMA
#undef PG8_WAIT_V
#undef PG8_WAIT_L
#undef PG8_BAR
#undef PG8_SCHED
}
}

#ifndef PG8_SP2
#define PG8_SP2 true
#endif
#ifndef PG8_ALIGN
#define PG8_ALIGN true
#endif

constexpr int BATCH = 8, SEQ = 2048, DM = 2048, M = BATCH * SEQ;
constexpr int NE = 16, CAP = 256, DE = 2048, MOE_ROWS = BATCH * NE * CAP;
constexpr int IN_AB = 5120, IN_CD = 6144;
constexpr float RMS_EPS = 1e-6f, LN_EPS = 1e-5f;
constexpr float LOG2E = 1.4426950408889634f, LN2 = 0.6931471805599453f;
constexpr float ATT_SCALE = 0.08838834764831845f;
constexpr int NWAVES = 8, NTHR = 512;

constexpr size_t MiB = 1ull << 20;
constexpr size_t WS_CTL = 0, CTL_ZERO_BYTES = 1 * MiB;
constexpr size_t WS_AFF = 1 * MiB;
constexpr size_t WS_SEL = 2 * MiB;
constexpr size_t WS_GATE = 3 * MiB;
constexpr size_t WS_IDX = 3 * MiB + 512 * 1024;
constexpr size_t WS_LSE = 4 * MiB;
constexpr size_t WS_WIN0 = 8 * MiB, WS_WOUT0 = 28 * MiB, WS_WIN1 = 36 * MiB, WS_WOUT1 = 60 * MiB;
constexpr size_t WS_WGU = 68 * MiB;
constexpr size_t WS_WDN = 580 * MiB;
constexpr size_t WS_XRES = 836 * MiB;
constexpr size_t WS_H = 964 * MiB;
constexpr size_t WS_P = 1028 * MiB;
constexpr size_t WS_YCAT = 1220 * MiB;
constexpr size_t WS_OP = 1764 * MiB;
constexpr size_t OP_STRIDE = (size_t)16384 * 1024 + 4096 + 512;
constexpr size_t QKV_STRIDE = (size_t)64 * 2048 * 128 + 4096 + 512;
constexpr size_t WS_XE = 1380 * MiB;
constexpr size_t WS_QKV = WS_XE;
constexpr size_t WS_HID = 1508 * MiB;
constexpr size_t WS_YE = 1636 * MiB;
constexpr size_t WS_WIN8 = 1896 * MiB;
constexpr size_t WS_H8 = 1864 * MiB;
constexpr size_t WS_END = 1908 * MiB;
constexpr float YE_SCALE = 64.0f;
constexpr float W8_SCALE = 64.0f;

constexpr int RING_BYTES = 131072;
constexpr int LDSCTL_OFF = 147328, MISC_OFF = LDSCTL_OFF;
constexpr int LDS_BYTES = 147456;

#define GAS __attribute__((address_space(1)))
#define LAS __attribute__((address_space(3)))
typedef unsigned short bf16;
typedef unsigned u32x4 __attribute__((ext_vector_type(4)));
typedef unsigned u32x2 __attribute__((ext_vector_type(2)));
typedef float f32x4 __attribute__((ext_vector_type(4)));
typedef short bf16x8 __attribute__((ext_vector_type(8)));
typedef short s16x4 __attribute__((ext_vector_type(4)));
typedef GAS unsigned gu32;
#define RLX_AGENT __ATOMIC_RELAXED, __HIP_MEMORY_SCOPE_AGENT
#define LDS_WAIT() asm volatile("s_waitcnt lgkmcnt(0)" ::: "memory")
#define VM_WAIT() asm volatile("s_waitcnt vmcnt(0)" ::: "memory")
using pg8::cvt_pk_bf16;
__device__ __forceinline__ float bf_lo(unsigned w) { return __uint_as_float(w << 16); }
__device__ __forceinline__ float bf_hi(unsigned w) { return __uint_as_float(w & 0xffff0000u); }
__device__ __forceinline__ int lane_now() { int l; asm volatile("v_mbcnt_lo_u32_b32 %0, -1, 0\n\tv_mbcnt_hi_u32_b32 %0, -1, %0" : "=v"(l)); return l; }
__device__ __forceinline__ int shx(int v, int o, int lane) { return __builtin_amdgcn_ds_bpermute((lane ^ o) << 2, v); }
__device__ __forceinline__ unsigned shx(unsigned v, int o, int lane) { return (unsigned)__builtin_amdgcn_ds_bpermute((lane ^ o) << 2, (int)v); }
__device__ __forceinline__ float shx(float v, int o, int lane) { return __int_as_float(__builtin_amdgcn_ds_bpermute((lane ^ o) << 2, __float_as_int(v))); }
__device__ __forceinline__ unsigned shup(unsigned v, int o, int lane) { return (unsigned)__builtin_amdgcn_ds_bpermute((lane - o) << 2, (int)v); }
__device__ __forceinline__ float wave_sum(float v, int lane) {
#pragma unroll
    for (int o = 1; o < 64; o <<= 1) v += shx(v, o, lane);
    return v;
}
__device__ __forceinline__ s16x4 vtr(const LAS unsigned char* p) { return __builtin_bit_cast(s16x4, __builtin_amdgcn_ds_read_tr16_b64_v4i16((LAS s16x4*)p)); }

#define XB_TMO      128
#define XB_XCNT(j)  (256  + 64 * (j))
#define XB_XSUB(j)  (1280 + 64 * (j))
#define XB_XGEN(j)  (2304 + 64 * (j))
#define XB_TOP      3328
#define XB_TOPGEN   3392
#define XCD_BAR_WORDS 3456
#define XB_SPIN_CAP (1u << 18)

__device__ __forceinline__ unsigned xb_ld(unsigned* p)              { return __hip_atomic_load(p, __ATOMIC_RELAXED, __HIP_MEMORY_SCOPE_AGENT); }
__device__ __forceinline__ unsigned xb_add(unsigned* p, unsigned v) { return __hip_atomic_fetch_add(p, v, __ATOMIC_RELAXED, __HIP_MEMORY_SCOPE_AGENT); }
__device__ __forceinline__ unsigned xb_xcc_id() { return (unsigned)__builtin_amdgcn_s_getreg((3 << 11) | 20) & 0xFu; }
#define XB_SPIN(cond, bar) do { unsigned _sp = 0; while (cond) { __builtin_amdgcn_s_sleep(1); \
    if ((++_sp & 255u) == 0u) { if (xb_ld(&(bar)[XB_TMO])) break; if (_sp > XB_SPIN_CAP) { atomicAdd(&(bar)[XB_TMO], 1u); break; } } } } while (0)

struct XcdBarrier {
    unsigned* bar; unsigned x; int wave;
    volatile LAS unsigned* st;
};

__device__ __forceinline__ XcdBarrier xcd_barrier_post(unsigned* bar, volatile LAS unsigned* st, int wave) {
    XcdBarrier b; b.bar = bar; b.x = xb_xcc_id(); b.st = st; b.wave = wave;
    if (b.wave == 0 && lane_now() == 0) (void)xb_add(&bar[XB_XCNT(b.x)], 1u);
    return b;
}
__device__ __forceinline__ void xcd_barrier_complete(unsigned* bar, unsigned x, unsigned& nloc, unsigned& nx) {
    const unsigned G = gridDim.x * gridDim.y * gridDim.z;
    unsigned sum, cnt, mine, sp = 0u;
    for (;;) {
        sum = 0u; cnt = 0u; mine = 0u;
#pragma unroll
        for (unsigned j = 0; j < 16; ++j) { const unsigned c = xb_ld(&bar[XB_XCNT(j)]); sum += c; cnt += (c > 0u) ? 1u : 0u; mine = (j == x) ? c : mine; }
        if (sum == G) break;
        __builtin_amdgcn_s_sleep(1);
        if ((++sp & 255u) == 0u) { if (xb_ld(&bar[XB_TMO])) break; if (sp > XB_SPIN_CAP) { atomicAdd(&bar[XB_TMO], 1u); break; } }
    }
    nloc = mine > 0u ? mine : 1u; nx = cnt > 0u ? cnt : 1u;
}

__device__ __forceinline__ void xcd_barrier(const XcdBarrier& b) {
    asm volatile("s_waitcnt vmcnt(0)" ::: "memory");
    __syncthreads();
    if (b.wave == 0 && lane_now() == 0) {
        unsigned* bar = b.bar;
        __builtin_amdgcn_s_waitcnt(0);
#if MK_EARLY_INV
        asm volatile("buffer_inv sc1" ::: "memory");
#endif
        unsigned nloc = b.st[0], nx = b.st[1];
        if (nloc == 0u) { xcd_barrier_complete(bar, b.x, nloc, nx); b.st[0] = nloc; b.st[1] = nx; }
        const unsigned old = xb_add(&bar[XB_XSUB(b.x)], 1u);
        const unsigned gen = old / nloc;
        if (old + 1u == (gen + 1u) * nloc) {
            __builtin_amdgcn_fence(__ATOMIC_RELEASE, "agent");
            asm volatile("s_waitcnt vmcnt(0)" ::: "memory");
            const unsigned og = xb_add(&bar[XB_TOP], 1u);
            const unsigned tg = og / nx;
            if (og + 1u == (tg + 1u) * nx) xb_add(&bar[XB_TOPGEN], 1u);
            else XB_SPIN(xb_ld(&bar[XB_TOPGEN]) == tg, bar);
            __builtin_amdgcn_fence(__ATOMIC_ACQUIRE, "agent");
            xb_add(&bar[XB_XGEN(b.x)], 1u);
            asm volatile("s_waitcnt vmcnt(0)" ::: "memory");
        } else {
            XB_SPIN(xb_ld(&bar[XB_XGEN(b.x)]) == gen, bar);
#if !MK_EARLY_INV
            __builtin_amdgcn_fence(__ATOMIC_ACQUIRE, "agent");
#endif
            asm volatile("s_waitcnt vmcnt(0)" ::: "memory");
        }
    }
    __syncthreads();
}

struct Ctx {
    const float *x, *norm_mix, *norm_ffn, *norm_final, *w_in_ab, *a_v_norm, *a_sw, *a_sb, *b_rpb, *w_out_ab, *w_in_cd, *c_conv, *w_out_cd, *router, *w_gate, *w_up, *w_down;
    float* out; unsigned char* ws;
    LAS unsigned char* lds;
    int tid, lane, wave, wave0, G, bid;
};

__device__ __forceinline__ void tr_load(const float* src, int N, f32x4 (&v)[16], int lane) {
    const int cc = lane & 15, rg = lane >> 4;
#pragma unroll
    for (int i = 0; i < 16; ++i) { const int k = (i & 1) + 2 * rg + 8 * (i >> 1); v[i] = *(const f32x4*)(src + (size_t)k * N + 4 * cc); }
}
__device__ __forceinline__ void tr_store(const f32x4 (&v)[16], bf16* dst, LAS unsigned* scr, int lane) {
    const int cc = lane & 15, rg = lane >> 4;
#pragma unroll
    for (int j = 0; j < 8; ++j)
#pragma unroll
        for (int q = 0; q < 4; ++q) scr[(4 * cc + q) * 33 + rg + 4 * j] = cvt_pk_bf16(v[2 * j][q], v[2 * j + 1][q]);
    LDS_WAIT(); asm volatile("" ::: "memory");
    const int ch = lane & 7;
#pragma unroll
    for (int jj = 0; jj < 8; ++jj) { const int n = (lane >> 3) + 8 * jj; const LAS unsigned* s = scr + n * 33 + 4 * ch;
        u32x4 o; o.x = s[0]; o.y = s[1]; o.z = s[2]; o.w = s[3];
        *(u32x4*)(dst + (size_t)n * DM + 8 * ch) = o; }
    LDS_WAIT(); asm volatile("" ::: "memory");
}
__device__ __forceinline__ void rms_row_load(const float* xrow, f32x4 (&v)[8], int lane) {
#pragma unroll
    for (int j = 0; j < 4; ++j) { v[2 * j] = *(const f32x4*)(xrow + 512 * j + 8 * lane); v[2 * j + 1] = *(const f32x4*)(xrow + 512 * j + 8 * lane + 4); }
}
__device__ __forceinline__ void rms_row_to_bf16(const f32x4 (&v)[8], const float* gw, bf16* orow, unsigned char* orow8, int lane) {
    float ss = 0.f;
#pragma unroll
    for (int j = 0; j < 8; ++j) ss += (v[j].x * v[j].x + v[j].y * v[j].y) + (v[j].z * v[j].z + v[j].w * v[j].w);
    const float rstd = 1.0f / sqrtf(wave_sum(ss, lane) * (1.0f / DM) + RMS_EPS);
#pragma unroll
    for (int j = 0; j < 4; ++j) { const f32x4 g0 = *(const f32x4*)(gw + 512 * j + 8 * lane), g1 = *(const f32x4*)(gw + 512 * j + 8 * lane + 4);
        const f32x4 a = v[2 * j] * rstd * g0, b2 = v[2 * j + 1] * rstd * g1;
        u32x4 o; o.x = cvt_pk_bf16(a.x, a.y); o.y = cvt_pk_bf16(a.z, a.w); o.z = cvt_pk_bf16(b2.x, b2.y); o.w = cvt_pk_bf16(b2.z, b2.w);
        *(u32x4*)(orow + 512 * j + 8 * lane) = o;
        { int p0 = 0, p1 = 0;
          p0 = __builtin_amdgcn_cvt_pk_fp8_f32(__builtin_amdgcn_fmed3f(a.x, -448.f, 448.f), __builtin_amdgcn_fmed3f(a.y, -448.f, 448.f), p0, false); p0 = __builtin_amdgcn_cvt_pk_fp8_f32(__builtin_amdgcn_fmed3f(a.z, -448.f, 448.f), __builtin_amdgcn_fmed3f(a.w, -448.f, 448.f), p0, true);
          p1 = __builtin_amdgcn_cvt_pk_fp8_f32(__builtin_amdgcn_fmed3f(b2.x, -448.f, 448.f), __builtin_amdgcn_fmed3f(b2.y, -448.f, 448.f), p1, false); p1 = __builtin_amdgcn_cvt_pk_fp8_f32(__builtin_amdgcn_fmed3f(b2.z, -448.f, 448.f), __builtin_amdgcn_fmed3f(b2.w, -448.f, 448.f), p1, true);
          u32x2 w8; w8.x = (unsigned)p0; w8.y = (unsigned)p1; *(u32x2*)(orow8 + 512 * j + 8 * lane) = w8; } }
}
__device__ __forceinline__ int conv_job_items(int job) { return job == 0 ? 32 * 80 : job == 2 ? 32 * 96 : job < 4 ? 32 * 32 : ((job - 4) & 1) ? 16 * 1024 : 32 * 1024; }
struct ConvItem { const float* src; int N; bf16* dst; int fp8; };
__device__ __forceinline__ ConvItem conv_decode(const Ctx& c, int job, int r) {
    ConvItem t;
    if (job < 4) {
        const float* W = job == 0 ? c.w_in_ab : job == 1 ? c.w_out_ab : job == 2 ? c.w_in_cd : c.w_out_cd;
        const int N = job == 0 ? IN_AB : job == 2 ? IN_CD : DM;
        bf16* WT = (bf16*)(c.ws + (job == 0 ? WS_WIN0 : job == 1 ? WS_WOUT0 : job == 2 ? WS_WIN1 : WS_WOUT1));
        const int nsb = N / 128, sub = r & 7, sup = r >> 3, kb = 4 * (sup / nsb) + (sub & 3), nb = 2 * (sup % nsb) + (sub >> 2);
        t.src = W + (size_t)(64 * kb) * N + 64 * nb; t.N = N; t.dst = WT + (size_t)(64 * nb) * DM + 64 * kb; t.fp8 = 0;
        const int q0 = job == 0 ? 32 : job == 2 ? 48 : 1 << 30;
        if (nb >= q0) { t.fp8 = 1; t.dst = (bf16*)(c.ws + WS_WIN8 + (job == 2 ? 6 * MiB : 0) + (size_t)(64 * (nb - q0)) * DM + 64 * kb); }
    } else {
        const int l = (job - 4) >> 1, isdn = (job - 4) & 1, mat = r >> 10, w = r & 1023, sub = w & 7, sup = w >> 3, kb = 4 * (sup >> 4) + (sub & 3), n0 = 64 * (2 * (sup & 15) + (sub >> 2));
        const int e = isdn ? mat : mat >> 1, which = isdn ? 2 : (mat & 1);
        t.src = (which == 0 ? c.w_gate : which == 1 ? c.w_up : c.w_down) + ((size_t)(l * NE + e) * 2048 + 64 * kb) * 2048 + n0; t.N = 2048;
        t.fp8 = 1;
        if (which < 2) t.dst = (bf16*)(c.ws + WS_WGU + (size_t)l * 128 * MiB + (size_t)(e * 4096 + (n0 >> 7) * 256 + which * 128 + (n0 & 127)) * 2048 + 64 * kb);
        else t.dst = (bf16*)(c.ws + WS_WDN + (size_t)l * 64 * MiB + (size_t)(e * 2048 + n0) * 2048 + 64 * kb);
    }
    return t;
}
__device__ __forceinline__ void conv_job(const Ctx& c, int job, int lo, int hi, int icu, int ncu) {
    LAS unsigned* scr = (LAS unsigned*)(c.lds + c.wave * 8704);
    const int step = ncu * NWAVES; int it = lo + icu * NWAVES + c.wave;
    if (it >= hi) return;
    f32x4 va[16], vb[16];
    ConvItem ta = conv_decode(c, job, it), tb = ta;
    tr_load(ta.src, ta.N, va, c.lane);
    for (;;) {
        if (it + step < hi) { tb = conv_decode(c, job, it + step); tr_load(tb.src, tb.N, vb, c.lane); }
        tr_store(va, ta.dst, scr, c.lane);
        it += step; if (it >= hi) break;
        if (it + step < hi) { ta = conv_decode(c, job, it + step); tr_load(ta.src, ta.N, va, c.lane); }
        tr_store(vb, tb.dst, scr, c.lane);
        it += step; if (it >= hi) break;
    }
}
constexpr int DMA_PIECE = 1040, DMA_BUF = 8 * DMA_PIECE;
__device__ __forceinline__ void dma_issue(const float* src, int N, LAS unsigned char* buf, int lane) {
    const float* p = src + (size_t)(lane >> 3) * N + 4 * (lane & 7);
#pragma unroll
    for (int j = 0; j < 8; ++j) __builtin_amdgcn_global_load_lds((const unsigned*)(p + (size_t)(8 * j) * N), (LAS unsigned*)(buf + j * DMA_PIECE), 16, 0, 2);
}
__device__ __forceinline__ void dma_drain_store(const LAS unsigned char* buf, bf16* dst, int lane) {
    const int ch = lane & 7, nr = lane >> 3;
#pragma unroll
    for (int pass = 0; pass < 4; ++pass) { const int n = nr + 8 * pass; const LAS float* s = (const LAS float*)(buf + ch * DMA_PIECE) + n;
        float f[8];
#pragma unroll
        for (int q = 0; q < 8; ++q) f[q] = s[q * 32];
        u32x4 o; o.x = cvt_pk_bf16(f[0], f[1]); o.y = cvt_pk_bf16(f[2], f[3]); o.z = cvt_pk_bf16(f[4], f[5]); o.w = cvt_pk_bf16(f[6], f[7]);
        __builtin_nontemporal_store(o, (u32x4*)(dst + (size_t)n * DM + 8 * ch)); }
}
__device__ __forceinline__ void dma_drain_store_fp8(const LAS unsigned char* buf, unsigned char* dst8, int lane) {
    const int ch = lane & 3, nr = lane >> 2;
#pragma unroll
    for (int pass = 0; pass < 2; ++pass) { const int n = nr + 16 * pass; const LAS float* s = (const LAS float*)(buf + 2 * ch * DMA_PIECE) + n;
        float f[16];
#pragma unroll
        for (int q = 0; q < 16; ++q) f[q] = s[(q >> 3) * (DMA_PIECE / 4) + (q & 7) * 32] * W8_SCALE;
        u32x4 o;
#pragma unroll
        for (int w = 0; w < 4; ++w) { int p = 0; p = __builtin_amdgcn_cvt_pk_fp8_f32(f[4 * w], f[4 * w + 1], p, false); p = __builtin_amdgcn_cvt_pk_fp8_f32(f[4 * w + 2], f[4 * w + 3], p, true); o[w] = (unsigned)p; }
        __builtin_nontemporal_store(o, (u32x4*)(dst8 + (size_t)n * DM + 16 * ch)); }
}
__device__ __forceinline__ void conv_job_dma(const Ctx& c, int job, int lo, int hi, int icu, int ncu) {
    LAS unsigned char* b0 = c.lds + c.wave * (2 * DMA_BUF); LAS unsigned char* b1 = b0 + DMA_BUF;
    const int step = ncu * NWAVES; int it = lo + icu * NWAVES + c.wave;
    if (it >= hi) return;
    ConvItem t = conv_decode(c, job, it);
    dma_issue(t.src, t.N, b0, c.lane);
    for (;;) {
        dma_issue(t.src + 32, t.N, b1, c.lane);
        asm volatile("s_waitcnt vmcnt(8)" ::: "memory");
        if (t.fp8) dma_drain_store_fp8(b0, (unsigned char*)t.dst, c.lane); else dma_drain_store(b0, t.dst, c.lane);
        asm volatile("s_waitcnt lgkmcnt(0)" ::: "memory");
        const int nit = it + step; ConvItem tn = t;
        if (nit < hi) { tn = conv_decode(c, job, nit); dma_issue(tn.src, tn.N, b0, c.lane); asm volatile("s_waitcnt vmcnt(8)" ::: "memory"); }
        else asm volatile("s_waitcnt vmcnt(0)" ::: "memory");
        if (t.fp8) dma_drain_store_fp8(b1, (unsigned char*)t.dst + (size_t)32 * DM, c.lane); else dma_drain_store(b1, t.dst + (size_t)32 * DM, c.lane);
        asm volatile("s_waitcnt lgkmcnt(0)" ::: "memory");
        if (nit >= hi) break;
        it = nit; t = tn;
    }
}
constexpr int WT_PITCH = 1040, WT_BYTES = 64 * WT_PITCH;
__device__ __forceinline__ int conv_job_tiles(int job) { return job == 0 ? 32 * 20 : job == 2 ? 32 * 24 : job < 4 ? 32 * 8 : ((job - 4) & 1) ? 16 * 256 : 32 * 256; }
struct ConvTile { const float* src; int N; int rowbase  ; int k0; int kind  ; unsigned char* dstb; };
__device__ __forceinline__ ConvTile conv_tile_decode(const Ctx& c, int job, int tt) {
    ConvTile t;
    if (job < 4) {
        const float* W = job == 0 ? c.w_in_ab : job == 1 ? c.w_out_ab : job == 2 ? c.w_in_cd : c.w_out_cd;
        const int N = job == 0 ? IN_AB : job == 2 ? IN_CD : DM, nT = N / 256, kb = tt / nT, nt = tt % nT;
        t.src = W + (size_t)(64 * kb) * N + 256 * nt; t.N = N; t.rowbase = 256 * nt; t.k0 = 64 * kb; t.kind = 0;
        t.dstb = c.ws + (job == 0 ? WS_WIN0 : job == 1 ? WS_WOUT0 : job == 2 ? WS_WIN1 : WS_WOUT1);
        const int q0 = job == 0 ? 8 : job == 2 ? 12 : 1 << 30;
        if (nt >= q0) { t.kind = 2; t.rowbase = 256 * (nt - q0); t.dstb = c.ws + WS_WIN8 + (job == 2 ? 6 * MiB : 0); }
    } else {
        const int l = (job - 4) >> 1, isdn = (job - 4) & 1, mat = tt >> 8, w = tt & 255, kb = w >> 3, nt = w & 7;
        const int e = isdn ? mat : mat >> 1, which = isdn ? 2 : (mat & 1);
        t.src = (which == 0 ? c.w_gate : which == 1 ? c.w_up : c.w_down) + ((size_t)(l * NE + e) * 2048 + 64 * kb) * 2048 + 256 * nt; t.N = 2048; t.k0 = 64 * kb;
        if (which < 2) { t.kind = 1; t.rowbase = e * 4096 + (2 * nt) * 256 + which * 128; t.dstb = c.ws + WS_WGU + (size_t)l * 128 * MiB; }
        else { t.kind = 2; t.rowbase = e * 2048 + 256 * nt; t.dstb = c.ws + WS_WDN + (size_t)l * 64 * MiB; }
    }
    return t;
}
__device__ __forceinline__ void wt_issue(const Ctx& c, const ConvTile& t, LAS unsigned char* buf) {
    const float* p = t.src + (size_t)(8 * c.wave) * t.N + 4 * c.lane;
#pragma unroll
    for (int j = 0; j < 8; ++j) __builtin_amdgcn_global_load_lds((const unsigned*)(p + (size_t)j * t.N), (LAS unsigned*)(buf + (8 * c.wave + j) * WT_PITCH), 16, 0, 2);
}
__device__ __forceinline__ void wt_drain(const Ctx& c, const ConvTile& t, const LAS unsigned char* buf) {
    if (t.kind == 0) {
#pragma unroll
        for (int j = 0; j < 4; ++j) { const int id = c.tid + 512 * j, n = id >> 3, ch = id & 7; const LAS float* s = (const LAS float*)(buf + (8 * ch) * WT_PITCH) + n;
            float f[8];
#pragma unroll
            for (int q = 0; q < 8; ++q) f[q] = s[q * (WT_PITCH / 4)];
            u32x4 o; o.x = cvt_pk_bf16(f[0], f[1]); o.y = cvt_pk_bf16(f[2], f[3]); o.z = cvt_pk_bf16(f[4], f[5]); o.w = cvt_pk_bf16(f[6], f[7]);
            __builtin_nontemporal_store(o, (u32x4*)((bf16*)t.dstb + (size_t)(t.rowbase + n) * DM + t.k0 + 8 * ch)); }
    } else {
#pragma unroll
        for (int j = 0; j < 2; ++j) { const int id = c.tid + 512 * j, n = id >> 2, ch = id & 3; const LAS float* s = (const LAS float*)(buf + (16 * ch) * WT_PITCH) + n;
            float f[16];
#pragma unroll
            for (int q = 0; q < 16; ++q) f[q] = s[q * (WT_PITCH / 4)] * W8_SCALE;
            u32x4 o;
#pragma unroll
            for (int w = 0; w < 4; ++w) { int p = 0; p = __builtin_amdgcn_cvt_pk_fp8_f32(f[4 * w], f[4 * w + 1], p, false); p = __builtin_amdgcn_cvt_pk_fp8_f32(f[4 * w + 2], f[4 * w + 3], p, true); o[w] = (unsigned)p; }
            const int row = t.kind == 1 ? t.rowbase + (n >> 7) * 256 + (n & 127) : t.rowbase + n;
            __builtin_nontemporal_store(o, (u32x4*)(t.dstb + (size_t)row * DM + t.k0 + 16 * ch)); }
    }
}
__device__ __forceinline__ void conv_job_wg(const Ctx& c, int job, int lo, int hi, int icu, int ncu) {
    int tt = lo + icu; if (tt >= hi) return;
    LAS unsigned char* b0 = c.lds; LAS unsigned char* b1 = c.lds + WT_BYTES;
    ConvTile t = conv_tile_decode(c, job, tt);
    wt_issue(c, t, b0);
    for (int b = 0;; b ^= 1) {
        const int nx = tt + ncu; ConvTile tn = t;
        asm volatile("" ::: "memory"); __builtin_amdgcn_s_barrier(); asm volatile("" ::: "memory");
        if (nx < hi) { tn = conv_tile_decode(c, job, nx); wt_issue(c, tn, b ? b0 : b1); asm volatile("s_waitcnt vmcnt(8)" ::: "memory"); }
        else asm volatile("s_waitcnt vmcnt(0)" ::: "memory");
        __builtin_amdgcn_s_barrier(); asm volatile("" ::: "memory");
        wt_drain(c, t, b ? b1 : b0);
        asm volatile("s_waitcnt lgkmcnt(0)" ::: "memory");
        if (nx >= hi) break;
        tt = nx; t = tn;
    }
}
__device__ __forceinline__ void conv_job_loads(const Ctx& c, int job, int lo, int hi, int icu, int ncu) {
    const int step = ncu * NWAVES;
    for (int it = lo + icu * NWAVES + c.wave; it < hi; it += step) { f32x4 v[16]; const ConvItem t = conv_decode(c, job, it); tr_load(t.src, t.N, v, c.lane);
#pragma unroll
        for (int k = 0; k < 16; ++k) asm volatile("" :: "v"(v[k])); }
}
__device__ __forceinline__ void conv_job_half(const Ctx& c, int job, int when  ) {
#if MK_CONV_SKEW
    const int n = conv_job_items(job), pass = c.G * NWAVES, per = (n + pass - 1) / pass, j = c.bid >> 3, q = ((j >> 1) * per) / (((c.G + 7) >> 3) * 2);
    const int s = (j & 1) ? q : per - q, cut = s * pass < n ? s * pass : n;
    if (when == 0) { if (cut > 0) conv_job_dma(c, job, 0, cut, c.bid, c.G); }
    else if (cut < n) conv_job_dma(c, job, cut, n, c.bid, c.G);
#else
    const int hg = c.G >> 1, half = c.bid >= hg ? 1 : 0, n = conv_job_items(job), mid = (n >> 1);
    if (half != when) return;
    conv_job_dma(c, job, half ? mid : 0, half ? n : mid, half ? c.bid - hg : c.bid, half ? c.G - hg : hg);
#endif
}
__device__ __forceinline__ void p_prologue(const Ctx& c) {
    conv_job_dma(c, 0, 0, conv_job_items(0), c.bid, c.G); __syncthreads();
    const int gw = c.bid * NWAVES + c.wave, NGW = c.G * NWAVES;
    bf16* H = (bf16*)(c.ws + WS_H);
    f32x4 va[8], vb[8]; int m = gw;
    if (m < M) rms_row_load(c.x + (size_t)m * DM, va, c.lane);
    for (; m < M; m += NGW) { const int mn = m + NGW;
        if (mn < M) rms_row_load(c.x + (size_t)mn * DM, vb, c.lane);
        rms_row_to_bf16(va, c.norm_mix, H + (size_t)m * DM, c.ws + WS_H8 + (size_t)m * DM, c.lane);
#pragma unroll
        for (int j = 0; j < 8; ++j) va[j] = vb[j]; }
}
constexpr int KP = 272, VP = 288, ATT_K_OFF = 0, ATT_V_OFF = 256 * KP, ATT_RP_OFF = ATT_V_OFF + 256 * VP;
__device__ __forceinline__ void att_write_lds(const Ctx& c, const u32x4 (&kr)[8], const u32x4 (&vr)[8], int rot) {
#pragma unroll
    for (int j = 0; j < 8; ++j) { const int id = c.tid + 512 * j, row = ((id >> 4) & 128) | (((id >> 4) + rot) & 127), c16 = id & 15;
        *(LAS u32x4*)(c.lds + ATT_K_OFF + row * KP + 16 * c16) = kr[j]; *(LAS u32x4*)(c.lds + ATT_V_OFF + row * VP + 16 * c16) = vr[j]; }
}
template <int NB, class Fn>
__device__ __forceinline__ void attn_blocks(const LAS unsigned char* lds, const int (&krow)[NB], const bf16x8 (&qf)[4], f32x4 (&O)[8], float& m, float& l, int i, int g, const Fn (&fn)[NB]) {
    const LAS unsigned char* kbp[NB]; const LAS unsigned char* vbp[NB];
#pragma unroll
    for (int nb = 0; nb < NB; ++nb) { const unsigned ko = (unsigned)(ATT_K_OFF + (krow[nb] + i) * KP + 16 * g), vo = (unsigned)(ATT_V_OFF + (krow[nb] + 4 * g + (i >> 2)) * VP + 8 * (i & 3));
        kbp[nb] = lds + ko; vbp[nb] = lds + vo; }
    f32x4 S[NB][2];
#pragma unroll
    for (int nb = 0; nb < NB; ++nb) { S[nb][0] = (f32x4){0.f, 0.f, 0.f, 0.f}; S[nb][1] = (f32x4){0.f, 0.f, 0.f, 0.f}; }
#pragma unroll
    for (int kh = 0; kh < 2; ++kh) {
        bf16x8 kf[2][NB][2];
#pragma unroll
        for (int kk = 0; kk < 2; ++kk)
#pragma unroll
            for (int nb = 0; nb < NB; ++nb)
#pragma unroll
                for (int t = 0; t < 2; ++t) kf[kk][nb][t] = *(const LAS bf16x8*)(kbp[nb] + 16 * t * KP + 64 * (2 * kh + kk));
#pragma unroll
        for (int kk = 0; kk < 2; ++kk)
#pragma unroll
            for (int nb = 0; nb < NB; ++nb)
#pragma unroll
                for (int t = 0; t < 2; ++t) S[nb][t] = __builtin_amdgcn_mfma_f32_16x16x32_bf16(kf[kk][nb][t], qf[2 * kh + kk], S[nb][t], 0, 0, 0);
    }
    s16x4 vlo[8][NB], vhi[8][NB];
#pragma unroll
    for (int dn = 0; dn < 2; ++dn)
#pragma unroll
        for (int nb = 0; nb < NB; ++nb) { const LAS unsigned char* vb = vbp[nb] + 32 * dn; vlo[dn][nb] = vtr(vb); vhi[dn][nb] = vtr(vb + 16 * VP); }
    float sc[NB][8]; float mx = -INFINITY;
#pragma unroll
    for (int nb = 0; nb < NB; ++nb)
#pragma unroll
        for (int r = 0; r < 4; ++r) { sc[nb][r] = fn[nb](0, r, S[nb][0][r]); sc[nb][4 + r] = fn[nb](1, r, S[nb][1][r]); mx = fmaxf(mx, fmaxf(sc[nb][r], sc[nb][4 + r])); }
    { const int ln = (g << 4) | i; mx = fmaxf(mx, shx(mx, 16, ln)); mx = fmaxf(mx, shx(mx, 32, ln)); }
    const float mn = fmaxf(m, mx), alpha = __builtin_amdgcn_exp2f(m - mn);
    float ps = 0.f; bf16x8 pf[NB];
#pragma unroll
    for (int nb = 0; nb < NB; ++nb) { float p[8];
#pragma unroll
        for (int j = 0; j < 8; ++j) { p[j] = __builtin_amdgcn_exp2f(sc[nb][j] - mn); ps += p[j]; }
        u32x4 pw; pw.x = cvt_pk_bf16(p[0], p[1]); pw.y = cvt_pk_bf16(p[2], p[3]); pw.z = cvt_pk_bf16(p[4], p[5]); pw.w = cvt_pk_bf16(p[6], p[7]);
        pf[nb] = __builtin_bit_cast(bf16x8, pw); }
    l = l * alpha + ps; m = mn;
#pragma unroll
    for (int dn = 2; dn < 8; ++dn)
#pragma unroll
        for (int nb = 0; nb < NB; ++nb) { const LAS unsigned char* vb = vbp[nb] + 32 * dn; vlo[dn][nb] = vtr(vb); vhi[dn][nb] = vtr(vb + 16 * VP); }
#pragma unroll
    for (int dn = 0; dn < 8; ++dn) O[dn] = O[dn] * alpha;
#pragma unroll
    for (int dn = 0; dn < 8; ++dn)
#pragma unroll
        for (int nb = 0; nb < NB; ++nb) {
            const bf16x8 vf = {vlo[dn][nb][0], vlo[dn][nb][1], vlo[dn][nb][2], vlo[dn][nb][3], vhi[dn][nb][0], vhi[dn][nb][1], vhi[dn][nb][2], vhi[dn][nb][3]};
            O[dn] = __builtin_amdgcn_mfma_f32_16x16x32_bf16(vf, pf[nb], O[dn], 0, 0, 0); }
}

__device__ __forceinline__ void sgu_unit(const Ctx& c, int u) {
    const int b = u >> 5, chn = (u >> 1) & 15, half = u & 1, tok0 = b * SEQ + chn * 128;
    const bf16* P = (const bf16*)(c.ws + WS_P); bf16* Y = (bf16*)(c.ws + WS_YCAT);
    LAS unsigned char* Vs = c.lds; LAS float* stat = (LAS float*)(c.lds + 128 * 272);
    const int lane = c.lane, wave = c.wave, i = lane & 15, g = lane >> 4;
    __syncthreads();
#pragma unroll
    for (int it = 0; it < 2; ++it) {
        u32x4 raw[2][8];
#pragma unroll
        for (int ps = 0; ps < 2; ++ps) { const bf16* row = P + (size_t)(tok0 + 16 * wave + 8 * it + 4 * ps + g) * IN_AB + 1024 + 8 * i;
#pragma unroll
            for (int j = 0; j < 8; ++j) raw[ps][j] = *(const u32x4*)(row + 128 * j); }
#pragma unroll
        for (int ps = 0; ps < 2; ++ps) { float s = 0.f;
#pragma unroll
            for (int j = 0; j < 8; ++j)
#pragma unroll
                for (int k = 0; k < 4; ++k) s += bf_lo(raw[ps][j][k]) + bf_hi(raw[ps][j][k]);
#pragma unroll
            for (int o = 1; o < 16; o <<= 1) s += shx(s, o, lane);
            const float mean = s * (1.0f / 1024.0f); float q2 = 0.f;
#pragma unroll
            for (int j = 0; j < 8; ++j)
#pragma unroll
                for (int k = 0; k < 4; ++k) { const float d0 = bf_lo(raw[ps][j][k]) - mean, d1 = bf_hi(raw[ps][j][k]) - mean; q2 += d0 * d0 + d1 * d1; }
#pragma unroll
            for (int o = 1; o < 16; o <<= 1) q2 += shx(q2, o, lane);
            const float rstd = 1.0f / sqrtf(q2 * (1.0f / 1024.0f) + LN_EPS);
            if (i == 0) { const int tk = 16 * wave + 8 * it + 4 * ps + g; stat[2 * tk] = mean; stat[2 * tk + 1] = rstd; } }
    }
    u32x4 rawv[4];
#pragma unroll
    for (int j = 0; j < 4; ++j) { const int id = c.tid + 512 * j, tok = id >> 4, c16 = id & 15; rawv[j] = *(const u32x4*)(P + (size_t)(tok0 + tok) * IN_AB + 1024 + (4 * half) * 128 + 8 * c16); }
    __syncthreads();
    for (int gi = 0; gi < 4; ++gi) {
        const int gidx = 4 * half + gi;
#pragma unroll
        for (int j = 0; j < 4; ++j) { const int id = c.tid + 512 * j, tok = id >> 4, c16 = id & 15;
            const u32x4 raw = rawv[j];
            const float mean = stat[2 * tok], rstd = stat[2 * tok + 1];
            const f32x4 g0 = *(const f32x4*)(c.a_v_norm + gidx * 128 + 8 * c16), g1 = *(const f32x4*)(c.a_v_norm + gidx * 128 + 8 * c16 + 4);
            u32x4 w;
            w.x = cvt_pk_bf16((bf_lo(raw.x) - mean) * rstd * g0.x, (bf_hi(raw.x) - mean) * rstd * g0.y);
            w.y = cvt_pk_bf16((bf_lo(raw.y) - mean) * rstd * g0.z, (bf_hi(raw.y) - mean) * rstd * g0.w);
            w.z = cvt_pk_bf16((bf_lo(raw.z) - mean) * rstd * g1.x, (bf_hi(raw.z) - mean) * rstd * g1.y);
            w.w = cvt_pk_bf16((bf_lo(raw.w) - mean) * rstd * g1.z, (bf_hi(raw.w) - mean) * rstd * g1.w);
            *(LAS u32x4*)(Vs + tok * 272 + 16 * c16) = w; }
        const int t = 16 * wave + i;
        const float* wrow = c.a_sw + (size_t)(gidx * 128 + t) * 128;
        bf16x8 bw[4];
#pragma unroll
        for (int kk = 0; kk < 4; ++kk) { const f32x4 lo = *(const f32x4*)(wrow + 32 * kk + 4 * g), hi = *(const f32x4*)(wrow + 32 * kk + 16 + 4 * g);
            u32x4 w; w.x = cvt_pk_bf16(lo.x, lo.y); w.y = cvt_pk_bf16(lo.z, lo.w); w.z = cvt_pk_bf16(hi.x, hi.y); w.w = cvt_pk_bf16(hi.z, hi.w); bw[kk] = __builtin_bit_cast(bf16x8, w); }
        const float bias = c.a_sb[gidx * 128 + t];
        if (gi < 3) {
#pragma unroll
            for (int j = 0; j < 4; ++j) { const int id = c.tid + 512 * j, tok = id >> 4, c16 = id & 15; rawv[j] = *(const u32x4*)(P + (size_t)(tok0 + tok) * IN_AB + 1024 + (gidx + 1) * 128 + 8 * c16); } }
        u32x2 uu[8];
#pragma unroll
        for (int mt = 0; mt < 8; ++mt) uu[mt] = *(const u32x2*)(P + (size_t)(tok0 + t) * IN_AB + gidx * 128 + 16 * mt + 4 * g);
        __syncthreads();
        f32x4 acc[8];
#pragma unroll
        for (int mt = 0; mt < 8; ++mt) { acc[mt] = (f32x4){0.f, 0.f, 0.f, 0.f};
#pragma unroll
            for (int kk = 0; kk < 4; ++kk) {
                const s16x4 lo = vtr(Vs + (32 * kk + 4 * g + (i >> 2)) * 272 + 32 * mt + 8 * (i & 3)), hi = vtr(Vs + (32 * kk + 16 + 4 * g + (i >> 2)) * 272 + 32 * mt + 8 * (i & 3));
                const bf16x8 af = {lo[0], lo[1], lo[2], lo[3], hi[0], hi[1], hi[2], hi[3]};
                acc[mt] = __builtin_amdgcn_mfma_f32_16x16x32_bf16(af, bw[kk], acc[mt], 0, 0, 0);
            } }
#pragma unroll
        for (int mt = 0; mt < 8; ++mt) { const int col = gidx * 128 + 16 * mt + 4 * g;
            u32x2 o; o.x = cvt_pk_bf16(bf_lo(uu[mt].x) * (acc[mt][0] + bias), bf_hi(uu[mt].x) * (acc[mt][1] + bias)); o.y = cvt_pk_bf16(bf_lo(uu[mt].y) * (acc[mt][2] + bias), bf_hi(uu[mt].y) * (acc[mt][3] + bias));
            *(u32x2*)(Y + (size_t)(tok0 + t) * DM + col) = o; }
        __syncthreads();
    }
}
struct NattenFn { const LAS float* rp; int brow, band0, cs, qc, g;
    __device__ __forceinline__ float operator()(int t, int reg, float s) const {
        const int kc = band0 + 16 * t + 4 * g + reg, rel = kc - cs; int bi = kc - qc + 15; bi = bi < 0 ? 0 : (bi > 30 ? 30 : bi);
        const float v = (s * ATT_SCALE + rp[brow + bi]) * LOG2E;
        return ((unsigned)rel < 16u) ? v : -INFINITY; } };
__device__ __forceinline__ void nat_issue(const Ctx& c, int item, u32x4 (&kr)[8], u32x4 (&vr)[8], bf16x8 (&qn)[4], int rot) {
    const int unit = item >> 2, chunk = item & 3, hp = unit & 3, r = (unit >> 2) & 31, b = unit >> 7;
    const int rs = r - 4 < 0 ? 0 : (r - 4 > 24 ? 24 : r - 4);
    const bf16* QKV = (const bf16*)(c.ws + WS_QKV); constexpr size_t WSTEP = QKV_STRIDE;
#pragma unroll
    for (int j = 0; j < 8; ++j) { const int id = c.tid + 512 * j, hh = id >> 11, row = ((id >> 4) + rot) & 127, c16 = id & 15;
        const bf16* src = QKV + WSTEP + ((size_t)(b * 8 + 2 * hp + hh) * SEQ + rs * 64 + chunk * 128 + row) * 128 + 8 * c16;
        kr[j] = *(const u32x4*)src; vr[j] = *(const u32x4*)(src + WSTEP); }
    if (chunk == 0) { const int i = c.lane & 15, g = c.lane >> 4, hh = c.wave >> 2, cb = c.wave & 3;
#pragma unroll
        for (int kk = 0; kk < 4; ++kk) qn[kk] = *(const bf16x8*)(QKV + ((size_t)(b * 8 + 2 * hp + hh) * SEQ + r * 64 + cb * 16 + i) * 128 + 32 * kk + 8 * g); }
}
__device__ __forceinline__ int nat_unit(const Ctx& c, int k) {
    if (c.G == 256) { const int x = c.bid & 7, ci = c.bid >> 3, set = 4 * x + k; return ((set >> 2) << 7) | (ci << 2) | (set & 3); }
    return c.bid + k * c.G;
}
__device__ __forceinline__ void p_natten(const Ctx& c) {
    const int NK = (1024 - c.bid + c.G - 1) / c.G, NITEM = NK * 4;
    const int lane = c.lane, wave = c.wave, i = lane & 15, g = lane >> 4, hh = wave >> 2, cb = wave & 3;
    LAS float* rp = (LAS float*)(c.lds + ATT_RP_OFF);
    u32x4 kr[8], vr[8]; bf16x8 qn[4], qf[4]; f32x4 O[8]; float m = -1e30f, l = 0.f;
#pragma unroll
    for (int kk = 0; kk < 4; ++kk) { qn[kk] = (bf16x8){0, 0, 0, 0, 0, 0, 0, 0}; qf[kk] = qn[kk]; }
#pragma unroll
    for (int dn = 0; dn < 8; ++dn) O[dn] = (f32x4){0.f, 0.f, 0.f, 0.f};
    const int band0 = cb * 16 - 8 < 0 ? 0 : (cb * 16 - 8 > 32 ? 32 : cb * 16 - 8), qc = cb * 16 + i, cs = qc - 8 < 0 ? 0 : (qc - 8 > 48 ? 48 : qc - 8);
    int item = 0;
    const int rot = (c.bid * 13) & 127;
    if (item < NITEM) nat_issue(c, nat_unit(c, 0) * 4, kr, vr, qn, rot);
    while (item < NITEM) {
        const int unit = nat_unit(c, item >> 2), chunk = item & 3, hp = unit & 3, r = (unit >> 2) & 31, b = unit >> 7;
        const int rs = r - 4 < 0 ? 0 : (r - 4 > 24 ? 24 : r - 4);
        __syncthreads();
        att_write_lds(c, kr, vr, rot);
        if (chunk == 0) {
            for (int k = c.tid; k < 930; k += NTHR) rp[k] = c.b_rpb[(2 * hp) * 465 + k];
#pragma unroll
            for (int kk = 0; kk < 4; ++kk) qf[kk] = qn[kk];
        }
        __syncthreads();
        const int nitem = item + 1;
        if (nitem < NITEM) nat_issue(c, nat_unit(c, nitem >> 2) * 4 + (nitem & 3), kr, vr, qn, rot);
        {
            const int a0 = 2 * chunk;
            const NattenFn fn[2] = {{rp + hh * 465, (rs + a0 - r + 7) * 31, band0, cs, qc, g}, {rp + hh * 465, (rs + a0 + 1 - r + 7) * 31, band0, cs, qc, g}};
            const int krow[2] = {hh * 128 + band0, hh * 128 + 64 + band0};
            attn_blocks<2, NattenFn>(c.lds, krow, qf, O, m, l, i, g, fn);
        }
        if (chunk == 3) {
            float lt = l; lt += shx(lt, 16, lane); lt += shx(lt, 32, lane);
            const float inv = 1.0f / lt;
            bf16* Y = (bf16*)(c.ws + WS_YCAT) + (size_t)(b * SEQ + r * 64 + qc) * DM + 1024 + (2 * hp + hh) * 128 + 4 * g;
#pragma unroll
            for (int dn = 0; dn < 8; ++dn) { u32x2 o; o.x = cvt_pk_bf16(O[dn][0] * inv, O[dn][1] * inv); o.y = cvt_pk_bf16(O[dn][2] * inv, O[dn][3] * inv);
                *(u32x2*)(Y + 16 * dn) = o; O[dn] = (f32x4){0.f, 0.f, 0.f, 0.f}; }
            m = -1e30f; l = 0.f;
        }
        item = nitem;
    }
}

struct ConvRegs { u32x4 cbv[2], cc[2][3], cx[2][3]; float wt[2][3]; };
__device__ __forceinline__ void conv_load(const Ctx& c, int u, int j, ConvRegs& r) {
    const bf16* P = (const bf16*)(c.ws + WS_P);
#pragma unroll
    for (int k = 0; k < 2; ++k) { const int id = c.tid + 512 * (j + k), tok = 64 * u + (id >> 7), c8 = id & 127, s = tok & (SEQ - 1);
        const bf16* row = P + (size_t)tok * IN_CD + 8 * c8; r.cbv[k] = *(const u32x4*)row;
#pragma unroll
        for (int w = 0; w < 3; ++w) { const int ss = s + w - 1; const bool in = ss >= 0 && ss < SEQ; r.wt[k][w] = in ? 1.f : 0.f;
            const bf16* rr = row + (ptrdiff_t)(in ? w - 1 : 0) * IN_CD; r.cc[k][w] = *(const u32x4*)(rr + 1024); r.cx[k][w] = *(const u32x4*)(rr + 2048); } }
}
__device__ __forceinline__ void conv_finish(const Ctx& c, int u, int j, const ConvRegs& r) {
    bf16* Y = (bf16*)(c.ws + WS_YCAT);
#pragma unroll
    for (int k = 0; k < 2; ++k) { const int id = c.tid + 512 * (j + k), tok = 64 * u + (id >> 7), c8 = id & 127;
        f32x4 acc0 = {0.f, 0.f, 0.f, 0.f}, acc1 = {0.f, 0.f, 0.f, 0.f};
#pragma unroll
        for (int w = 0; w < 3; ++w) { const f32x4 t0 = *(const f32x4*)(c.c_conv + w * 1024 + 8 * c8) * r.wt[k][w], t1 = *(const f32x4*)(c.c_conv + w * 1024 + 8 * c8 + 4) * r.wt[k][w];
            const u32x4 a = r.cc[k][w], x = r.cx[k][w];
            acc0.x += t0.x * bf_lo(a.x) * bf_lo(x.x); acc0.y += t0.y * bf_hi(a.x) * bf_hi(x.x); acc0.z += t0.z * bf_lo(a.y) * bf_lo(x.y); acc0.w += t0.w * bf_hi(a.y) * bf_hi(x.y);
            acc1.x += t1.x * bf_lo(a.z) * bf_lo(x.z); acc1.y += t1.y * bf_hi(a.z) * bf_hi(x.z); acc1.z += t1.z * bf_lo(a.w) * bf_lo(x.w); acc1.w += t1.w * bf_hi(a.w) * bf_hi(x.w); }
        const u32x4 b = r.cbv[k];
        u32x4 o; o.x = cvt_pk_bf16(bf_lo(b.x) * acc0.x, bf_hi(b.x) * acc0.y); o.y = cvt_pk_bf16(bf_lo(b.y) * acc0.z, bf_hi(b.y) * acc0.w);
        o.z = cvt_pk_bf16(bf_lo(b.z) * acc1.x, bf_hi(b.z) * acc1.y); o.w = cvt_pk_bf16(bf_lo(b.w) * acc1.z, bf_hi(b.w) * acc1.w);
        *(u32x4*)(Y + (size_t)tok * DM + 8 * c8) = o; }
}
__device__ __forceinline__ void conv_unit(const Ctx& c, int u) {
    ConvRegs ra, rb;
    conv_load(c, u, 0, ra);
#pragma unroll 1
    for (int j = 0; j < 16; j += 4) {
        conv_load(c, u, j + 2, rb);
        conv_finish(c, u, j, ra);
        if (j + 4 < 16) conv_load(c, u, j + 4, ra);
        conv_finish(c, u, j + 2, rb);
    }
}
struct DilFn { float slope_dil; int qi, g, klbase, length, rowb;
    __device__ __forceinline__ float operator()(int t, int reg, float s) const {
        const int jj = rowb + 16 * t + 4 * g + reg, delta = jj - 64 - qi, ad = delta < 0 ? -delta : delta, kl = klbase + jj;
        const float v = (s * ATT_SCALE - slope_dil * (float)ad) * LOG2E;
        return (ad <= 64 && kl >= 0 && kl < length) ? v : -INFINITY; } };
struct DilDec { int pat, h, b, dil, L, qc, res; };
__device__ __forceinline__ DilDec dil_decode(int u) { DilDec d; d.pat = u >> 10; d.h = u & 7; d.b = (u >> 3) & 7; const int sub = (u >> 6) & 15; d.dil = 1 << (2 * d.pat); const int nch = 16 >> (2 * d.pat);
    d.L = SEQ >> (2 * d.pat); d.qc = sub % nch; d.res = sub / nch; return d; }
__device__ __forceinline__ void dil_issue(const Ctx& c, int u, u32x4 (&kr)[8], u32x4 (&vr)[8], bf16x8 (&qn)[4], int rot) {
    const DilDec d = dil_decode(u);
    const bf16* QKV = (const bf16*)(c.ws + WS_QKV) + (size_t)(d.b * 8 + d.h) * SEQ * 128; constexpr size_t WSTEP = QKV_STRIDE;
#pragma unroll
    for (int j = 0; j < 8; ++j) { const int id = c.tid + 512 * j, row = ((id >> 4) & 128) | (((id >> 4) + rot) & 127), c16 = id & 15; int kl = 128 * d.qc - 64 + row;
        kl = kl < 0 ? 0 : (kl > d.L - 1 ? d.L - 1 : kl);
        const bf16* src = QKV + WSTEP + (size_t)(kl * d.dil + d.res) * 128 + 8 * c16; kr[j] = *(const u32x4*)src; vr[j] = *(const u32x4*)(src + WSTEP); }
    const int i = c.lane & 15, g = c.lane >> 4;
#pragma unroll
    for (int kk = 0; kk < 4; ++kk) qn[kk] = *(const bf16x8*)(QKV + (size_t)((128 * d.qc + 16 * c.wave + i) * d.dil + d.res) * 128 + 32 * kk + 8 * g);
}
__device__ __forceinline__ int dil_unit(const Ctx& c, int k) {
    if (c.G == 256) { const int x = c.bid & 7, ci = c.bid >> 3, lu = (k % 3) * 32 + ci, bh = 8 * x + 2 * (k / 3) + lu / 48, v = lu % 48;
        return ((v / 16) << 10) | ((v % 16) << 6) | bh; }
    return c.bid + k * c.G;
}
__device__ __forceinline__ void p_dilated(const Ctx& c) {
    const int NU = (3072 - c.bid + c.G - 1) / c.G;
    const int lane = c.lane, wave = c.wave, i = lane & 15, g = lane >> 4;
    u32x4 kr[8], vr[8]; bf16x8 qn[4], qf[4];
    const int rot = (c.bid * 13) & 127;
    if (0 < NU) dil_issue(c, dil_unit(c, 0), kr, vr, qn, rot);
    for (int k = 0; k < NU; ++k) {
        const int u = dil_unit(c, k);
        const DilDec d = dil_decode(u);
        __syncthreads();
        att_write_lds(c, kr, vr, rot);
#pragma unroll
        for (int kk = 0; kk < 4; ++kk) qf[kk] = qn[kk];
        __syncthreads();
        if (k + 1 < NU) dil_issue(c, dil_unit(c, k + 1), kr, vr, qn, rot);
        f32x4 O[8]; float m = -1e30f, l = 0.f;
        const int qi = 16 * wave + i, klbase = 128 * d.qc - 64, kb0 = wave >> 1;
#pragma unroll 1
        for (int crep = 0; crep < MK_DIL_REPS; ++crep) {
        m = -1e30f; l = 0.f;
#pragma unroll
        for (int dn = 0; dn < 8; ++dn) O[dn] = (f32x4){0.f, 0.f, 0.f, 0.f};
        const int lo_row = klbase < 0 ? -klbase : 0, hi_row = d.L - klbase < 256 ? d.L - klbase : 256;
        const float slope_dil = __builtin_amdgcn_exp2f(-(float)(d.h + 1)) * (float)d.dil;
#pragma unroll 1
        for (int pr = 0; pr < 2; ++pr) { const int r0 = 32 * (kb0 + 2 * pr);
            if (r0 + 64 > lo_row && r0 < hi_row) {
                const DilFn fn[2] = {{slope_dil, qi, g, klbase, d.L, r0}, {slope_dil, qi, g, klbase, d.L, r0 + 32}};
                const int krow[2] = {r0, r0 + 32};
                attn_blocks<2, DilFn>(c.lds, krow, qf, O, m, l, i, g, fn); } }
        { const int r0 = 32 * (kb0 + 4);
            if (r0 + 32 > lo_row && r0 < hi_row) {
                const DilFn fn[1] = {{slope_dil, qi, g, klbase, d.L, r0}};
                const int krow[1] = {r0};
                attn_blocks<1, DilFn>(c.lds, krow, qf, O, m, l, i, g, fn); } }
        }
        float lt = l; lt += shx(lt, 16, lane); lt += shx(lt, 32, lane);
        const float inv = 1.0f / lt;
        const int tokq = d.b * SEQ + (128 * d.qc + qi) * d.dil + d.res;
        bf16* OP = (bf16*)(c.ws + WS_OP) + (size_t)d.pat * OP_STRIDE + (size_t)tokq * 1024 + d.h * 128 + 4 * g;
#pragma unroll
        for (int dn = 0; dn < 8; ++dn) { u32x2 o; o.x = cvt_pk_bf16(O[dn][0] * inv, O[dn][1] * inv); o.y = cvt_pk_bf16(O[dn][2] * inv, O[dn][3] * inv); *(u32x2*)(OP + 16 * dn) = o; }
        if (g == 0) ((float*)(c.ws + WS_LSE))[((size_t)d.pat * M + tokq) * 8 + d.h] = (m + __builtin_amdgcn_logf(lt)) * LN2;
    }
}
__device__ __forceinline__ void p_merge(const Ctx& c) {
    const bf16* OP = (const bf16*)(c.ws + WS_OP); const float* LSE = (const float*)(c.ws + WS_LSE); bf16* Y = (bf16*)(c.ws + WS_YCAT);
    const int stride = c.G * NTHR;
    for (int id0 = c.bid * NTHR + c.tid; id0 < M * 128; id0 += 4 * stride) {
        float l[4][3]; u32x4 a[4][3]; bool ok[4];
#pragma unroll
        for (int k = 0; k < 4; ++k) { const int id = id0 + k * stride; ok[k] = id < M * 128; const int idc = ok[k] ? id : id0, tok = idc >> 7, c8 = idc & 127, h = c8 >> 4;
#pragma unroll
            for (int p = 0; p < 3; ++p) { l[k][p] = LSE[((size_t)p * M + tok) * 8 + h]; a[k][p] = *(const u32x4*)(OP + (size_t)p * OP_STRIDE + (size_t)tok * 1024 + 8 * c8); } }
#pragma unroll
        for (int k = 0; k < 4; ++k) { const int id = id0 + k * stride, tok = id >> 7, c8 = id & 127;
            const float mx = fmaxf(l[k][0], fmaxf(l[k][1], l[k][2])); float w0 = __expf(l[k][0] - mx), w1 = __expf(l[k][1] - mx), w2 = __expf(l[k][2] - mx); const float inv = 1.0f / (w0 + w1 + w2); w0 *= inv; w1 *= inv; w2 *= inv;
            u32x4 o;
#pragma unroll
            for (int q = 0; q < 4; ++q) o[q] = cvt_pk_bf16(w0 * bf_lo(a[k][0][q]) + w1 * bf_lo(a[k][1][q]) + w2 * bf_lo(a[k][2][q]), w0 * bf_hi(a[k][0][q]) + w1 * bf_hi(a[k][1][q]) + w2 * bf_hi(a[k][2][q]));
            if (ok[k]) *(u32x4*)(Y + (size_t)tok * DM + 1024 + 8 * c8) = o; }
    }
}

__device__ __forceinline__ void p_router(const Ctx& c, int layer) {
    const int lane = c.lane, wave = c.wave, i = lane & 15, g = lane >> 4, NU = M / 16;
    constexpr int XP = 4112, XBUF = 16 * XP;
    LAS float* red = (LAS float*)(c.lds + 2 * XBUF); LAS float* ssq = red + 2048;
    const float* gnf = c.norm_ffn + layer * DM;
    const float* gn = gnf + 256 * wave + 4 * g;
    const float* R = c.router + (size_t)layer * DM * NE + (size_t)(256 * wave + 4 * g) * NE + i;
    float rg[64];
#pragma unroll
    for (int kk = 0; kk < 16; ++kk) { const f32x4 g4 = *(const f32x4*)(gn + 16 * kk);
#pragma unroll
        for (int s = 0; s < 4; ++s) rg[4 * kk + s] = R[(size_t)(16 * kk + s) * NE] * g4[s]; }
    const unsigned char* XR = c.ws + WS_XRES;
#define RT_ISSUE(uu, bb) do { _Pragma("unroll") for (int _j = 0; _j < 8; ++_j) { const int _p = 8 * wave + _j; \
        __builtin_amdgcn_global_load_lds((const unsigned*)(XR + ((size_t)(uu) * 16 + (_p >> 2)) * 4096 + (_p & 3) * 1024 + lane * 16), (LAS unsigned*)(c.lds + (bb) * XBUF + (_p >> 2) * XP + (_p & 3) * 1024), 16, 0, 0); } } while (0)
    __syncthreads();
    int u = c.bid, b = 0;
    if (u < NU) RT_ISSUE(u, 0);
    for (; u < NU; u += c.G, b ^= 1) {
        const int row0 = u * 16;
        asm volatile("s_waitcnt vmcnt(0)" ::: "memory"); __syncthreads();
        if (u + c.G < NU) RT_ISSUE(u + c.G, b ^ 1);
        const LAS unsigned char* xb = c.lds + b * XBUF + i * XP + (256 * wave + 4 * g) * 2;
        float ss = 0.f; f32x4 acc0 = {0.f, 0.f, 0.f, 0.f}, acc1 = {0.f, 0.f, 0.f, 0.f};
#pragma unroll
        for (int kk = 0; kk < 16; ++kk) { const u32x2 w = *(const LAS u32x2*)(xb + 32 * kk); const float x0 = bf_lo(w.x), x1 = bf_hi(w.x), x2 = bf_lo(w.y), x3 = bf_hi(w.y);
            ss += (x0 * x0 + x1 * x1) + (x2 * x2 + x3 * x3);
            acc0 = __builtin_amdgcn_mfma_f32_16x16x4f32(x0, rg[4 * kk + 0], acc0, 0, 0, 0); acc1 = __builtin_amdgcn_mfma_f32_16x16x4f32(x1, rg[4 * kk + 1], acc1, 0, 0, 0);
            acc0 = __builtin_amdgcn_mfma_f32_16x16x4f32(x2, rg[4 * kk + 2], acc0, 0, 0, 0); acc1 = __builtin_amdgcn_mfma_f32_16x16x4f32(x3, rg[4 * kk + 3], acc1, 0, 0, 0); }
        const f32x4 acc = acc0 + acc1;
        ss += shx(ss, 16, lane); ss += shx(ss, 32, lane);
#pragma unroll
        for (int r = 0; r < 4; ++r) red[wave * 256 + (4 * g + r) * 16 + i] = acc[r];
        if (g == 0) ssq[wave * 16 + i] = ss;
        __syncthreads();
#pragma unroll
        for (int j = 0; j < 4; ++j) { const int cid = c.tid + 512 * j, row = cid >> 7, c16 = cid & 127; float tot = 0.f;
#pragma unroll
            for (int w = 0; w < 8; ++w) tot += ssq[w * 16 + row];
            const float rstd = 1.0f / sqrtf(tot * (1.0f / DM) + RMS_EPS);
            const LAS unsigned char* xs = c.lds + b * XBUF + row * XP + c16 * 32;
            const u32x4 wa = *(const LAS u32x4*)xs, wb = *(const LAS u32x4*)(xs + 16);
            u32x4 o;
#pragma unroll
            for (int q = 0; q < 4; ++q) { const unsigned wq0 = q < 2 ? wa[2 * q] : wb[2 * q - 4], wq1 = q < 2 ? wa[2 * q + 1] : wb[2 * q - 3];
                const f32x4 g4 = *(const f32x4*)(gnf + 16 * c16 + 4 * q) * rstd; int p = 0;
                p = __builtin_amdgcn_cvt_pk_fp8_f32(__builtin_amdgcn_fmed3f(bf_lo(wq0) * g4.x, -448.f, 448.f), __builtin_amdgcn_fmed3f(bf_hi(wq0) * g4.y, -448.f, 448.f), p, false);
                p = __builtin_amdgcn_cvt_pk_fp8_f32(__builtin_amdgcn_fmed3f(bf_lo(wq1) * g4.z, -448.f, 448.f), __builtin_amdgcn_fmed3f(bf_hi(wq1) * g4.w, -448.f, 448.f), p, true);
                o[q] = (unsigned)p; }
            *(u32x4*)(c.ws + WS_H8 + (size_t)(row0 + row) * DM + 16 * c16) = o; }
        if (wave == 0) {
            float* AFF = (float*)(c.ws + WS_AFF);
#pragma unroll
            for (int r = 0; r < 4; ++r) { const int row = 4 * g + r; float t2 = 0.f, lg = 0.f;
#pragma unroll
                for (int w = 0; w < 8; ++w) { t2 += ssq[w * 16 + row]; lg += red[w * 256 + row * 16 + i]; }
                lg *= 1.0f / sqrtf(t2 * (1.0f / DM) + RMS_EPS);
                float mx = lg;
#pragma unroll
                for (int o = 1; o < 16; o <<= 1) mx = fmaxf(mx, shx(mx, o, lane));
                const float ex = __expf(lg - mx); float sm = ex;
#pragma unroll
                for (int o = 1; o < 16; o <<= 1) sm += shx(sm, o, lane);
                const int grow = row0 + row;
                AFF[((size_t)(grow >> 11) * NE + i) * SEQ + (grow & (SEQ - 1))] = ex / sm; }
        }
    }
#undef RT_ISSUE
    asm volatile("s_waitcnt vmcnt(0)" ::: "memory");
}

__device__ __forceinline__ void topk_unit(const Ctx& c, int w) {
    const int be = w, e = be >> 3, b = be & 7, lane = c.lane, wave = c.wave, tid = c.tid;
    LAS unsigned* wsum = (LAS unsigned*)c.lds;
    const u32x4 mine = *(const u32x4*)((const unsigned*)(c.ws + WS_AFF) + (size_t)(b * NE + e) * SEQ + 4 * tid);
    __syncthreads();
    unsigned T = 0u;
    for (int bit = 30; bit >= 0; --bit) {
        const unsigned cand = T | (1u << bit);
        int cnt = (int)(mine.x >= cand) + (int)(mine.y >= cand) + (int)(mine.z >= cand) + (int)(mine.w >= cand);
#pragma unroll
        for (int o = 1; o < 64; o <<= 1) cnt += shx(cnt, o, lane);
        if (lane == 0) wsum[(bit & 1) * 8 + wave] = (unsigned)cnt;
        __syncthreads();
        unsigned tot = 0u;
#pragma unroll
        for (int k = 0; k < 8; ++k) tot += wsum[(bit & 1) * 8 + k];
        if (tot >= (unsigned)CAP) T = cand;
    }
    unsigned gt[4], eq[4]; unsigned val = 0u;
#pragma unroll
    for (int k = 0; k < 4; ++k) { gt[k] = mine[k] > T ? 1u : 0u; eq[k] = mine[k] == T ? 1u : 0u; val += gt[k] + (eq[k] << 16); }
    unsigned incl = val;
#pragma unroll
    for (int o = 1; o < 64; o <<= 1) { const unsigned t = shup(incl, o, lane); if (lane >= o) incl += t; }
    if (lane == 63) wsum[16 + wave] = incl;
    __syncthreads();
    unsigned base = 0u, total = 0u;
#pragma unroll
    for (int k = 0; k < 8; ++k) { const unsigned t = wsum[16 + k]; total += t; if (k < wave) base += t; }
    const unsigned excl = base + incl - val, need = (unsigned)CAP - (total & 0xffffu);
    unsigned gtb = excl & 0xffffu, eqb = excl >> 16;
    int* SEL = (int*)(c.ws + WS_SEL); float* GATE = (float*)(c.ws + WS_GATE); int* IDX = (int*)(c.ws + WS_IDX);
#pragma unroll
    for (int k = 0; k < 4; ++k) { const int s = 4 * tid + k; const bool sel = gt[k] || (eq[k] && eqb < need); const unsigned slot = gtb + (eqb < need ? eqb : need);
        if (sel) { IDX[be * CAP + slot] = b * SEQ + s; GATE[be * CAP + slot] = __uint_as_float(mine[k]); }
        SEL[((size_t)b * SEQ + s) * NE + e] = sel ? (int)slot : -1;
        gtb += gt[k]; eqb += eq[k]; }
}

template <int FINAL>
__device__ __forceinline__ void p_combine(const Ctx& c, const float* gw) {
    const int lane = c.lane, stride = c.G * NWAVES; int m = c.bid * NWAVES + c.wave;
    if (m >= M) return;
    const unsigned char* YE = c.ws + WS_YE; const int* SEL = (const int*)(c.ws + WS_SEL);
    u32x4 xw[4], xn[4]; int selv, seln;
    { const bf16* xr = (const bf16*)(c.ws + WS_XRES) + (size_t)m * DM;
#pragma unroll
      for (int j = 0; j < 4; ++j) xw[j] = *(const u32x4*)(xr + 512 * j + 8 * lane);
      selv = SEL[(size_t)m * NE + (lane & 15)]; }
    for (;;) {
        const int mn = m + stride; const bool more = mn < M;
        if (more) { const bf16* xr = (const bf16*)(c.ws + WS_XRES) + (size_t)mn * DM;
#pragma unroll
            for (int j = 0; j < 4; ++j) xn[j] = *(const u32x4*)(xr + 512 * j + 8 * lane);
            seln = SEL[(size_t)mn * NE + (lane & 15)]; }
        const int b = m >> 11;
        f32x4 v[8];
#pragma unroll
        for (int j = 0; j < 4; ++j) { const u32x4 w = xw[j];
            v[2 * j] = (f32x4){bf_lo(w.x), bf_hi(w.x), bf_lo(w.y), bf_hi(w.y)}; v[2 * j + 1] = (f32x4){bf_lo(w.z), bf_hi(w.z), bf_lo(w.w), bf_hi(w.w)}; }
        unsigned mask = (unsigned)__builtin_amdgcn_ballot_w64(selv >= 0) & 0xffffu;
        while (mask) {
            u32x2 y[4][4]; int have[4];
#pragma unroll
            for (int t = 0; t < 4; ++t) { have[t] = mask != 0u;
                if (have[t]) { const int e = __builtin_ctz(mask); mask &= mask - 1u; const int slot = __builtin_amdgcn_readlane(selv, e);
                    const unsigned char* yr = YE + (size_t)((e * 8 + b) * CAP + slot) * DM + 8 * lane;
#pragma unroll
                    for (int j = 0; j < 4; ++j) y[t][j] = *(const u32x2*)(yr + 512 * j); } }
#pragma unroll
            for (int t = 0; t < 4; ++t) if (have[t]) {
#pragma unroll
                for (int j = 0; j < 4; ++j) { const u32x2 yy = y[t][j]; constexpr float YI = 1.0f / YE_SCALE;
                    const auto a0 = __builtin_amdgcn_cvt_pk_f32_fp8((int)yy.x, false), a1 = __builtin_amdgcn_cvt_pk_f32_fp8((int)yy.x, true), a2 = __builtin_amdgcn_cvt_pk_f32_fp8((int)yy.y, false), a3 = __builtin_amdgcn_cvt_pk_f32_fp8((int)yy.y, true);
                    v[2 * j].x += a0[0] * YI; v[2 * j].y += a0[1] * YI; v[2 * j].z += a1[0] * YI; v[2 * j].w += a1[1] * YI;
                    v[2 * j + 1].x += a2[0] * YI; v[2 * j + 1].y += a2[1] * YI; v[2 * j + 1].z += a3[0] * YI; v[2 * j + 1].w += a3[1] * YI; } }
        }
        float ss = 0.f;
#pragma unroll
        for (int j = 0; j < 8; ++j) ss += (v[j].x * v[j].x + v[j].y * v[j].y) + (v[j].z * v[j].z + v[j].w * v[j].w);
        const float rstd = 1.0f / sqrtf(wave_sum(ss, lane) * (1.0f / DM) + RMS_EPS);
#pragma unroll
        for (int j = 0; j < 4; ++j) {
            const f32x4 g0 = *(const f32x4*)(gw + 512 * j + 8 * lane), g1 = *(const f32x4*)(gw + 512 * j + 8 * lane + 4);
            const f32x4 a = v[2 * j] * rstd * g0, b2 = v[2 * j + 1] * rstd * g1;
            if (FINAL) { float* orow = c.out + (size_t)m * DM + 512 * j + 8 * lane; *(f32x4*)orow = a; *(f32x4*)(orow + 4) = b2; }
            else { { u32x4 xo; xo.x = cvt_pk_bf16(v[2 * j].x, v[2 * j].y); xo.y = cvt_pk_bf16(v[2 * j].z, v[2 * j].w); xo.z = cvt_pk_bf16(v[2 * j + 1].x, v[2 * j + 1].y); xo.w = cvt_pk_bf16(v[2 * j + 1].z, v[2 * j + 1].w);
                    *(u32x4*)((bf16*)(c.ws + WS_XRES) + (size_t)m * DM + 512 * j + 8 * lane) = xo; }
                u32x4 o; o.x = cvt_pk_bf16(a.x, a.y); o.y = cvt_pk_bf16(a.z, a.w); o.z = cvt_pk_bf16(b2.x, b2.y); o.w = cvt_pk_bf16(b2.z, b2.w);
                *(u32x4*)((bf16*)(c.ws + WS_H) + (size_t)m * DM + 512 * j + 8 * lane) = o;
                int p0 = 0, p1 = 0;
                p0 = __builtin_amdgcn_cvt_pk_fp8_f32(__builtin_amdgcn_fmed3f(a.x, -448.f, 448.f), __builtin_amdgcn_fmed3f(a.y, -448.f, 448.f), p0, false); p0 = __builtin_amdgcn_cvt_pk_fp8_f32(__builtin_amdgcn_fmed3f(a.z, -448.f, 448.f), __builtin_amdgcn_fmed3f(a.w, -448.f, 448.f), p0, true);
                p1 = __builtin_amdgcn_cvt_pk_fp8_f32(__builtin_amdgcn_fmed3f(b2.x, -448.f, 448.f), __builtin_amdgcn_fmed3f(b2.y, -448.f, 448.f), p1, false); p1 = __builtin_amdgcn_cvt_pk_fp8_f32(__builtin_amdgcn_fmed3f(b2.z, -448.f, 448.f), __builtin_amdgcn_fmed3f(b2.w, -448.f, 448.f), p1, true);
                u32x2 w8; w8.x = (unsigned)p0; w8.y = (unsigned)p1; *(u32x2*)(c.ws + WS_H8 + (size_t)m * DM + 512 * j + 8 * lane) = w8; } }
        if (!more) break;
        m = mn; selv = seln;
#pragma unroll
        for (int j = 0; j < 4; ++j) xw[j] = xn[j];
    }
}

typedef __attribute__((address_space(4))) const unsigned char* kaptr_t;
__device__ __forceinline__ bool phase_enter(Ctx& c) { const int ln = lane_now(); int w = c.wave0; asm volatile("" : "+s"(w)); c.wave = w; c.lane = ln; c.tid = w * 64 + ln;
    kaptr_t ka = (kaptr_t)__builtin_amdgcn_kernarg_segment_ptr(); asm volatile("" : "+s"(ka));
    typedef const float* fptr_t; typedef float* mfptr_t; typedef unsigned char* ucptr_t; typedef __attribute__((address_space(4))) const fptr_t* inptr_t; inptr_t in = (inptr_t)ka;
    c.x = in[0]; c.norm_mix = in[1]; c.norm_ffn = in[2]; c.norm_final = in[3]; c.w_in_ab = in[4]; c.a_v_norm = in[5]; c.a_sw = in[6]; c.a_sb = in[7];
    c.b_rpb = in[8]; c.w_out_ab = in[9]; c.w_in_cd = in[10]; c.c_conv = in[11]; c.w_out_cd = in[12]; c.router = in[13]; c.w_gate = in[14]; c.w_up = in[15]; c.w_down = in[16];
    c.out = *(__attribute__((address_space(4))) const mfptr_t*)(ka + 136); c.ws = *(__attribute__((address_space(4))) const ucptr_t*)(ka + 144);
    return true; }
constexpr int NPH = 18;
struct Args { const float* in[17]; float* out; unsigned char* ws; int ph_lo, ph_hi; };
__global__ void __launch_bounds__(NTHR, 2) mk_fwd(Args args) {
    extern __shared__ __attribute__((aligned(16))) unsigned char lds_raw[];
    Ctx c;
    c.lds = (LAS unsigned char*)lds_raw;
    c.tid = threadIdx.x; c.lane = c.tid & 63; c.wave = __builtin_amdgcn_readfirstlane(c.tid >> 6); c.wave0 = c.wave; c.G = gridDim.x; c.bid = blockIdx.x;
    c.ws = args.ws;
    static_assert(sizeof(Args) == 160, "phase_enter reads the kernarg segment by offset");
    volatile LAS unsigned* MISC = (volatile LAS unsigned*)(c.lds + MISC_OFF);
    for (int u = c.tid; u < (LDS_BYTES - LDSCTL_OFF) / 4; u += NTHR) ((LAS unsigned*)(c.lds + LDSCTL_OFF))[u] = 0u;
    __syncthreads();
    unsigned* barw = (unsigned*)(c.ws + WS_CTL) + 1024;
    XcdBarrier bar; bar.bar = barw; bar.x = 0; bar.st = nullptr; bar.wave = c.wave0;
    const int lo = args.ph_lo, hi = args.ph_hi;
#define NOST ((hi - lo == 1) ? (MK_PROBE_NOSTORE) : 0)
    if (hi - lo > 1) bar = xcd_barrier_post(barw, MISC + 8, c.wave0);
#define IN(k) (lo <= (k) && (k) < hi && phase_enter(c))
#define PH(k) for (int rep_ = 0; rep_ < (((k) == MK_REPEAT) ? 2 : 1); ++rep_) if (IN(k))
#define INR(k) (lo <= (k) && (k) < hi)
#define SEAM(k) do { if (INR(k) && INR((k) + 1)) { xcd_barrier(bar); if (MK_DOUBLE_BAR) xcd_barrier(bar); } } while (0)
#define H ((bf16*)(c.ws + WS_H))
#define P ((bf16*)(c.ws + WS_P))
#define YC ((bf16*)(c.ws + WS_YCAT))
#define XRES ((bf16*)(c.ws + WS_XRES))

    PH(0) { p_prologue(c); } SEAM(0);
    for (int layer = 0; layer < 2; ++layer) {
        const int pb = 1 + 8 * layer;
        if (layer == 0) {
            PH(1) { conv_job_half(c, 1, 0); conv_job_half(c, 4, 0); __syncthreads();
                { pg8::Gemm g{H, (const bf16*)(c.ws + WS_WIN0), M, 2048, DM}; pg8::Order S; S.init(M, 2048, c.G, c.bid, 0);
                  pg8::EpiBf16 E{P, IN_AB, 8, 1 << 30, (bf16*)(c.ws + WS_QKV), QKV_STRIDE, 1.0f, NOST}; pg8::gemm_phase<pg8::EpiBf16, pg8::Order, MK_ALIGN, MK_SP2>(c.lds, g, S, E, c.tid); }
                { pg8::Gemm g{(const bf16*)(c.ws + WS_H8), (const bf16*)(c.ws + WS_WIN8), M, 3072, DM}; pg8::Order S; S.init(M, 3072, c.G, c.bid, 0);
                  { LAS int* tab = (LAS int*)(c.lds + RING_BYTES); S.tab = tab; pg8::Unit uu;
#pragma unroll 1
                    for (int kq = 0; kq < 15 && S.next(kq, uu); ++kq) if (c.tid < 256) tab[kq * 256 + c.tid] = uu.pm * 256 + c.tid;
                    __syncthreads(); }
                  pg8::EpiBf16 E{P, IN_AB, 0, 0, (bf16*)(c.ws + WS_QKV), QKV_STRIDE, 1.0f / W8_SCALE, NOST}; pg8::gemm_phase<pg8::EpiBf16, pg8::Order, MK_ALIGN, MK_SP2, true, true>(c.lds, g, S, E, c.tid); }
                conv_job_half(c, 1, 1); conv_job_half(c, 4, 1); } SEAM(1);
            PH(2) { for (int rp2 = 0; rp2 < (MK_REPEAT == 20 ? 2 : 1); ++rp2) for (int u = c.bid; u < 256; u += c.G) sgu_unit(c, u); for (int rp2 = 0; rp2 < (MK_REPEAT == 21 ? 2 : 1); ++rp2) p_natten(c); } SEAM(2);
            PH(3) { conv_job_half(c, 5, 0); __syncthreads(); pg8::Gemm g{YC, (const bf16*)(c.ws + WS_WOUT0), M, DM, DM}; pg8::Order S; S.init(M, DM, c.G, c.bid, 0);
                pg8::EpiResidB E{c.x, XRES, DM, 1}; pg8::gemm_phase<pg8::EpiResidB, pg8::Order, MK_ALIGN, MK_SP2>(c.lds, g, S, E, c.tid); conv_job_half(c, 5, 1); } SEAM(3);
        } else {
            PH(8) { p_combine<0>(c, c.norm_mix + DM); } SEAM(8);
            PH(9) { { pg8::Gemm g{H, (const bf16*)(c.ws + WS_WIN1), M, 3072, DM}; pg8::Order S; S.init(M, 3072, c.G, c.bid, 0);
                  pg8::EpiBf16 E{P, IN_CD, 0, 1 << 30, (bf16*)(c.ws + WS_QKV), QKV_STRIDE, 1.0f, NOST}; pg8::gemm_phase<pg8::EpiBf16, pg8::Order, MK_ALIGN, MK_SP2>(c.lds, g, S, E, c.tid); }
                { pg8::Gemm g{(const bf16*)(c.ws + WS_H8), (const bf16*)(c.ws + WS_WIN8 + 6 * MiB), M, 3072, DM}; pg8::Order S; S.init(M, 3072, c.G, c.bid, 0);
                  { LAS int* tab = (LAS int*)(c.lds + RING_BYTES); S.tab = tab; pg8::Unit uu;
#pragma unroll 1
                    for (int kq = 0; kq < 15 && S.next(kq, uu); ++kq) if (c.tid < 256) tab[kq * 256 + c.tid] = uu.pm * 256 + c.tid;
                    __syncthreads(); }
                  pg8::EpiBf16 E{P, IN_CD, 0, 0, (bf16*)(c.ws + WS_QKV), QKV_STRIDE, 1.0f / W8_SCALE, NOST}; pg8::gemm_phase<pg8::EpiBf16, pg8::Order, MK_ALIGN, MK_SP2, true, true>(c.lds, g, S, E, c.tid); } } SEAM(9);
            PH(10) { for (int rp2 = 0; rp2 < (MK_REPEAT == 100 ? 2 : 1); ++rp2) for (int u = c.bid; u < 256; u += c.G) conv_unit(c, u); for (int rp2 = 0; rp2 < (MK_REPEAT == 101 ? 2 : 1); ++rp2) p_dilated(c); } SEAM(10);
            PH(11) { p_merge(c); } SEAM(11);
            PH(12) { pg8::Gemm g{YC, (const bf16*)(c.ws + WS_WOUT1), M, DM, DM}; pg8::Order S; S.init(M, DM, c.G, c.bid, 0);
                pg8::EpiResidB E{XRES, XRES, DM, 0}; pg8::gemm_phase<pg8::EpiResidB, pg8::Order, MK_ALIGN, MK_SP2>(c.lds, g, S, E, c.tid); } SEAM(12);
        }
        const int pr = layer == 0 ? 4 : 13;
        PH(pr) { p_router(c, layer); } SEAM(pr);
        PH(pr + 1) { for (int u = c.bid; u < 128; u += c.G) topk_unit(c, u); } SEAM(pr + 1);
        PH(pr + 2) { if (layer == 0) { conv_job_half(c, 2, 0); conv_job_half(c, 3, 0); conv_job_half(c, 6, 0); } __syncthreads();
            pg8::Gemm g{(const bf16*)(c.ws + WS_H8), (const bf16*)(c.ws + WS_WGU + (size_t)layer * 128 * MiB), MOE_ROWS, 4096, DM};     pg8::Order S; S.init(MOE_ROWS, 4096, c.G, c.bid, 1);
            { LAS int* tab = (LAS int*)(c.lds + RING_BYTES); S.tab = tab; const int* IDX = (const int*)(c.ws + WS_IDX); pg8::Unit uu;
#pragma unroll 1
                for (int k = c.wave; k < 15 && S.next(k, uu); k += NWAVES) {
                    typedef int i32x4 __attribute__((ext_vector_type(4))); const i32x4 v = *(const i32x4*)(IDX + uu.pm * 256 + 4 * c.lane); *(LAS i32x4*)(tab + k * 256 + 4 * c.lane) = v; }
                __syncthreads(); }
            pg8::EpiSwiglu E{c.ws + WS_HID, DE, 1.0f / W8_SCALE, NOST};
#if MK_PROBE_NOSTORE >= 4
            if (hi - lo == 1) pg8::gemm_phase<pg8::EpiSwiglu, pg8::Order, MK_ALIGN, MK_SP2, true, true, MK_PROBE_NOSTORE>(c.lds, g, S, E, c.tid); else
#endif
            pg8::gemm_phase<pg8::EpiSwiglu, pg8::Order, MK_ALIGN, MK_SP2, true, true>(c.lds, g, S, E, c.tid); if (layer == 0) { conv_job_half(c, 2, 1); conv_job_half(c, 3, 1); conv_job_half(c, 6, 1); } } SEAM(pr + 2);
        PH(pr + 3) { if (layer == 0) conv_job_half(c, 7, 0); __syncthreads(); pg8::Gemm g{(const bf16*)(c.ws + WS_HID), (const bf16*)(c.ws + WS_WDN + (size_t)layer * 64 * MiB), MOE_ROWS, DM, DE};   pg8::Order S; S.init(MOE_ROWS, DM, c.G, c.bid, 1);
            { LAS int* tab = (LAS int*)(c.lds + RING_BYTES); S.tab = tab; pg8::Unit uu;
#pragma unroll 1
                for (int k = 0; k < 15 && S.next(k, uu); ++k) if (c.tid < 256) tab[k * 256 + c.tid] = uu.pm * 256 + c.tid;
                __syncthreads(); }
            pg8::EpiDown E{c.ws + WS_YE, DM, (const float*)(c.ws + WS_GATE), YE_SCALE / W8_SCALE, NOST}; pg8::gemm_phase<pg8::EpiDown, pg8::Order, MK_ALIGN, MK_SP2, true, true>(c.lds, g, S, E, c.tid); if (layer == 0) conv_job_half(c, 7, 1); } SEAM(pr + 3);
        (void)pb;
    }
    PH(17) { p_combine<1>(c, c.norm_final); }
#undef IN
#undef H
#undef P
#undef YC
#undef XRES
#undef PH
#undef INR
#undef SEAM
}

extern "C" void kernel_launch(void* const* d_in, const int* in_sizes, int n_in, void* d_out, int out_size, void* d_ws, size_t ws_size, hipStream_t stream) {
    static int grid = 0;
    if (grid == 0) {
        if (n_in != 17 || out_size != M * DM || ws_size < WS_END) { fprintf(stderr, "kernel_launch: unexpected shapes (n_in %d out %d ws %zu)\n", n_in, out_size, ws_size); grid = -1; return; }
        int dev = 0, cus = 0, per_cu = 0;
        if (hipGetDevice(&dev) != hipSuccess || hipDeviceGetAttribute(&cus, hipDeviceAttributeMultiprocessorCount, dev) != hipSuccess) { grid = -1; return; }
        if (hipFuncSetAttribute((const void*)mk_fwd, hipFuncAttributeMaxDynamicSharedMemorySize, LDS_BYTES) != hipSuccess) { fprintf(stderr, "kernel_launch: hipFuncSetAttribute failed\n"); grid = -1; return; }
        if (hipOccupancyMaxActiveBlocksPerMultiprocessor(&per_cu, (const void*)mk_fwd, NTHR, LDS_BYTES) != hipSuccess || per_cu < 1) { fprintf(stderr, "kernel_launch: occupancy query says %d\n", per_cu); (void)hipGetLastError(); }
        grid = cus;
    }
    if (grid < 0) return;
    (void)hipMemsetAsync((char*)d_ws + WS_CTL, 0, CTL_ZERO_BYTES, stream);
    Args a{};
    for (int i = 0; i < 17; ++i) a.in[i] = (const float*)d_in[i];
    a.out = (float*)d_out; a.ws = (unsigned char*)d_ws;
#if MK_N_LAUNCHES == 1
    a.ph_lo = 0; a.ph_hi = NPH;
    hipLaunchKernelGGL(mk_fwd, dim3(grid), dim3(NTHR), LDS_BYTES, stream, a);
#if MK_PROBE_PHASE >= 0
    a.ph_lo = MK_PROBE_PHASE; a.ph_hi = MK_PROBE_PHASE + 1;
    hipLaunchKernelGGL(mk_fwd, dim3(grid), dim3(NTHR), LDS_BYTES, stream, a);
#endif
#else
    for (int p = 0; p < NPH; ++p) { a.ph_lo = p; a.ph_hi = p + 1; hipLaunchKernelGGL(mk_fwd, dim3(grid), dim3(NTHR), LDS_BYTES, stream, a); }
#endif
}
```

```cpp
#include <hip/hip_runtime.h>
#include <cstdio>
#include <cstdint>
#ifndef MK_N_LAUNCHES
#define MK_N_LAUNCHES 1
#endif
#ifndef MK_REPEAT
#define MK_REPEAT (-1)
#endif
#ifndef MK_DIL_REPS
#define MK_DIL_REPS 1
#endif
#ifndef MK_CONV_PROBE
#define MK_CONV_PROBE 0
#endif
#ifndef MK_SP2
#define MK_SP2 true
#endif
#ifndef MK_ALIGN
#define MK_ALIGN true
#endif
#ifndef MK_EARLY_INV
#define MK_EARLY_INV 1
#endif
#ifndef MK_DOUBLE_BAR
#define MK_DOUBLE_BAR 0
#endif
#ifndef MK_PROBE_PHASE
#define MK_PROBE_PHASE (-1)
#endif
#ifndef MK_PROBE_NOSTORE
#define MK_PROBE_NOSTORE 0
#endif
#ifndef MK_CONV_SKEW
#define MK_CONV_SKEW 0
#endif
namespace pg8 {
#define PG8_LAS __attribute__((address_space(3)))
typedef unsigned short bf16_t;
typedef short bf16x8 __attribute__((ext_vector_type(8)));
typedef float f32x4 __attribute__((ext_vector_type(4)));
typedef int i32x8 __attribute__((ext_vector_type(8)));
typedef short bf16x16 __attribute__((ext_vector_type(16)));
typedef unsigned u32x4 __attribute__((ext_vector_type(4)));
constexpr int BM = 256, BK = 64, HALF = 128, HTB = HALF * BK * 2  , STAGE_BYTES = 8 * HTB, NXCD = 8, WGM = 4;

__host__ __device__ __forceinline__ int lds_byte(int r, int c) { const int st = (r >> 4) * 2 + (c >> 5), rr = r & 15, cc = c & 31, ob = rr * 64 + cc * 2; return st * 1024 + (ob ^ (((ob >> 9) & 1) << 5)); }
__host__ __device__ __forceinline__ void stage_rc(int b, int& R, int& C) { const int st = b / 1024, sb = b % 1024, swz = sb ^ (((sb >> 9) & 1) << 5); R = (st >> 1) * 16 + swz / 64; C = (st & 1) * 32 + (swz % 64) / 2; }
__host__ __device__ __forceinline__ int perm32(int rho) { const int n = rho >> 4, i = rho & 15; return 8 * (i >> 2) + 4 * n + (i & 3); }


struct Unit { int pm, pn, pb; };
struct Gemm { const bf16_t* A; const bf16_t* Bt; int M, N, K; };

struct Order {
    int nM, nN, nwg, G, c, moe; const PG8_LAS int* tab;
    __host__ __device__ __forceinline__ void init(int M, int N, int G_, int c_, int moe_) { nM = M / BM; nN = N / BM; nwg = nM * nN; G = G_; c = c_; moe = moe_; tab = nullptr; }
    __host__ __device__ __forceinline__ bool next(int i, Unit& u) const {
        const long L = (long)i * G + c; if (L >= nwg) return false;
        int wgid = (int)L; { const int q = nwg / NXCD, r = nwg % NXCD, xcd = wgid % NXCD, off = wgid / NXCD; wgid = (xcd < r ? xcd * (q + 1) : r * (q + 1) + (xcd - r) * q) + off; }
        const int nig = WGM * nN, gid = wgid / nig, fm = gid * WGM, gsz = (nM - fm) < WGM ? (nM - fm) : WGM;
        u.pm = fm + ((wgid % nig) % gsz); u.pn = (wgid % nig) / gsz; u.pb = moe ? (u.pm >> 3) * nN + u.pn : u.pn; return true;
    }
    __device__ __forceinline__ void a_ready(const Unit&) const {}
    __device__ __forceinline__ void done(const Unit&) const {}
};

typedef float f32x2_t __attribute__((ext_vector_type(2))); typedef __bf16 bf16x2_t __attribute__((ext_vector_type(2)));
__device__ __forceinline__ unsigned cvt_pk_bf16(float lo, float hi) { f32x2_t v = {lo, hi}; bf16x2_t b = __builtin_convertvector(v, bf16x2_t); return __builtin_bit_cast(unsigned, b); }
__device__ __forceinline__ float gelu_tanh(float x) {
    const float t = x * (1.5957691216057308f + 0.07135481282636639f * x * x);
    return x * __builtin_amdgcn_rcpf(1.0f + __builtin_amdgcn_exp2f(-1.4426950408889634f * t));
}
__device__ __forceinline__ float silu_f(float x) { return x * __builtin_amdgcn_rcpf(1.0f + __builtin_amdgcn_exp2f(-1.4426950408889634f * x)); }

#if MK_PROBE_NOSTORE
#define PG8_ST(x) do { if (nost != 1) { x; } } while (0)
#else
#define PG8_ST(x) do { x; } while (0)
#endif
struct EpiBf16 {
    static constexpr bool PERM = true, AFTER_DRAIN = false;
    bf16_t* O; int ldc; int gelu_tiles; int qkv_tile0; bf16_t* QKV; size_t qkv_stride; float sc; int nost;
    __device__ __forceinline__ void operator()(const f32x4 (&acc)[2][2][4][2], const Unit& u, int wr, int wc, int fr, int fq) const {
        const int row0 = u.pm * BM + wr * 64 + fr, col0 = u.pn * BM + wc * 32 + 8 * fq; const bool act = u.pn < gelu_tiles, hm = u.pn >= qkv_tile0;
        const int t = u.pn - qkv_tile0, which = t >> 2, hp = t & 3;
#pragma unroll
        for (int ai = 0; ai < 2; ++ai)
#pragma unroll
            for (int m = 0; m < 4; ++m) { const int row = row0 + ai * HALF + m * 16;
                bf16_t* rowp = O + (size_t)row * ldc + col0; size_t bjstep = HALF;
                if (hm) { rowp = QKV + (size_t)which * qkv_stride + ((size_t)((row >> 11) * 8 + 2 * hp) * 2048 + (row & 2047)) * 128 + wc * 32 + 8 * fq; bjstep = (size_t)2048 * 128; }
#pragma unroll
                for (int bj = 0; bj < 2; ++bj) { f32x4 v0 = acc[ai][bj][m][0] * sc, v1 = acc[ai][bj][m][1] * sc;
                    if (act) {
#pragma unroll
                        for (int j = 0; j < 4; ++j) { v0[j] = gelu_tanh(v0[j]); v1[j] = gelu_tanh(v1[j]); } }
                    u32x4 w; w.x = cvt_pk_bf16(v0[0], v0[1]); w.y = cvt_pk_bf16(v0[2], v0[3]); w.z = cvt_pk_bf16(v1[0], v1[1]); w.w = cvt_pk_bf16(v1[2], v1[3]);
                    PG8_ST(*(u32x4*)(rowp + bj * bjstep) = w); } }
    }
};
struct EpiResid {
    static constexpr bool PERM = false, AFTER_DRAIN = false;
    const float* base; float* out; int ldc;
    __device__ __forceinline__ void operator()(const f32x4 (&acc)[2][2][4][2], const Unit& u, int wr, int wc, int fr, int fq) const {
        const int row0 = u.pm * BM + wr * 64 + fr, col0 = u.pn * BM + wc * 32 + 4 * fq;
#pragma unroll
        for (int ai = 0; ai < 2; ++ai)
#pragma unroll
            for (int m = 0; m < 4; ++m) { const size_t off = (size_t)(row0 + ai * HALF + m * 16) * ldc + col0;
                f32x4 bs[2][2];
#pragma unroll
                for (int bj = 0; bj < 2; ++bj)
#pragma unroll
                    for (int n = 0; n < 2; ++n) bs[bj][n] = *(const f32x4*)(base + off + bj * HALF + n * 16);
#pragma unroll
                for (int bj = 0; bj < 2; ++bj)
#pragma unroll
                    for (int n = 0; n < 2; ++n) *(f32x4*)(out + off + bj * HALF + n * 16) = bs[bj][n] + acc[ai][bj][m][n];
                asm volatile("" ::: "memory"); }
    }
};
struct EpiResidB {
    static constexpr bool PERM = true, AFTER_DRAIN = false;
    const void* base; bf16_t* out; int ldc; int base_f32; int nost = 0;
    __device__ __forceinline__ void operator()(const f32x4 (&acc)[2][2][4][2], const Unit& u, int wr, int wc, int fr, int fq) const {
        const int row0 = u.pm * BM + wr * 64 + fr, col0 = u.pn * BM + wc * 32 + 8 * fq;
#pragma unroll
        for (int ai = 0; ai < 2; ++ai)
#pragma unroll
            for (int m = 0; m < 4; ++m) { const size_t off = (size_t)(row0 + ai * HALF + m * 16) * ldc + col0;
                f32x4 b0[2], b1[2];
                if (base_f32) {
#pragma unroll
                    for (int bj = 0; bj < 2; ++bj) { b0[bj] = *(const f32x4*)((const float*)base + off + bj * HALF); b1[bj] = *(const f32x4*)((const float*)base + off + bj * HALF + 4); }
                } else {
#pragma unroll
                    for (int bj = 0; bj < 2; ++bj) { const u32x4 w = *(const u32x4*)((const bf16_t*)base + off + bj * HALF);
                        b0[bj] = (f32x4){__uint_as_float(w.x << 16), __uint_as_float(w.x & 0xffff0000u), __uint_as_float(w.y << 16), __uint_as_float(w.y & 0xffff0000u)};
                        b1[bj] = (f32x4){__uint_as_float(w.z << 16), __uint_as_float(w.z & 0xffff0000u), __uint_as_float(w.w << 16), __uint_as_float(w.w & 0xffff0000u)}; }
                }
#pragma unroll
                for (int bj = 0; bj < 2; ++bj) { const f32x4 v0 = b0[bj] + acc[ai][bj][m][0], v1 = b1[bj] + acc[ai][bj][m][1];
                    u32x4 w; w.x = cvt_pk_bf16(v0[0], v0[1]); w.y = cvt_pk_bf16(v0[2], v0[3]); w.z = cvt_pk_bf16(v1[0], v1[1]); w.w = cvt_pk_bf16(v1[2], v1[3]);
                    *(u32x4*)(out + off + bj * HALF) = w; }
                asm volatile("" ::: "memory"); }
    }
};
struct EpiSwiglu {
    static constexpr bool PERM = true, AFTER_DRAIN = false;
    unsigned char* O; int ldc; float sc; int nost;
    __device__ __forceinline__ void operator()(const f32x4 (&acc)[2][2][4][2], const Unit& u, int wr, int wc, int fr, int fq) const {
        const int row0 = u.pm * BM + wr * 64 + fr, col0 = u.pn * HALF + wc * 32 + 8 * fq;
#pragma unroll
        for (int ai = 0; ai < 2; ++ai)
#pragma unroll
            for (int m = 0; m < 4; ++m) { unsigned char* rowp = O + (size_t)(row0 + ai * HALF + m * 16) * ldc + col0;
                f32x4 h0, h1;
#pragma unroll
                for (int j = 0; j < 4; ++j) { h0[j] = __builtin_amdgcn_fmed3f(silu_f(acc[ai][0][m][0][j] * sc) * (acc[ai][1][m][0][j] * sc), -448.f, 448.f); h1[j] = __builtin_amdgcn_fmed3f(silu_f(acc[ai][0][m][1][j] * sc) * (acc[ai][1][m][1][j] * sc), -448.f, 448.f); }
                int p0 = 0, p1 = 0;
                p0 = __builtin_amdgcn_cvt_pk_fp8_f32(h0[0], h0[1], p0, false); p0 = __builtin_amdgcn_cvt_pk_fp8_f32(h0[2], h0[3], p0, true);
                p1 = __builtin_amdgcn_cvt_pk_fp8_f32(h1[0], h1[1], p1, false); p1 = __builtin_amdgcn_cvt_pk_fp8_f32(h1[2], h1[3], p1, true);
                typedef unsigned u32x2v __attribute__((ext_vector_type(2))); u32x2v w; w.x = (unsigned)p0; w.y = (unsigned)p1;
                PG8_ST(*(u32x2v*)rowp = w); }
    }
};
struct EpiDown {
    static constexpr bool PERM = true, AFTER_DRAIN = false;
    unsigned char* O; int ldc; const float* gate; float sc; int nost;
    __device__ __forceinline__ void operator()(const f32x4 (&acc)[2][2][4][2], const Unit& u, int wr, int wc, int fr, int fq) const {
        const int row0 = u.pm * BM + wr * 64 + fr, col0 = u.pn * BM + wc * 32 + 8 * fq;
#pragma unroll
        for (int ai = 0; ai < 2; ++ai)
#pragma unroll
            for (int m = 0; m < 4; ++m) { const int row = row0 + ai * HALF + m * 16; const float gt = gate[row] * sc; unsigned char* rowp = O + (size_t)row * ldc + col0;
#pragma unroll
                for (int bj = 0; bj < 2; ++bj) { f32x4 v0 = acc[ai][bj][m][0] * gt, v1 = acc[ai][bj][m][1] * gt;
#pragma unroll
                    for (int j = 0; j < 4; ++j) { v0[j] = __builtin_amdgcn_fmed3f(v0[j], -448.f, 448.f); v1[j] = __builtin_amdgcn_fmed3f(v1[j], -448.f, 448.f); }
                    int p0 = 0, p1 = 0;
                    p0 = __builtin_amdgcn_cvt_pk_fp8_f32(v0[0], v0[1], p0, false); p0 = __builtin_amdgcn_cvt_pk_fp8_f32(v0[2], v0[3], p0, true);
                    p1 = __builtin_amdgcn_cvt_pk_fp8_f32(v1[0], v1[1], p1, false); p1 = __builtin_amdgcn_cvt_pk_fp8_f32(v1[2], v1[3], p1, true);
                    typedef unsigned u32x2v __attribute__((ext_vector_type(2))); u32x2v w; w.x = (unsigned)p0; w.y = (unsigned)p1;
                    PG8_ST(*(u32x2v*)(rowp + bj * HALF) = w); }
                asm volatile("" ::: "memory"); }
    }
};

template <class Epi, class Sched, bool ALIGN_EPI = false, bool SP2 = false, bool GATHER = false, bool FP8 = false, int PV = 0>
__device__ __forceinline__ void gemm_phase(PG8_LAS unsigned char* lds, const Gemm g, const Sched& S, const Epi& E, int tid_) {
    asm volatile("" : "+v"(tid_));
    const int tid = tid_, wid = __builtin_amdgcn_readfirstlane(tid >> 6), lane = tid & 63, wr = wid >> 2, wc = wid & 3, fr = lane & 15, fq = lane >> 4;
    constexpr int ES = FP8 ? 1 : 2;
#if MK_PROBE_NOSTORE
    const int K = g.K, nt = (K * ES / (BK * 2)) >> (E.nost == 3 ? 1 : 0);
#else
    const int K = g.K, nt = K * ES / (BK * 2);
#endif
    unsigned voffA[2], voffB[2];
#pragma unroll
    for (int i = 0; i < 2; ++i) { int R, C; stage_rc(tid * 16 + i * 8192, R, C); const int Rb = Epi::PERM ? ((R & ~31) + perm32(R & 31)) : R;
        voffA[i] = (unsigned)(R * K * ES + C * 2); voffB[i] = (unsigned)(Rb * K * ES + C * 2); }
    static_assert(!GATHER || SP2, "the gathered A operand is wired into the SP2 loop only");
    unsigned gofA[2][2] = {{0u, 0u}, {0u, 0u}};
#define PG8_GOFF(dst, ord) do { _Pragma("unroll") for (int _h = 0; _h < 2; ++_h) _Pragma("unroll") for (int _i = 0; _i < 2; ++_i) { int _R, _C; stage_rc(tid * 16 + _i * 8192, _R, _C); \
        dst[_h][_i] = (unsigned)(S.tab[(ord) * 256 + _h * 128 + _R] * K * ES + _C * 2); } } while (0)
#define PG8_STAGE_A(bufoff, gbase, h) do { if constexpr (GATHER) PG8_STAGE(bufoff, gbase, gofA[h]); else PG8_STAGE(bufoff, (gbase) + (h) * hstep, voffA); } while (0)
    const size_t kstep = (size_t)(BK * 2);
    const size_t hstep = (size_t)HALF * K * ES;
    const size_t tstep = 2 * hstep;
    const unsigned ldsw = (unsigned)wid * 1024u;
    const int aoff = lds_byte(wr * 64 + fr, fq * 8), boff = lds_byte(wc * 32 + fr, fq * 8);
#define PG8_SA(b, h) (((b) * 2 + (h)) * HTB)
#define PG8_SB(b, h) ((4 + (b) * 2 + (h)) * HTB)
#if MK_PROBE_NOSTORE
#define PG8_PV(v) (PV != (v))
#else
#define PG8_PV(v) true
#endif
#define PG8_STAGE(bufoff, gbase, voff) do { if constexpr (PG8_PV(4)) _Pragma("unroll") for (int _i = 0; _i < 2; ++_i) \
        __builtin_amdgcn_global_load_lds((const unsigned*)((const char*)(gbase) + (voff)[_i]), (PG8_LAS unsigned*)(lds + (bufoff) + ldsw + _i * 8192), 16, 0, 0); } while (0)
#define PG8_LDA(dst, b, h) do { if constexpr (PG8_PV(5)) _Pragma("unroll") for (int m = 0; m < 4; ++m) _Pragma("unroll") for (int k = 0; k < 2; ++k) dst[m][k] = *(const PG8_LAS bf16x8*)(lds + PG8_SA(b, h) + aoff + m * 2048 + k * 1024); } while (0)
#define PG8_LDB(dst, b, h) do { if constexpr (PG8_PV(5)) _Pragma("unroll") for (int n = 0; n < 2; ++n) _Pragma("unroll") for (int k = 0; k < 2; ++k) dst[n][k] = *(const PG8_LAS bf16x8*)(lds + PG8_SB(b, h) + boff + n * 2048 + k * 1024); } while (0)
#define PG8_MMA(ai, bj, At, Bt) do { __builtin_amdgcn_s_setprio(1); if constexpr (PV == 6) { _Pragma("unroll") for (int ks = 0; ks < 2; ++ks) _Pragma("unroll") for (int mp = 0; mp < 2; ++mp) { \
            const i32x8 _a = __builtin_bit_cast(i32x8, __builtin_shufflevector(Bt[ks][0], Bt[ks][1], 0, 1, 2, 3, 4, 5, 6, 7, 8, 9, 10, 11, 12, 13, 14, 15)); \
            const i32x8 _b = __builtin_bit_cast(i32x8, __builtin_shufflevector(At[2 * mp + ks][0], At[2 * mp + ks][1], 0, 1, 2, 3, 4, 5, 6, 7, 8, 9, 10, 11, 12, 13, 14, 15)); \
            acc16[ai][bj][mp] = __builtin_amdgcn_mfma_scale_f32_32x32x64_f8f6f4(_a, _b, acc16[ai][bj][mp], 0, 0, 0, 0x7f7f7f7f, 0, 0x7f7f7f7f); } } \
        else if constexpr (FP8) { _Pragma("unroll") for (int m = 0; m < 4; ++m) _Pragma("unroll") for (int n = 0; n < 2; ++n) { \
            const i32x8 _a = __builtin_bit_cast(i32x8, __builtin_shufflevector(Bt[n][0], Bt[n][1], 0, 1, 2, 3, 4, 5, 6, 7, 8, 9, 10, 11, 12, 13, 14, 15)); \
            const i32x8 _b = __builtin_bit_cast(i32x8, __builtin_shufflevector(At[m][0], At[m][1], 0, 1, 2, 3, 4, 5, 6, 7, 8, 9, 10, 11, 12, 13, 14, 15)); \
            acc[ai][bj][m][n] = __builtin_amdgcn_mfma_scale_f32_16x16x128_f8f6f4(_a, _b, acc[ai][bj][m][n], 0, 0, 0, 0x7f7f7f7f, 0, 0x7f7f7f7f); } } \
        else { _Pragma("unroll") for (int m = 0; m < 4; ++m) _Pragma("unroll") for (int n = 0; n < 2; ++n) _Pragma("unroll") for (int k = 0; k < 2; ++k) \
        acc[ai][bj][m][n] = __builtin_amdgcn_mfma_f32_16x16x32_bf16(Bt[n][k], At[m][k], acc[ai][bj][m][n], 0, 0, 0); } __builtin_amdgcn_s_setprio(0); } while (0)
#define PG8_WAIT_V(n) asm volatile("s_waitcnt vmcnt(" #n ")" ::: "memory")
#define PG8_WAIT_L(n) asm volatile("s_waitcnt lgkmcnt(" #n ")" ::: "memory")
#define PG8_BAR __builtin_amdgcn_s_barrier()
#define PG8_SCHED __builtin_amdgcn_sched_barrier(0)
    Unit cur, nxt; int ui = 0;
    if (!S.next(0, cur)) return;
    f32x4 acc[2][2][4][2];
#pragma unroll
    for (int a = 0; a < 2; ++a)
#pragma unroll
        for (int b = 0; b < 2; ++b)
#pragma unroll
            for (int m = 0; m < 4; ++m)
#pragma unroll
                for (int n = 0; n < 2; ++n) acc[a][b][m][n] = (f32x4){0.f, 0.f, 0.f, 0.f};
    bf16x8 At[4][2], B0[2][2], B1[2][2];
    typedef float f32x16_t __attribute__((ext_vector_type(16)));
    f32x16_t acc16[2][2][2];
    if constexpr (PV == 6) {
#pragma unroll
        for (int a = 0; a < 2; ++a)
#pragma unroll
            for (int b = 0; b < 2; ++b)
#pragma unroll
                for (int m = 0; m < 2; ++m)
#pragma unroll
                    for (int j = 0; j < 16; ++j) acc16[a][b][m][j] = 0.f; }
    const char* cA = (const char*)g.A + (GATHER ? (size_t)0 : (size_t)cur.pm * tstep); const char* cB = (const char*)g.Bt + (size_t)cur.pb * tstep;
    S.a_ready(cur);
    if constexpr (GATHER) PG8_GOFF(gofA, 0);
    if constexpr (SP2) {
        PG8_STAGE(PG8_SB(0, 0), cB, voffB); PG8_STAGE(PG8_SB(0, 1), cB + hstep, voffB); PG8_STAGE_A(PG8_SA(0, 0), cA, 0); PG8_STAGE_A(PG8_SA(0, 1), cA, 1);
        if (wr == 1) PG8_BAR;
        PG8_WAIT_V(2); PG8_BAR;
        PG8_STAGE(PG8_SB(1, 0), cB + kstep, voffB); PG8_STAGE_A(PG8_SA(1, 0), cA + kstep, 0); PG8_STAGE(PG8_SB(1, 1), cB + hstep + kstep, voffB);
        PG8_WAIT_V(6); PG8_BAR;
    } else {
        PG8_STAGE(PG8_SB(0, 0), cB, voffB); PG8_STAGE(PG8_SA(0, 0), cA, voffA); PG8_STAGE(PG8_SB(0, 1), cB + hstep, voffB); PG8_STAGE(PG8_SA(0, 1), cA + hstep, voffA);
        if (wr == 1) PG8_BAR;
        PG8_WAIT_V(4); PG8_BAR;
        PG8_STAGE(PG8_SB(1, 0), cB + kstep, voffB); PG8_STAGE(PG8_SA(1, 0), cA + kstep, voffA); PG8_STAGE(PG8_SB(1, 1), cB + hstep + kstep, voffB);
        PG8_WAIT_V(6); PG8_BAR;
    }
    for (;;) {
        const bool has_next = S.next(ui + 1, nxt);
        const char* nA = (has_next && !GATHER) ? (const char*)g.A + (size_t)nxt.pm * tstep : cA; const char* nB = has_next ? (const char*)g.Bt + (size_t)nxt.pb * tstep : cB;
        for (int t = 0; t < nt; t += 2) {
            const bool last = (t == nt - 2);
            const char* a1 = cA + (size_t)(t + 1) * kstep;
            const char* a2 = last ? nA : cA + (size_t)(t + 2) * kstep; const char* b2 = last ? nB : cB + (size_t)(t + 2) * kstep;
            const char* a3 = a2 + kstep; const char* b3 = b2 + kstep;
            if (last && has_next) S.a_ready(nxt);
            if constexpr (SP2) {
            PG8_LDB(B0, 0, 0); PG8_LDB(B1, 0, 1); PG8_SCHED; PG8_LDA(At, 0, 0); PG8_STAGE_A(PG8_SA(1, 1), a1, 1);
            if constexpr (GATHER) { if (last && has_next) PG8_GOFF(gofA, ui + 1); }
            PG8_WAIT_V(8); PG8_WAIT_L(0); PG8_BAR; PG8_MMA(0, 0, At, B0); PG8_MMA(0, 1, At, B1); PG8_BAR; PG8_SCHED;
            PG8_LDA(At, 0, 1); PG8_STAGE(PG8_SB(0, 0), b2, voffB); PG8_STAGE(PG8_SB(0, 1), b2 + hstep, voffB); PG8_STAGE_A(PG8_SA(0, 0), a2, 0);
            PG8_WAIT_V(8); PG8_WAIT_L(0); PG8_BAR; PG8_MMA(1, 0, At, B0); PG8_MMA(1, 1, At, B1); PG8_BAR; PG8_SCHED;
            PG8_LDB(B0, 1, 0); PG8_LDB(B1, 1, 1); PG8_SCHED; PG8_LDA(At, 1, 0); PG8_STAGE_A(PG8_SA(0, 1), a2, 1);
            PG8_WAIT_V(8); PG8_WAIT_L(0); PG8_BAR; PG8_MMA(0, 0, At, B0); PG8_MMA(0, 1, At, B1); PG8_BAR; PG8_SCHED;
            PG8_LDA(At, 1, 1); PG8_STAGE(PG8_SB(1, 0), b3, voffB); PG8_STAGE(PG8_SB(1, 1), b3 + hstep, voffB); PG8_STAGE_A(PG8_SA(1, 0), a3, 0);
            PG8_WAIT_V(8); PG8_WAIT_L(0); PG8_BAR; PG8_MMA(1, 0, At, B0); PG8_MMA(1, 1, At, B1); PG8_BAR; PG8_SCHED;
            } else {
            PG8_LDB(B0, 0, 0); PG8_SCHED; PG8_LDA(At, 0, 0); PG8_STAGE(PG8_SA(1, 1), a1 + hstep, voffA);
            PG8_WAIT_L(8); PG8_BAR; PG8_WAIT_L(0); PG8_MMA(0, 0, At, B0); PG8_BAR; PG8_SCHED;
            PG8_LDB(B1, 0, 1); PG8_STAGE(PG8_SB(0, 0), b2, voffB);
            PG8_BAR; PG8_WAIT_L(0); PG8_MMA(0, 1, At, B1); PG8_BAR;
            PG8_LDA(At, 0, 1); PG8_STAGE(PG8_SA(0, 0), a2, voffA);
            PG8_BAR; PG8_WAIT_L(0); PG8_MMA(1, 0, At, B0); PG8_BAR; PG8_SCHED;
            PG8_STAGE(PG8_SB(0, 1), b2 + hstep, voffB);
            PG8_WAIT_V(6); PG8_BAR; PG8_MMA(1, 1, At, B1); PG8_BAR;
            PG8_LDB(B0, 1, 0); PG8_SCHED; PG8_LDA(At, 1, 0); PG8_STAGE(PG8_SA(0, 1), a2 + hstep, voffA);
            PG8_WAIT_L(8); PG8_BAR; PG8_WAIT_L(0); PG8_MMA(0, 0, At, B0); PG8_BAR; PG8_SCHED;
            PG8_LDB(B1, 1, 1); PG8_STAGE(PG8_SB(1, 0), b3, voffB);
            PG8_BAR; PG8_WAIT_L(0); PG8_MMA(0, 1, At, B1); PG8_BAR;
            PG8_LDA(At, 1, 1); PG8_STAGE(PG8_SA(1, 0), a3, voffA);
            PG8_BAR; PG8_WAIT_L(0); PG8_MMA(1, 0, At, B0); PG8_BAR; PG8_SCHED;
            PG8_STAGE(PG8_SB(1, 1), b3 + hstep, voffB);
            PG8_WAIT_V(6); PG8_BAR; PG8_MMA(1, 1, At, B1); PG8_BAR;
            }
        }
        if constexpr (ALIGN_EPI) { if (wr == 0) PG8_BAR; }
        if constexpr (PV == 6) {
#pragma unroll
            for (int a = 0; a < 2; ++a)
#pragma unroll
                for (int b = 0; b < 2; ++b)
#pragma unroll
                    for (int m = 0; m < 2; ++m) asm volatile("" :: "v"(acc16[a][b][m])); }
        else
#if MK_PROBE_NOSTORE
        if (E.nost != 2)
#endif
        if constexpr (!Epi::AFTER_DRAIN) { E(acc, cur, wr, wc, fr, fq); S.done(cur); }
        if (!has_next) break;
#pragma unroll
        for (int a = 0; a < 2; ++a)
#pragma unroll
            for (int b = 0; b < 2; ++b)
#pragma unroll
                for (int m = 0; m < 4; ++m)
#pragma unroll
                    for (int n = 0; n < 2; ++n) acc[a][b][m][n] = (f32x4){0.f, 0.f, 0.f, 0.f};
        cur = nxt; cA = nA; cB = nB; ++ui;
        if constexpr (ALIGN_EPI) { if (wr == 1) PG8_BAR; }
    }
    PG8_WAIT_V(0);
    if constexpr (!ALIGN_EPI) { if (wr == 0) PG8_BAR; }
    PG8_BAR;
    if constexpr (Epi::AFTER_DRAIN) { E.fused(acc, cur, wr, wc, fr, fq, lds, wid, lane); S.done(cur); }
#undef PG8_SA
#undef PG8_GOFF
#undef PG8_STAGE_A
#undef PG8_SB
#undef PG8_STAGE
#undef PG8_LDA
#undef PG8_LDB
#undef PG8_MMA
#undef PG8_WAIT_V
#undef PG8_WAIT_L
#undef PG8_BAR
#undef PG8_SCHED
}
}

#ifndef PG8_SP2
#define PG8_SP2 true
#endif
#ifndef PG8_ALIGN
#define PG8_ALIGN true
#endif

constexpr int BATCH = 8, SEQ = 2048, DM = 2048, M = BATCH * SEQ;
constexpr int NE = 16, CAP = 256, DE = 2048, MOE_ROWS = BATCH * NE * CAP;
constexpr int IN_AB = 5120, IN_CD = 6144;
constexpr float RMS_EPS = 1e-6f, LN_EPS = 1e-5f;
constexpr float LOG2E = 1.4426950408889634f, LN2 = 0.6931471805599453f;
constexpr float ATT_SCALE = 0.08838834764831845f;
constexpr int NWAVES = 8, NTHR = 512;

constexpr size_t MiB = 1ull << 20;
constexpr size_t WS_CTL = 0, CTL_ZERO_BYTES = 1 * MiB;
constexpr size_t WS_AFF = 1 * MiB;
constexpr size_t WS_SEL = 2 * MiB;
constexpr size_t WS_GATE = 3 * MiB;
constexpr size_t WS_IDX = 3 * MiB + 512 * 1024;
constexpr size_t WS_LSE = 4 * MiB;
constexpr size_t WS_WIN0 = 8 * MiB, WS_WOUT0 = 28 * MiB, WS_WIN1 = 36 * MiB, WS_WOUT1 = 60 * MiB;
constexpr size_t WS_WGU = 68 * MiB;
constexpr size_t WS_WDN = 580 * MiB;
constexpr size_t WS_XRES = 836 * MiB;
constexpr size_t WS_H = 964 * MiB;
constexpr size_t WS_P = 1028 * MiB;
constexpr size_t WS_YCAT = 1220 * MiB;
constexpr size_t WS_OP = 1764 * MiB;
constexpr size_t OP_STRIDE = (size_t)16384 * 1024 + 4096 + 512;
constexpr size_t QKV_STRIDE = (size_t)64 * 2048 * 128 + 4096 + 512;
constexpr size_t WS_XE = 1380 * MiB;
constexpr size_t WS_QKV = WS_XE;
constexpr size_t WS_HID = 1508 * MiB;
constexpr size_t WS_YE = 1636 * MiB;
constexpr size_t WS_WIN8 = 1896 * MiB;
constexpr size_t WS_H8 = 1864 * MiB;
constexpr size_t WS_END = 1908 * MiB;
constexpr float YE_SCALE = 64.0f;
constexpr float W8_SCALE = 64.0f;

constexpr int RING_BYTES = 131072;
constexpr int LDSCTL_OFF = 147328, MISC_OFF = LDSCTL_OFF;
constexpr int LDS_BYTES = 147456;

#define GAS __attribute__((address_space(1)))
#define LAS __attribute__((address_space(3)))
typedef unsigned short bf16;
typedef unsigned u32x4 __attribute__((ext_vector_type(4)));
typedef unsigned u32x2 __attribute__((ext_vector_type(2)));
typedef float f32x4 __attribute__((ext_vector_type(4)));
typedef short bf16x8 __attribute__((ext_vector_type(8)));
typedef short s16x4 __attribute__((ext_vector_type(4)));
typedef GAS unsigned gu32;
#define RLX_AGENT __ATOMIC_RELAXED, __HIP_MEMORY_SCOPE_AGENT
#define LDS_WAIT() asm volatile("s_waitcnt lgkmcnt(0)" ::: "memory")
#define VM_WAIT() asm volatile("s_waitcnt vmcnt(0)" ::: "memory")
using pg8::cvt_pk_bf16;
__device__ __forceinline__ float bf_lo(unsigned w) { return __uint_as_float(w << 16); }
__device__ __forceinline__ float bf_hi(unsigned w) { return __uint_as_float(w & 0xffff0000u); }
__device__ __forceinline__ int lane_now() { int l; asm volatile("v_mbcnt_lo_u32_b32 %0, -1, 0\n\tv_mbcnt_hi_u32_b32 %0, -1, %0" : "=v"(l)); return l; }
__device__ __forceinline__ int shx(int v, int o, int lane) { return __builtin_amdgcn_ds_bpermute((lane ^ o) << 2, v); }
__device__ __forceinline__ unsigned shx(unsigned v, int o, int lane) { return (unsigned)__builtin_amdgcn_ds_bpermute((lane ^ o) << 2, (int)v); }
__device__ __forceinline__ float shx(float v, int o, int lane) { return __int_as_float(__builtin_amdgcn_ds_bpermute((lane ^ o) << 2, __float_as_int(v))); }
__device__ __forceinline__ unsigned shup(unsigned v, int o, int lane) { return (unsigned)__builtin_amdgcn_ds_bpermute((lane - o) << 2, (int)v); }
__device__ __forceinline__ float wave_sum(float v, int lane) {
#pragma unroll
    for (int o = 1; o < 64; o <<= 1) v += shx(v, o, lane);
    return v;
}
__device__ __forceinline__ s16x4 vtr(const LAS unsigned char* p) { return __builtin_bit_cast(s16x4, __builtin_amdgcn_ds_read_tr16_b64_v4i16((LAS s16x4*)p)); }

#define XB_TMO      128
#define XB_XCNT(j)  (256  + 64 * (j))
#define XB_XSUB(j)  (1280 + 64 * (j))
#define XB_XGEN(j)  (2304 + 64 * (j))
#define XB_TOP      3328
#define XB_TOPGEN   3392
#define XCD_BAR_WORDS 3456
#define XB_SPIN_CAP (1u << 18)

__device__ __forceinline__ unsigned xb_ld(unsigned* p)              { return __hip_atomic_load(p, __ATOMIC_RELAXED, __HIP_MEMORY_SCOPE_AGENT); }
__device__ __forceinline__ unsigned xb_add(unsigned* p, unsigned v) { return __hip_atomic_fetch_add(p, v, __ATOMIC_RELAXED, __HIP_MEMORY_SCOPE_AGENT); }
__device__ __forceinline__ unsigned xb_xcc_id() { return (unsigned)__builtin_amdgcn_s_getreg((3 << 11) | 20) & 0xFu; }
#define XB_SPIN(cond, bar) do { unsigned _sp = 0; while (cond) { __builtin_amdgcn_s_sleep(1); \
    if ((++_sp & 255u) == 0u) { if (xb_ld(&(bar)[XB_TMO])) break; if (_sp > XB_SPIN_CAP) { atomicAdd(&(bar)[XB_TMO], 1u); break; } } } } while (0)

struct XcdBarrier {
    unsigned* bar; unsigned x; int wave;
    volatile LAS unsigned* st;
};

__device__ __forceinline__ XcdBarrier xcd_barrier_post(unsigned* bar, volatile LAS unsigned* st, int wave) {
    XcdBarrier b; b.bar = bar; b.x = xb_xcc_id(); b.st = st; b.wave = wave;
    if (b.wave == 0 && lane_now() == 0) (void)xb_add(&bar[XB_XCNT(b.x)], 1u);
    return b;
}
__device__ __forceinline__ void xcd_barrier_complete(unsigned* bar, unsigned x, unsigned& nloc, unsigned& nx) {
    const unsigned G = gridDim.x * gridDim.y * gridDim.z;
    unsigned sum, cnt, mine, sp = 0u;
    for (;;) {
        sum = 0u; cnt = 0u; mine = 0u;
#pragma unroll
        for (unsigned j = 0; j < 16; ++j) { const unsigned c = xb_ld(&bar[XB_XCNT(j)]); sum += c; cnt += (c > 0u) ? 1u : 0u; mine = (j == x) ? c : mine; }
        if (sum == G) break;
        __builtin_amdgcn_s_sleep(1);
        if ((++sp & 255u) == 0u) { if (xb_ld(&bar[XB_TMO])) break; if (sp > XB_SPIN_CAP) { atomicAdd(&bar[XB_TMO], 1u); break; } }
    }
    nloc = mine > 0u ? mine : 1u; nx = cnt > 0u ? cnt : 1u;
}

__device__ __forceinline__ void xcd_barrier(const XcdBarrier& b) {
    asm volatile("s_waitcnt vmcnt(0)" ::: "memory");
    __syncthreads();
    if (b.wave == 0 && lane_now() == 0) {
        unsigned* bar = b.bar;
        __builtin_amdgcn_s_waitcnt(0);
#if MK_EARLY_INV
        asm volatile("buffer_inv sc1" ::: "memory");
#endif
        unsigned nloc = b.st[0], nx = b.st[1];
        if (nloc == 0u) { xcd_barrier_complete(bar, b.x, nloc, nx); b.st[0] = nloc; b.st[1] = nx; }
        const unsigned old = xb_add(&bar[XB_XSUB(b.x)], 1u);
        const unsigned gen = old / nloc;
        if (old + 1u == (gen + 1u) * nloc) {
            __builtin_amdgcn_fence(__ATOMIC_RELEASE, "agent");
            asm volatile("s_waitcnt vmcnt(0)" ::: "memory");
            const unsigned og = xb_add(&bar[XB_TOP], 1u);
            const unsigned tg = og / nx;
            if (og + 1u == (tg + 1u) * nx) xb_add(&bar[XB_TOPGEN], 1u);
            else XB_SPIN(xb_ld(&bar[XB_TOPGEN]) == tg, bar);
            __builtin_amdgcn_fence(__ATOMIC_ACQUIRE, "agent");
            xb_add(&bar[XB_XGEN(b.x)], 1u);
            asm volatile("s_waitcnt vmcnt(0)" ::: "memory");
        } else {
            XB_SPIN(xb_ld(&bar[XB_XGEN(b.x)]) == gen, bar);
#if !MK_EARLY_INV
            __builtin_amdgcn_fence(__ATOMIC_ACQUIRE, "agent");
#endif
            asm volatile("s_waitcnt vmcnt(0)" ::: "memory");
        }
    }
    __syncthreads();
}

struct Ctx {
    const float *x, *norm_mix, *norm_ffn, *norm_final, *w_in_ab, *a_v_norm, *a_sw, *a_sb, *b_rpb, *w_out_ab, *w_in_cd, *c_conv, *w_out_cd, *router, *w_gate, *w_up, *w_down;
    float* out; unsigned char* ws;
    LAS unsigned char* lds;
    int tid, lane, wave, wave0, G, bid;
};

__device__ __forceinline__ void tr_load(const float* src, int N, f32x4 (&v)[16], int lane) {
    const int cc = lane & 15, rg = lane >> 4;
#pragma unroll
    for (int i = 0; i < 16; ++i) { const int k = (i & 1) + 2 * rg + 8 * (i >> 1); v[i] = *(const f32x4*)(src + (size_t)k * N + 4 * cc); }
}
__device__ __forceinline__ void tr_store(const f32x4 (&v)[16], bf16* dst, LAS unsigned* scr, int lane) {
    const int cc = lane & 15, rg = lane >> 4;
#pragma unroll
    for (int j = 0; j < 8; ++j)
#pragma unroll
        for (int q = 0; q < 4; ++q) scr[(4 * cc + q) * 33 + rg + 4 * j] = cvt_pk_bf16(v[2 * j][q], v[2 * j + 1][q]);
    LDS_WAIT(); asm volatile("" ::: "memory");
    const int ch = lane & 7;
#pragma unroll
    for (int jj = 0; jj < 8; ++jj) { const int n = (lane >> 3) + 8 * jj; const LAS unsigned* s = scr + n * 33 + 4 * ch;
        u32x4 o; o.x = s[0]; o.y = s[1]; o.z = s[2]; o.w = s[3];
        *(u32x4*)(dst + (size_t)n * DM + 8 * ch) = o; }
    LDS_WAIT(); asm volatile("" ::: "memory");
}
__device__ __forceinline__ void rms_row_load(const float* xrow, f32x4 (&v)[8], int lane) {
#pragma unroll
    for (int j = 0; j < 4; ++j) { v[2 * j] = *(const f32x4*)(xrow + 512 * j + 8 * lane); v[2 * j + 1] = *(const f32x4*)(xrow + 512 * j + 8 * lane + 4); }
}
__device__ __forceinline__ void rms_row_to_bf16(const f32x4 (&v)[8], const float* gw, bf16* orow, unsigned char* orow8, int lane) {
    float ss = 0.f;
#pragma unroll
    for (int j = 0; j < 8; ++j) ss += (v[j].x * v[j].x + v[j].y * v[j].y) + (v[j].z * v[j].z + v[j].w * v[j].w);
    const float rstd = 1.0f / sqrtf(wave_sum(ss, lane) * (1.0f / DM) + RMS_EPS);
#pragma unroll
    for (int j = 0; j < 4; ++j) { const f32x4 g0 = *(const f32x4*)(gw + 512 * j + 8 * lane), g1 = *(const f32x4*)(gw + 512 * j + 8 * lane + 4);
        const f32x4 a = v[2 * j] * rstd * g0, b2 = v[2 * j + 1] * rstd * g1;
        u32x4 o; o.x = cvt_pk_bf16(a.x, a.y); o.y = cvt_pk_bf16(a.z, a.w); o.z = cvt_pk_bf16(b2.x, b2.y); o.w = cvt_pk_bf16(b2.z, b2.w);
        *(u32x4*)(orow + 512 * j + 8 * lane) = o;
        { int p0 = 0, p1 = 0;
          p0 = __builtin_amdgcn_cvt_pk_fp8_f32(__builtin_amdgcn_fmed3f(a.x, -448.f, 448.f), __builtin_amdgcn_fmed3f(a.y, -448.f, 448.f), p0, false); p0 = __builtin_amdgcn_cvt_pk_fp8_f32(__builtin_amdgcn_fmed3f(a.z, -448.f, 448.f), __builtin_amdgcn_fmed3f(a.w, -448.f, 448.f), p0, true);
          p1 = __builtin_amdgcn_cvt_pk_fp8_f32(__builtin_amdgcn_fmed3f(b2.x, -448.f, 448.f), __builtin_amdgcn_fmed3f(b2.y, -448.f, 448.f), p1, false); p1 = __builtin_amdgcn_cvt_pk_fp8_f32(__builtin_amdgcn_fmed3f(b2.z, -448.f, 448.f), __builtin_amdgcn_fmed3f(b2.w, -448.f, 448.f), p1, true);
          u32x2 w8; w8.x = (unsigned)p0; w8.y = (unsigned)p1; *(u32x2*)(orow8 + 512 * j + 8 * lane) = w8; } }
}
__device__ __forceinline__ int conv_job_items(int job) { return job == 0 ? 32 * 80 : job == 2 ? 32 * 96 : job < 4 ? 32 * 32 : ((job - 4) & 1) ? 16 * 1024 : 32 * 1024; }
struct ConvItem { const float* src; int N; bf16* dst; int fp8; };
__device__ __forceinline__ ConvItem conv_decode(const Ctx& c, int job, int r) {
    ConvItem t;
    if (job < 4) {
        const float* W = job == 0 ? c.w_in_ab : job == 1 ? c.w_out_ab : job == 2 ? c.w_in_cd : c.w_out_cd;
        const int N = job == 0 ? IN_AB : job == 2 ? IN_CD : DM;
        bf16* WT = (bf16*)(c.ws + (job == 0 ? WS_WIN0 : job == 1 ? WS_WOUT0 : job == 2 ? WS_WIN1 : WS_WOUT1));
        const int nsb = N / 128, sub = r & 7, sup = r >> 3, kb = 4 * (sup / nsb) + (sub & 3), nb = 2 * (sup % nsb) + (sub >> 2);
        t.src = W + (size_t)(64 * kb) * N + 64 * nb; t.N = N; t.dst = WT + (size_t)(64 * nb) * DM + 64 * kb; t.fp8 = 0;
        const int q0 = job == 0 ? 32 : job == 2 ? 48 : 1 << 30;
        if (nb >= q0) { t.fp8 = 1; t.dst = (bf16*)(c.ws + WS_WIN8 + (job == 2 ? 6 * MiB : 0) + (size_t)(64 * (nb - q0)) * DM + 64 * kb); }
    } else {
        const int l = (job - 4) >> 1, isdn = (job - 4) & 1, mat = r >> 10, w = r & 1023, sub = w & 7, sup = w >> 3, kb = 4 * (sup >> 4) + (sub & 3), n0 = 64 * (2 * (sup & 15) + (sub >> 2));
        const int e = isdn ? mat : mat >> 1, which = isdn ? 2 : (mat & 1);
        t.src = (which == 0 ? c.w_gate : which == 1 ? c.w_up : c.w_down) + ((size_t)(l * NE + e) * 2048 + 64 * kb) * 2048 + n0; t.N = 2048;
        t.fp8 = 1;
        if (which < 2) t.dst = (bf16*)(c.ws + WS_WGU + (size_t)l * 128 * MiB + (size_t)(e * 4096 + (n0 >> 7) * 256 + which * 128 + (n0 & 127)) * 2048 + 64 * kb);
        else t.dst = (bf16*)(c.ws + WS_WDN + (size_t)l * 64 * MiB + (size_t)(e * 2048 + n0) * 2048 + 64 * kb);
    }
    return t;
}
__device__ __forceinline__ void conv_job(const Ctx& c, int job, int lo, int hi, int icu, int ncu) {
    LAS unsigned* scr = (LAS unsigned*)(c.lds + c.wave * 8704);
    const int step = ncu * NWAVES; int it = lo + icu * NWAVES + c.wave;
    if (it >= hi) return;
    f32x4 va[16], vb[16];
    ConvItem ta = conv_decode(c, job, it), tb = ta;
    tr_load(ta.src, ta.N, va, c.lane);
    for (;;) {
        if (it + step < hi) { tb = conv_decode(c, job, it + step); tr_load(tb.src, tb.N, vb, c.lane); }
        tr_store(va, ta.dst, scr, c.lane);
        it += step; if (it >= hi) break;
        if (it + step < hi) { ta = conv_decode(c, job, it + step); tr_load(ta.src, ta.N, va, c.lane); }
        tr_store(vb, tb.dst, scr, c.lane);
        it += step; if (it >= hi) break;
    }
}
constexpr int DMA_PIECE = 1040, DMA_BUF = 8 * DMA_PIECE;
__device__ __forceinline__ void dma_issue(const float* src, int N, LAS unsigned char* buf, int lane) {
    const float* p = src + (size_t)(lane >> 3) * N + 4 * (lane & 7);
#pragma unroll
    for (int j = 0; j < 8; ++j) __builtin_amdgcn_global_load_lds((const unsigned*)(p + (size_t)(8 * j) * N), (LAS unsigned*)(buf + j * DMA_PIECE), 16, 0, 2);
}
__device__ __forceinline__ void dma_drain_store(const LAS unsigned char* buf, bf16* dst, int lane) {
    const int ch = lane & 7, nr = lane >> 3;
#pragma unroll
    for (int pass = 0; pass < 4; ++pass) { const int n = nr + 8 * pass; const LAS float* s = (const LAS float*)(buf + ch * DMA_PIECE) + n;
        float f[8];
#pragma unroll
        for (int q = 0; q < 8; ++q) f[q] = s[q * 32];
        u32x4 o; o.x = cvt_pk_bf16(f[0], f[1]); o.y = cvt_pk_bf16(f[2], f[3]); o.z = cvt_pk_bf16(f[4], f[5]); o.w = cvt_pk_bf16(f[6], f[7]);
        __builtin_nontemporal_store(o, (u32x4*)(dst + (size_t)n * DM + 8 * ch)); }
}
__device__ __forceinline__ void dma_drain_store_fp8(const LAS unsigned char* buf, unsigned char* dst8, int lane) {
    const int ch = lane & 3, nr = lane >> 2;
#pragma unroll
    for (int pass = 0; pass < 2; ++pass) { const int n = nr + 16 * pass; const LAS float* s = (const LAS float*)(buf + 2 * ch * DMA_PIECE) + n;
        float f[16];
#pragma unroll
        for (int q = 0; q < 16; ++q) f[q] = s[(q >> 3) * (DMA_PIECE / 4) + (q & 7) * 32] * W8_SCALE;
        u32x4 o;
#pragma unroll
        for (int w = 0; w < 4; ++w) { int p = 0; p = __builtin_amdgcn_cvt_pk_fp8_f32(f[4 * w], f[4 * w + 1], p, false); p = __builtin_amdgcn_cvt_pk_fp8_f32(f[4 * w + 2], f[4 * w + 3], p, true); o[w] = (unsigned)p; }
        __builtin_nontemporal_store(o, (u32x4*)(dst8 + (size_t)n * DM + 16 * ch)); }
}
__device__ __forceinline__ void conv_job_dma(const Ctx& c, int job, int lo, int hi, int icu, int ncu) {
    LAS unsigned char* b0 = c.lds + c.wave * (2 * DMA_BUF); LAS unsigned char* b1 = b0 + DMA_BUF;
    const int step = ncu * NWAVES; int it = lo + icu * NWAVES + c.wave;
    if (it >= hi) return;
    ConvItem t = conv_decode(c, job, it);
    dma_issue(t.src, t.N, b0, c.lane);
    for (;;) {
        dma_issue(t.src + 32, t.N, b1, c.lane);
        asm volatile("s_waitcnt vmcnt(8)" ::: "memory");
        if (t.fp8) dma_drain_store_fp8(b0, (unsigned char*)t.dst, c.lane); else dma_drain_store(b0, t.dst, c.lane);
        asm volatile("s_waitcnt lgkmcnt(0)" ::: "memory");
        const int nit = it + step; ConvItem tn = t;
        if (nit < hi) { tn = conv_decode(c, job, nit); dma_issue(tn.src, tn.N, b0, c.lane); asm volatile("s_waitcnt vmcnt(8)" ::: "memory"); }
        else asm volatile("s_waitcnt vmcnt(0)" ::: "memory");
        if (t.fp8) dma_drain_store_fp8(b1, (unsigned char*)t.dst + (size_t)32 * DM, c.lane); else dma_drain_store(b1, t.dst + (size_t)32 * DM, c.lane);
        asm volatile("s_waitcnt lgkmcnt(0)" ::: "memory");
        if (nit >= hi) break;
        it = nit; t = tn;
    }
}
constexpr int WT_PITCH = 1040, WT_BYTES = 64 * WT_PITCH;
__device__ __forceinline__ int conv_job_tiles(int job) { return job == 0 ? 32 * 20 : job == 2 ? 32 * 24 : job < 4 ? 32 * 8 : ((job - 4) & 1) ? 16 * 256 : 32 * 256; }
struct ConvTile { const float* src; int N; int rowbase  ; int k0; int kind  ; unsigned char* dstb; };
__device__ __forceinline__ ConvTile conv_tile_decode(const Ctx& c, int job, int tt) {
    ConvTile t;
    if (job < 4) {
        const float* W = job == 0 ? c.w_in_ab : job == 1 ? c.w_out_ab : job == 2 ? c.w_in_cd : c.w_out_cd;
        const int N = job == 0 ? IN_AB : job == 2 ? IN_CD : DM, nT = N / 256, kb = tt / nT, nt = tt % nT;
        t.src = W + (size_t)(64 * kb) * N + 256 * nt; t.N = N; t.rowbase = 256 * nt; t.k0 = 64 * kb; t.kind = 0;
        t.dstb = c.ws + (job == 0 ? WS_WIN0 : job == 1 ? WS_WOUT0 : job == 2 ? WS_WIN1 : WS_WOUT1);
        const int q0 = job == 0 ? 8 : job == 2 ? 12 : 1 << 30;
        if (nt >= q0) { t.kind = 2; t.rowbase = 256 * (nt - q0); t.dstb = c.ws + WS_WIN8 + (job == 2 ? 6 * MiB : 0); }
    } else {
        const int l = (job - 4) >> 1, isdn = (job - 4) & 1, mat = tt >> 8, w = tt & 255, kb = w >> 3, nt = w & 7;
        const int e = isdn ? mat : mat >> 1, which = isdn ? 2 : (mat & 1);
        t.src = (which == 0 ? c.w_gate : which == 1 ? c.w_up : c.w_down) + ((size_t)(l * NE + e) * 2048 + 64 * kb) * 2048 + 256 * nt; t.N = 2048; t.k0 = 64 * kb;
        if (which < 2) { t.kind = 1; t.rowbase = e * 4096 + (2 * nt) * 256 + which * 128; t.dstb = c.ws + WS_WGU + (size_t)l * 128 * MiB; }
        else { t.kind = 2; t.rowbase = e * 2048 + 256 * nt; t.dstb = c.ws + WS_WDN + (size_t)l * 64 * MiB; }
    }
    return t;
}
__device__ __forceinline__ void wt_issue(const Ctx& c, const ConvTile& t, LAS unsigned char* buf) {
    const float* p = t.src + (size_t)(8 * c.wave) * t.N + 4 * c.lane;
#pragma unroll
    for (int j = 0; j < 8; ++j) __builtin_amdgcn_global_load_lds((const unsigned*)(p + (size_t)j * t.N), (LAS unsigned*)(buf + (8 * c.wave + j) * WT_PITCH), 16, 0, 2);
}
__device__ __forceinline__ void wt_drain(const Ctx& c, const ConvTile& t, const LAS unsigned char* buf) {
    if (t.kind == 0) {
#pragma unroll
        for (int j = 0; j < 4; ++j) { const int id = c.tid + 512 * j, n = id >> 3, ch = id & 7; const LAS float* s = (const LAS float*)(buf + (8 * ch) * WT_PITCH) + n;
            float f[8];
#pragma unroll
            for (int q = 0; q < 8; ++q) f[q] = s[q * (WT_PITCH / 4)];
            u32x4 o; o.x = cvt_pk_bf16(f[0], f[1]); o.y = cvt_pk_bf16(f[2], f[3]); o.z = cvt_pk_bf16(f[4], f[5]); o.w = cvt_pk_bf16(f[6], f[7]);
            __builtin_nontemporal_store(o, (u32x4*)((bf16*)t.dstb + (size_t)(t.rowbase + n) * DM + t.k0 + 8 * ch)); }
    } else {
#pragma unroll
        for (int j = 0; j < 2; ++j) { const int id = c.tid + 512 * j, n = id >> 2, ch = id & 3; const LAS float* s = (const LAS float*)(buf + (16 * ch) * WT_PITCH) + n;
            float f[16];
#pragma unroll
            for (int q = 0; q < 16; ++q) f[q] = s[q * (WT_PITCH / 4)] * W8_SCALE;
            u32x4 o;
#pragma unroll
            for (int w = 0; w < 4; ++w) { int p = 0; p = __builtin_amdgcn_cvt_pk_fp8_f32(f[4 * w], f[4 * w + 1], p, false); p = __builtin_amdgcn_cvt_pk_fp8_f32(f[4 * w + 2], f[4 * w + 3], p, true); o[w] = (unsigned)p; }
            const int row = t.kind == 1 ? t.rowbase + (n >> 7) * 256 + (n & 127) : t.rowbase + n;
            __builtin_nontemporal_store(o, (u32x4*)(t.dstb + (size_t)row * DM + t.k0 + 16 * ch)); }
    }
}
__device__ __forceinline__ void conv_job_wg(const Ctx& c, int job, int lo, int hi, int icu, int ncu) {
    int tt = lo + icu; if (tt >= hi) return;
    LAS unsigned char* b0 = c.lds; LAS unsigned char* b1 = c.lds + WT_BYTES;
    ConvTile t = conv_tile_decode(c, job, tt);
    wt_issue(c, t, b0);
    for (int b = 0;; b ^= 1) {
        const int nx = tt + ncu; ConvTile tn = t;
        asm volatile("" ::: "memory"); __builtin_amdgcn_s_barrier(); asm volatile("" ::: "memory");
        if (nx < hi) { tn = conv_tile_decode(c, job, nx); wt_issue(c, tn, b ? b0 : b1); asm volatile("s_waitcnt vmcnt(8)" ::: "memory"); }
        else asm volatile("s_waitcnt vmcnt(0)" ::: "memory");
        __builtin_amdgcn_s_barrier(); asm volatile("" ::: "memory");
        wt_drain(c, t, b ? b1 : b0);
        asm volatile("s_waitcnt lgkmcnt(0)" ::: "memory");
        if (nx >= hi) break;
        tt = nx; t = tn;
    }
}
__device__ __forceinline__ void conv_job_loads(const Ctx& c, int job, int lo, int hi, int icu, int ncu) {
    const int step = ncu * NWAVES;
    for (int it = lo + icu * NWAVES + c.wave; it < hi; it += step) { f32x4 v[16]; const ConvItem t = conv_decode(c, job, it); tr_load(t.src, t.N, v, c.lane);
#pragma unroll
        for (int k = 0; k < 16; ++k) asm volatile("" :: "v"(v[k])); }
}
__device__ __forceinline__ void conv_job_half(const Ctx& c, int job, int when  ) {
#if MK_CONV_SKEW
    const int n = conv_job_items(job), pass = c.G * NWAVES, per = (n + pass - 1) / pass, j = c.bid >> 3, q = ((j >> 1) * per) / (((c.G + 7) >> 3) * 2);
    const int s = (j & 1) ? q : per - q, cut = s * pass < n ? s * pass : n;
    if (when == 0) { if (cut > 0) conv_job_dma(c, job, 0, cut, c.bid, c.G); }
    else if (cut < n) conv_job_dma(c, job, cut, n, c.bid, c.G);
#else
    const int hg = c.G >> 1, half = c.bid >= hg ? 1 : 0, n = conv_job_items(job), mid = (n >> 1);
    if (half != when) return;
    conv_job_dma(c, job, half ? mid : 0, half ? n : mid, half ? c.bid - hg : c.bid, half ? c.G - hg : hg);
#endif
}
__device__ __forceinline__ void p_prologue(const Ctx& c) {
    conv_job_dma(c, 0, 0, conv_job_items(0), c.bid, c.G); __syncthreads();
    const int gw = c.bid * NWAVES + c.wave, NGW = c.G * NWAVES;
    bf16* H = (bf16*)(c.ws + WS_H);
    f32x4 va[8], vb[8]; int m = gw;
    if (m < M) rms_row_load(c.x + (size_t)m * DM, va, c.lane);
    for (; m < M; m += NGW) { const int mn = m + NGW;
        if (mn < M) rms_row_load(c.x + (size_t)mn * DM, vb, c.lane);
        rms_row_to_bf16(va, c.norm_mix, H + (size_t)m * DM, c.ws + WS_H8 + (size_t)m * DM, c.lane);
#pragma unroll
        for (int j = 0; j < 8; ++j) va[j] = vb[j]; }
}
constexpr int KP = 272, VP = 288, ATT_K_OFF = 0, ATT_V_OFF = 256 * KP, ATT_RP_OFF = ATT_V_OFF + 256 * VP;
__device__ __forceinline__ void att_write_lds(const Ctx& c, const u32x4 (&kr)[8], const u32x4 (&vr)[8], int rot) {
#pragma unroll
    for (int j = 0; j < 8; ++j) { const int id = c.tid + 512 * j, row = ((id >> 4) & 128) | (((id >> 4) + rot) & 127), c16 = id & 15;
        *(LAS u32x4*)(c.lds + ATT_K_OFF + row * KP + 16 * c16) = kr[j]; *(LAS u32x4*)(c.lds + ATT_V_OFF + row * VP + 16 * c16) = vr[j]; }
}
template <int NB, class Fn>
__device__ __forceinline__ void attn_blocks(const LAS unsigned char* lds, const int (&krow)[NB], const bf16x8 (&qf)[4], f32x4 (&O)[8], float& m, float& l, int i, int g, const Fn (&fn)[NB]) {
    const LAS unsigned char* kbp[NB]; const LAS unsigned char* vbp[NB];
#pragma unroll
    for (int nb = 0; nb < NB; ++nb) { const unsigned ko = (unsigned)(ATT_K_OFF + (krow[nb] + i) * KP + 16 * g), vo = (unsigned)(ATT_V_OFF + (krow[nb] + 4 * g + (i >> 2)) * VP + 8 * (i & 3));
        kbp[nb] = lds + ko; vbp[nb] = lds + vo; }
    f32x4 S[NB][2];
#pragma unroll
    for (int nb = 0; nb < NB; ++nb) { S[nb][0] = (f32x4){0.f, 0.f, 0.f, 0.f}; S[nb][1] = (f32x4){0.f, 0.f, 0.f, 0.f}; }
#pragma unroll
    for (int kh = 0; kh < 2; ++kh) {
        bf16x8 kf[2][NB][2];
#pragma unroll
        for (int kk = 0; kk < 2; ++kk)
#pragma unroll
            for (int nb = 0; nb < NB; ++nb)
#pragma unroll
                for (int t = 0; t < 2; ++t) kf[kk][nb][t] = *(const LAS bf16x8*)(kbp[nb] + 16 * t * KP + 64 * (2 * kh + kk));
#pragma unroll
        for (int kk = 0; kk < 2; ++kk)
#pragma unroll
            for (int nb = 0; nb < NB; ++nb)
#pragma unroll
                for (int t = 0; t < 2; ++t) S[nb][t] = __builtin_amdgcn_mfma_f32_16x16x32_bf16(kf[kk][nb][t], qf[2 * kh + kk], S[nb][t], 0, 0, 0);
    }
    s16x4 vlo[8][NB], vhi[8][NB];
#pragma unroll
    for (int dn = 0; dn < 2; ++dn)
#pragma unroll
        for (int nb = 0; nb < NB; ++nb) { const LAS unsigned char* vb = vbp[nb] + 32 * dn; vlo[dn][nb] = vtr(vb); vhi[dn][nb] = vtr(vb + 16 * VP); }
    float sc[NB][8]; float mx = -INFINITY;
#pragma unroll
    for (int nb = 0; nb < NB; ++nb)
#pragma unroll
        for (int r = 0; r < 4; ++r) { sc[nb][r] = fn[nb](0, r, S[nb][0][r]); sc[nb][4 + r] = fn[nb](1, r, S[nb][1][r]); mx = fmaxf(mx, fmaxf(sc[nb][r], sc[nb][4 + r])); }
    { const int ln = (g << 4) | i; mx = fmaxf(mx, shx(mx, 16, ln)); mx = fmaxf(mx, shx(mx, 32, ln)); }
    const float mn = fmaxf(m, mx), alpha = __builtin_amdgcn_exp2f(m - mn);
    float ps = 0.f; bf16x8 pf[NB];
#pragma unroll
    for (int nb = 0; nb < NB; ++nb) { float p[8];
#pragma unroll
        for (int j = 0; j < 8; ++j) { p[j] = __builtin_amdgcn_exp2f(sc[nb][j] - mn); ps += p[j]; }
        u32x4 pw; pw.x = cvt_pk_bf16(p[0], p[1]); pw.y = cvt_pk_bf16(p[2], p[3]); pw.z = cvt_pk_bf16(p[4], p[5]); pw.w = cvt_pk_bf16(p[6], p[7]);
        pf[nb] = __builtin_bit_cast(bf16x8, pw); }
    l = l * alpha + ps; m = mn;
#pragma unroll
    for (int dn = 2; dn < 8; ++dn)
#pragma unroll
        for (int nb = 0; nb < NB; ++nb) { const LAS unsigned char* vb = vbp[nb] + 32 * dn; vlo[dn][nb] = vtr(vb); vhi[dn][nb] = vtr(vb + 16 * VP); }
#pragma unroll
    for (int dn = 0; dn < 8; ++dn) O[dn] = O[dn] * alpha;
#pragma unroll
    for (int dn = 0; dn < 8; ++dn)
#pragma unroll
        for (int nb = 0; nb < NB; ++nb) {
            const bf16x8 vf = {vlo[dn][nb][0], vlo[dn][nb][1], vlo[dn][nb][2], vlo[dn][nb][3], vhi[dn][nb][0], vhi[dn][nb][1], vhi[dn][nb][2], vhi[dn][nb][3]};
            O[dn] = __builtin_amdgcn_mfma_f32_16x16x32_bf16(vf, pf[nb], O[dn], 0, 0, 0); }
}

__device__ __forceinline__ void sgu_unit(const Ctx& c, int u) {
    const int b = u >> 5, chn = (u >> 1) & 15, half = u & 1, tok0 = b * SEQ + chn * 128;
    const bf16* P = (const bf16*)(c.ws + WS_P); bf16* Y = (bf16*)(c.ws + WS_YCAT);
    LAS unsigned char* Vs = c.lds; LAS float* stat = (LAS float*)(c.lds + 128 * 272);
    const int lane = c.lane, wave = c.wave, i = lane & 15, g = lane >> 4;
    __syncthreads();
#pragma unroll
    for (int it = 0; it < 2; ++it) {
        u32x4 raw[2][8];
#pragma unroll
        for (int ps = 0; ps < 2; ++ps) { const bf16* row = P + (size_t)(tok0 + 16 * wave + 8 * it + 4 * ps + g) * IN_AB + 1024 + 8 * i;
#pragma unroll
            for (int j = 0; j < 8; ++j) raw[ps][j] = *(const u32x4*)(row + 128 * j); }
#pragma unroll
        for (int ps = 0; ps < 2; ++ps) { float s = 0.f;
#pragma unroll
            for (int j = 0; j < 8; ++j)
#pragma unroll
                for (int k = 0; k < 4; ++k) s += bf_lo(raw[ps][j][k]) + bf_hi(raw[ps][j][k]);
#pragma unroll
            for (int o = 1; o < 16; o <<= 1) s += shx(s, o, lane);
            const float mean = s * (1.0f / 1024.0f); float q2 = 0.f;
#pragma unroll
            for (int j = 0; j < 8; ++j)
#pragma unroll
                for (int k = 0; k < 4; ++k) { const float d0 = bf_lo(raw[ps][j][k]) - mean, d1 = bf_hi(raw[ps][j][k]) - mean; q2 += d0 * d0 + d1 * d1; }
#pragma unroll
            for (int o = 1; o < 16; o <<= 1) q2 += shx(q2, o, lane);
            const float rstd = 1.0f / sqrtf(q2 * (1.0f / 1024.0f) + LN_EPS);
            if (i == 0) { const int tk = 16 * wave + 8 * it + 4 * ps + g; stat[2 * tk] = mean; stat[2 * tk + 1] = rstd; } }
    }
    u32x4 rawv[4];
#pragma unroll
    for (int j = 0; j < 4; ++j) { const int id = c.tid + 512 * j, tok = id >> 4, c16 = id & 15; rawv[j] = *(const u32x4*)(P + (size_t)(tok0 + tok) * IN_AB + 1024 + (4 * half) * 128 + 8 * c16); }
    __syncthreads();
    for (int gi = 0; gi < 4; ++gi) {
        const int gidx = 4 * half + gi;
#pragma unroll
        for (int j = 0; j < 4; ++j) { const int id = c.tid + 512 * j, tok = id >> 4, c16 = id & 15;
            const u32x4 raw = rawv[j];
            const float mean = stat[2 * tok], rstd = stat[2 * tok + 1];
            const f32x4 g0 = *(const f32x4*)(c.a_v_norm + gidx * 128 + 8 * c16), g1 = *(const f32x4*)(c.a_v_norm + gidx * 128 + 8 * c16 + 4);
            u32x4 w;
            w.x = cvt_pk_bf16((bf_lo(raw.x) - mean) * rstd * g0.x, (bf_hi(raw.x) - mean) * rstd * g0.y);
            w.y = cvt_pk_bf16((bf_lo(raw.y) - mean) * rstd * g0.z, (bf_hi(raw.y) - mean) * rstd * g0.w);
            w.z = cvt_pk_bf16((bf_lo(raw.z) - mean) * rstd * g1.x, (bf_hi(raw.z) - mean) * rstd * g1.y);
            w.w = cvt_pk_bf16((bf_lo(raw.w) - mean) * rstd * g1.z, (bf_hi(raw.w) - mean) * rstd * g1.w);
            *(LAS u32x4*)(Vs + tok * 272 + 16 * c16) = w; }
        const int t = 16 * wave + i;
        const float* wrow = c.a_sw + (size_t)(gidx * 128 + t) * 128;
        bf16x8 bw[4];
#pragma unroll
        for (int kk = 0; kk < 4; ++kk) { const f32x4 lo = *(const f32x4*)(wrow + 32 * kk + 4 * g), hi = *(const f32x4*)(wrow + 32 * kk + 16 + 4 * g);
            u32x4 w; w.x = cvt_pk_bf16(lo.x, lo.y); w.y = cvt_pk_bf16(lo.z, lo.w); w.z = cvt_pk_bf16(hi.x, hi.y); w.w = cvt_pk_bf16(hi.z, hi.w); bw[kk] = __builtin_bit_cast(bf16x8, w); }
        const float bias = c.a_sb[gidx * 128 + t];
        if (gi < 3) {
#pragma unroll
            for (int j = 0; j < 4; ++j) { const int id = c.tid + 512 * j, tok = id >> 4, c16 = id & 15; rawv[j] = *(const u32x4*)(P + (size_t)(tok0 + tok) * IN_AB + 1024 + (gidx + 1) * 128 + 8 * c16); } }
        u32x2 uu[8];
#pragma unroll
        for (int mt = 0; mt < 8; ++mt) uu[mt] = *(const u32x2*)(P + (size_t)(tok0 + t) * IN_AB + gidx * 128 + 16 * mt + 4 * g);
        __syncthreads();
        f32x4 acc[8];
#pragma unroll
        for (int mt = 0; mt < 8; ++mt) { acc[mt] = (f32x4){0.f, 0.f, 0.f, 0.f};
#pragma unroll
            for (int kk = 0; kk < 4; ++kk) {
                const s16x4 lo = vtr(Vs + (32 * kk + 4 * g + (i >> 2)) * 272 + 32 * mt + 8 * (i & 3)), hi = vtr(Vs + (32 * kk + 16 + 4 * g + (i >> 2)) * 272 + 32 * mt + 8 * (i & 3));
                const bf16x8 af = {lo[0], lo[1], lo[2], lo[3], hi[0], hi[1], hi[2], hi[3]};
                acc[mt] = __builtin_amdgcn_mfma_f32_16x16x32_bf16(af, bw[kk], acc[mt], 0, 0, 0);
            } }
#pragma unroll
        for (int mt = 0; mt < 8; ++mt) { const int col = gidx * 128 + 16 * mt + 4 * g;
            u32x2 o; o.x = cvt_pk_bf16(bf_lo(uu[mt].x) * (acc[mt][0] + bias), bf_hi(uu[mt].x) * (acc[mt][1] + bias)); o.y = cvt_pk_bf16(bf_lo(uu[mt].y) * (acc[mt][2] + bias), bf_hi(uu[mt].y) * (acc[mt][3] + bias));
            *(u32x2*)(Y + (size_t)(tok0 + t) * DM + col) = o; }
        __syncthreads();
    }
}
struct NattenFn { const LAS float* rp; int brow, band0, cs, qc, g;
    __device__ __forceinline__ float operator()(int t, int reg, float s) const {
        const int kc = band0 + 16 * t + 4 * g + reg, rel = kc - cs; int bi = kc - qc + 15; bi = bi < 0 ? 0 : (bi > 30 ? 30 : bi);
        const float v = (s * ATT_SCALE + rp[brow + bi]) * LOG2E;
        return ((unsigned)rel < 16u) ? v : -INFINITY; } };
__device__ __forceinline__ void nat_issue(const Ctx& c, int item, u32x4 (&kr)[8], u32x4 (&vr)[8], bf16x8 (&qn)[4], int rot) {
    const int unit = item >> 2, chunk = item & 3, hp = unit & 3, r = (unit >> 2) & 31, b = unit >> 7;
    const int rs = r - 4 < 0 ? 0 : (r - 4 > 24 ? 24 : r - 4);
    const bf16* QKV = (const bf16*)(c.ws + WS_QKV); constexpr size_t WSTEP = QKV_STRIDE;
#pragma unroll
    for (int j = 0; j < 8; ++j) { const int id = c.tid + 512 * j, hh = id >> 11, row = ((id >> 4) + rot) & 127, c16 = id & 15;
        const bf16* src = QKV + WSTEP + ((size_t)(b * 8 + 2 * hp + hh) * SEQ + rs * 64 + chunk * 128 + row) * 128 + 8 * c16;
        kr[j] = *(const u32x4*)src; vr[j] = *(const u32x4*)(src + WSTEP); }
    if (chunk == 0) { const int i = c.lane & 15, g = c.lane >> 4, hh = c.wave >> 2, cb = c.wave & 3;
#pragma unroll
        for (int kk = 0; kk < 4; ++kk) qn[kk] = *(const bf16x8*)(QKV + ((size_t)(b * 8 + 2 * hp + hh) * SEQ + r * 64 + cb * 16 + i) * 128 + 32 * kk + 8 * g); }
}
__device__ __forceinline__ int nat_unit(const Ctx& c, int k) {
    if (c.G == 256) { const int x = c.bid & 7, ci = c.bid >> 3, set = 4 * x + k; return ((set >> 2) << 7) | (ci << 2) | (set & 3); }
    return c.bid + k * c.G;
}
__device__ __forceinline__ void p_natten(const Ctx& c) {
    const int NK = (1024 - c.bid + c.G - 1) / c.G, NITEM = NK * 4;
    const int lane = c.lane, wave = c.wave, i = lane & 15, g = lane >> 4, hh = wave >> 2, cb = wave & 3;
    LAS float* rp = (LAS float*)(c.lds + ATT_RP_OFF);
    u32x4 kr[8], vr[8]; bf16x8 qn[4], qf[4]; f32x4 O[8]; float m = -1e30f, l = 0.f;
#pragma unroll
    for (int kk = 0; kk < 4; ++kk) { qn[kk] = (bf16x8){0, 0, 0, 0, 0, 0, 0, 0}; qf[kk] = qn[kk]; }
#pragma unroll
    for (int dn = 0; dn < 8; ++dn) O[dn] = (f32x4){0.f, 0.f, 0.f, 0.f};
    const int band0 = cb * 16 - 8 < 0 ? 0 : (cb * 16 - 8 > 32 ? 32 : cb * 16 - 8), qc = cb * 16 + i, cs = qc - 8 < 0 ? 0 : (qc - 8 > 48 ? 48 : qc - 8);
    int item = 0;
    const int rot = (c.bid * 13) & 127;
    if (item < NITEM) nat_issue(c, nat_unit(c, 0) * 4, kr, vr, qn, rot);
    while (item < NITEM) {
        const int unit = nat_unit(c, item >> 2), chunk = item & 3, hp = unit & 3, r = (unit >> 2) & 31, b = unit >> 7;
        const int rs = r - 4 < 0 ? 0 : (r - 4 > 24 ? 24 : r - 4);
        __syncthreads();
        att_write_lds(c, kr, vr, rot);
        if (chunk == 0) {
            for (int k = c.tid; k < 930; k += NTHR) rp[k] = c.b_rpb[(2 * hp) * 465 + k];
#pragma unroll
            for (int kk = 0; kk < 4; ++kk) qf[kk] = qn[kk];
        }
        __syncthreads();
        const int nitem = item + 1;
        if (nitem < NITEM) nat_issue(c, nat_unit(c, nitem >> 2) * 4 + (nitem & 3), kr, vr, qn, rot);
        {
            const int a0 = 2 * chunk;
            const NattenFn fn[2] = {{rp + hh * 465, (rs + a0 - r + 7) * 31, band0, cs, qc, g}, {rp + hh * 465, (rs + a0 + 1 - r + 7) * 31, band0, cs, qc, g}};
            const int krow[2] = {hh * 128 + band0, hh * 128 + 64 + band0};
            attn_blocks<2, NattenFn>(c.lds, krow, qf, O, m, l, i, g, fn);
        }
        if (chunk == 3) {
            float lt = l; lt += shx(lt, 16, lane); lt += shx(lt, 32, lane);
            const float inv = 1.0f / lt;
            bf16* Y = (bf16*)(c.ws + WS_YCAT) + (size_t)(b * SEQ + r * 64 + qc) * DM + 1024 + (2 * hp + hh) * 128 + 4 * g;
#pragma unroll
            for (int dn = 0; dn < 8; ++dn) { u32x2 o; o.x = cvt_pk_bf16(O[dn][0] * inv, O[dn][1] * inv); o.y = cvt_pk_bf16(O[dn][2] * inv, O[dn][3] * inv);
                *(u32x2*)(Y + 16 * dn) = o; O[dn] = (f32x4){0.f, 0.f, 0.f, 0.f}; }
            m = -1e30f; l = 0.f;
        }
        item = nitem;
    }
}

struct ConvRegs { u32x4 cbv[2], cc[2][3], cx[2][3]; float wt[2][3]; };
__device__ __forceinline__ void conv_load(const Ctx& c, int u, int j, ConvRegs& r) {
    const bf16* P = (const bf16*)(c.ws + WS_P);
#pragma unroll
    for (int k = 0; k < 2; ++k) { const int id = c.tid + 512 * (j + k), tok = 64 * u + (id >> 7), c8 = id & 127, s = tok & (SEQ - 1);
        const bf16* row = P + (size_t)tok * IN_CD + 8 * c8; r.cbv[k] = *(const u32x4*)row;
#pragma unroll
        for (int w = 0; w < 3; ++w) { const int ss = s + w - 1; const bool in = ss >= 0 && ss < SEQ; r.wt[k][w] = in ? 1.f : 0.f;
            const bf16* rr = row + (ptrdiff_t)(in ? w - 1 : 0) * IN_CD; r.cc[k][w] = *(const u32x4*)(rr + 1024); r.cx[k][w] = *(const u32x4*)(rr + 2048); } }
}
__device__ __forceinline__ void conv_finish(const Ctx& c, int u, int j, const ConvRegs& r) {
    bf16* Y = (bf16*)(c.ws + WS_YCAT);
#pragma unroll
    for (int k = 0; k < 2; ++k) { const int id = c.tid + 512 * (j + k), tok = 64 * u + (id >> 7), c8 = id & 127;
        f32x4 acc0 = {0.f, 0.f, 0.f, 0.f}, acc1 = {0.f, 0.f, 0.f, 0.f};
#pragma unroll
        for (int w = 0; w < 3; ++w) { const f32x4 t0 = *(const f32x4*)(c.c_conv + w * 1024 + 8 * c8) * r.wt[k][w], t1 = *(const f32x4*)(c.c_conv + w * 1024 + 8 * c8 + 4) * r.wt[k][w];
            const u32x4 a = r.cc[k][w], x = r.cx[k][w];
            acc0.x += t0.x * bf_lo(a.x) * bf_lo(x.x); acc0.y += t0.y * bf_hi(a.x) * bf_hi(x.x); acc0.z += t0.z * bf_lo(a.y) * bf_lo(x.y); acc0.w += t0.w * bf_hi(a.y) * bf_hi(x.y);
            acc1.x += t1.x * bf_lo(a.z) * bf_lo(x.z); acc1.y += t1.y * bf_hi(a.z) * bf_hi(x.z); acc1.z += t1.z * bf_lo(a.w) * bf_lo(x.w); acc1.w += t1.w * bf_hi(a.w) * bf_hi(x.w); }
        const u32x4 b = r.cbv[k];
        u32x4 o; o.x = cvt_pk_bf16(bf_lo(b.x) * acc0.x, bf_hi(b.x) * acc0.y); o.y = cvt_pk_bf16(bf_lo(b.y) * acc0.z, bf_hi(b.y) * acc0.w);
        o.z = cvt_pk_bf16(bf_lo(b.z) * acc1.x, bf_hi(b.z) * acc1.y); o.w = cvt_pk_bf16(bf_lo(b.w) * acc1.z, bf_hi(b.w) * acc1.w);
        *(u32x4*)(Y + (size_t)tok * DM + 8 * c8) = o; }
}
__device__ __forceinline__ void conv_unit(const Ctx& c, int u) {
    ConvRegs ra, rb;
    conv_load(c, u, 0, ra);
#pragma unroll 1
    for (int j = 0; j < 16; j += 4) {
        conv_load(c, u, j + 2, rb);
        conv_finish(c, u, j, ra);
        if (j + 4 < 16) conv_load(c, u, j + 4, ra);
        conv_finish(c, u, j + 2, rb);
    }
}
struct DilFn { float slope_dil; int qi, g, klbase, length, rowb;
    __device__ __forceinline__ float operator()(int t, int reg, float s) const {
        const int jj = rowb + 16 * t + 4 * g + reg, delta = jj - 64 - qi, ad = delta < 0 ? -delta : delta, kl = klbase + jj;
        const float v = (s * ATT_SCALE - slope_dil * (float)ad) * LOG2E;
        return (ad <= 64 && kl >= 0 && kl < length) ? v : -INFINITY; } };
struct DilDec { int pat, h, b, dil, L, qc, res; };
__device__ __forceinline__ DilDec dil_decode(int u) { DilDec d; d.pat = u >> 10; d.h = u & 7; d.b = (u >> 3) & 7; const int sub = (u >> 6) & 15; d.dil = 1 << (2 * d.pat); const int nch = 16 >> (2 * d.pat);
    d.L = SEQ >> (2 * d.pat); d.qc = sub % nch; d.res = sub / nch; return d; }
__device__ __forceinline__ void dil_issue(const Ctx& c, int u, u32x4 (&kr)[8], u32x4 (&vr)[8], bf16x8 (&qn)[4], int rot) {
    const DilDec d = dil_decode(u);
    const bf16* QKV = (const bf16*)(c.ws + WS_QKV) + (size_t)(d.b * 8 + d.h) * SEQ * 128; constexpr size_t WSTEP = QKV_STRIDE;
#pragma unroll
    for (int j = 0; j < 8; ++j) { const int id = c.tid + 512 * j, row = ((id >> 4) & 128) | (((id >> 4) + rot) & 127), c16 = id & 15; int kl = 128 * d.qc - 64 + row;
        kl = kl < 0 ? 0 : (kl > d.L - 1 ? d.L - 1 : kl);
        const bf16* src = QKV + WSTEP + (size_t)(kl * d.dil + d.res) * 128 + 8 * c16; kr[j] = *(const u32x4*)src; vr[j] = *(const u32x4*)(src + WSTEP); }
    const int i = c.lane & 15, g = c.lane >> 4;
#pragma unroll
    for (int kk = 0; kk < 4; ++kk) qn[kk] = *(const bf16x8*)(QKV + (size_t)((128 * d.qc + 16 * c.wave + i) * d.dil + d.res) * 128 + 32 * kk + 8 * g);
}
__device__ __forceinline__ int dil_unit(const Ctx& c, int k) {
    if (c.G == 256) { const int x = c.bid & 7, ci = c.bid >> 3, lu = (k % 3) * 32 + ci, bh = 8 * x + 2 * (k / 3) + lu / 48, v = lu % 48;
        return ((v / 16) << 10) | ((v % 16) << 6) | bh; }
    return c.bid + k * c.G;
}
__device__ __forceinline__ void p_dilated(const Ctx& c) {
    const int NU = (3072 - c.bid + c.G - 1) / c.G;
    const int lane = c.lane, wave = c.wave, i = lane & 15, g = lane >> 4;
    u32x4 kr[8], vr[8]; bf16x8 qn[4], qf[4];
    const int rot = (c.bid * 13) & 127;
    if (0 < NU) dil_issue(c, dil_unit(c, 0), kr, vr, qn, rot);
    for (int k = 0; k < NU; ++k) {
        const int u = dil_unit(c, k);
        const DilDec d = dil_decode(u);
        __syncthreads();
        att_write_lds(c, kr, vr, rot);
#pragma unroll
        for (int kk = 0; kk < 4; ++kk) qf[kk] = qn[kk];
        __syncthreads();
        if (k + 1 < NU) dil_issue(c, dil_unit(c, k + 1), kr, vr, qn, rot);
        f32x4 O[8]; float m = -1e30f, l = 0.f;
        const int qi = 16 * wave + i, klbase = 128 * d.qc - 64, kb0 = wave >> 1;
#pragma unroll 1
        for (int crep = 0; crep < MK_DIL_REPS; ++crep) {
        m = -1e30f; l = 0.f;
#pragma unroll
        for (int dn = 0; dn < 8; ++dn) O[dn] = (f32x4){0.f, 0.f, 0.f, 0.f};
        const int lo_row = klbase < 0 ? -klbase : 0, hi_row = d.L - klbase < 256 ? d.L - klbase : 256;
        const float slope_dil = __builtin_amdgcn_exp2f(-(float)(d.h + 1)) * (float)d.dil;
#pragma unroll 1
        for (int pr = 0; pr < 2; ++pr) { const int r0 = 32 * (kb0 + 2 * pr);
            if (r0 + 64 > lo_row && r0 < hi_row) {
                const DilFn fn[2] = {{slope_dil, qi, g, klbase, d.L, r0}, {slope_dil, qi, g, klbase, d.L, r0 + 32}};
                const int krow[2] = {r0, r0 + 32};
                attn_blocks<2, DilFn>(c.lds, krow, qf, O, m, l, i, g, fn); } }
        { const int r0 = 32 * (kb0 + 4);
            if (r0 + 32 > lo_row && r0 < hi_row) {
                const DilFn fn[1] = {{slope_dil, qi, g, klbase, d.L, r0}};
                const int krow[1] = {r0};
                attn_blocks<1, DilFn>(c.lds, krow, qf, O, m, l, i, g, fn); } }
        }
        float lt = l; lt += shx(lt, 16, lane); lt += shx(lt, 32, lane);
        const float inv = 1.0f / lt;
        const int tokq = d.b * SEQ + (128 * d.qc + qi) * d.dil + d.res;
        bf16* OP = (bf16*)(c.ws + WS_OP) + (size_t)d.pat * OP_STRIDE + (size_t)tokq * 1024 + d.h * 128 + 4 * g;
#pragma unroll
        for (int dn = 0; dn < 8; ++dn) { u32x2 o; o.x = cvt_pk_bf16(O[dn][0] * inv, O[dn][1] * inv); o.y = cvt_pk_bf16(O[dn][2] * inv, O[dn][3] * inv); *(u32x2*)(OP + 16 * dn) = o; }
        if (g == 0) ((float*)(c.ws + WS_LSE))[((size_t)d.pat * M + tokq) * 8 + d.h] = (m + __builtin_amdgcn_logf(lt)) * LN2;
    }
}
__device__ __forceinline__ void p_merge(const Ctx& c) {
    const bf16* OP = (const bf16*)(c.ws + WS_OP); const float* LSE = (const float*)(c.ws + WS_LSE); bf16* Y = (bf16*)(c.ws + WS_YCAT);
    const int stride = c.G * NTHR;
    for (int id0 = c.bid * NTHR + c.tid; id0 < M * 128; id0 += 4 * stride) {
        float l[4][3]; u32x4 a[4][3]; bool ok[4];
#pragma unroll
        for (int k = 0; k < 4; ++k) { const int id = id0 + k * stride; ok[k] = id < M * 128; const int idc = ok[k] ? id : id0, tok = idc >> 7, c8 = idc & 127, h = c8 >> 4;
#pragma unroll
            for (int p = 0; p < 3; ++p) { l[k][p] = LSE[((size_t)p * M + tok) * 8 + h]; a[k][p] = *(const u32x4*)(OP + (size_t)p * OP_STRIDE + (size_t)tok * 1024 + 8 * c8); } }
#pragma unroll
        for (int k = 0; k < 4; ++k) { const int id = id0 + k * stride, tok = id >> 7, c8 = id & 127;
            const float mx = fmaxf(l[k][0], fmaxf(l[k][1], l[k][2])); float w0 = __expf(l[k][0] - mx), w1 = __expf(l[k][1] - mx), w2 = __expf(l[k][2] - mx); const float inv = 1.0f / (w0 + w1 + w2); w0 *= inv; w1 *= inv; w2 *= inv;
            u32x4 o;
#pragma unroll
            for (int q = 0; q < 4; ++q) o[q] = cvt_pk_bf16(w0 * bf_lo(a[k][0][q]) + w1 * bf_lo(a[k][1][q]) + w2 * bf_lo(a[k][2][q]), w0 * bf_hi(a[k][0][q]) + w1 * bf_hi(a[k][1][q]) + w2 * bf_hi(a[k][2][q]));
            if (ok[k]) *(u32x4*)(Y + (size_t)tok * DM + 1024 + 8 * c8) = o; }
    }
}

__device__ __forceinline__ void p_router(const Ctx& c, int layer) {
    const int lane = c.lane, wave = c.wave, i = lane & 15, g = lane >> 4, NU = M / 16;
    constexpr int XP = 4112, XBUF = 16 * XP;
    LAS float* red = (LAS float*)(c.lds + 2 * XBUF); LAS float* ssq = red + 2048;
    const float* gnf = c.norm_ffn + layer * DM;
    const float* gn = gnf + 256 * wave + 4 * g;
    const float* R = c.router + (size_t)layer * DM * NE + (size_t)(256 * wave + 4 * g) * NE + i;
    float rg[64];
#pragma unroll
    for (int kk = 0; kk < 16; ++kk) { const f32x4 g4 = *(const f32x4*)(gn + 16 * kk);
#pragma unroll
        for (int s = 0; s < 4; ++s) rg[4 * kk + s] = R[(size_t)(16 * kk + s) * NE] * g4[s]; }
    const unsigned char* XR = c.ws + WS_XRES;
#define RT_ISSUE(uu, bb) do { _Pragma("unroll") for (int _j = 0; _j < 8; ++_j) { const int _p = 8 * wave + _j; \
        __builtin_amdgcn_global_load_lds((const unsigned*)(XR + ((size_t)(uu) * 16 + (_p >> 2)) * 4096 + (_p & 3) * 1024 + lane * 16), (LAS unsigned*)(c.lds + (bb) * XBUF + (_p >> 2) * XP + (_p & 3) * 1024), 16, 0, 0); } } while (0)
    __syncthreads();
    int u = c.bid, b = 0;
    if (u < NU) RT_ISSUE(u, 0);
    for (; u < NU; u += c.G, b ^= 1) {
        const int row0 = u * 16;
        asm volatile("s_waitcnt vmcnt(0)" ::: "memory"); __syncthreads();
        if (u + c.G < NU) RT_ISSUE(u + c.G, b ^ 1);
        const LAS unsigned char* xb = c.lds + b * XBUF + i * XP + (256 * wave + 4 * g) * 2;
        float ss = 0.f; f32x4 acc0 = {0.f, 0.f, 0.f, 0.f}, acc1 = {0.f, 0.f, 0.f, 0.f};
#pragma unroll
        for (int kk = 0; kk < 16; ++kk) { const u32x2 w = *(const LAS u32x2*)(xb + 32 * kk); const float x0 = bf_lo(w.x), x1 = bf_hi(w.x), x2 = bf_lo(w.y), x3 = bf_hi(w.y);
            ss += (x0 * x0 + x1 * x1) + (x2 * x2 + x3 * x3);
            acc0 = __builtin_amdgcn_mfma_f32_16x16x4f32(x0, rg[4 * kk + 0], acc0, 0, 0, 0); acc1 = __builtin_amdgcn_mfma_f32_16x16x4f32(x1, rg[4 * kk + 1], acc1, 0, 0, 0);
            acc0 = __builtin_amdgcn_mfma_f32_16x16x4f32(x2, rg[4 * kk + 2], acc0, 0, 0, 0); acc1 = __builtin_amdgcn_mfma_f32_16x16x4f32(x3, rg[4 * kk + 3], acc1, 0, 0, 0); }
        const f32x4 acc = acc0 + acc1;
        ss += shx(ss, 16, lane); ss += shx(ss, 32, lane);
#pragma unroll
        for (int r = 0; r < 4; ++r) red[wave * 256 + (4 * g + r) * 16 + i] = acc[r];
        if (g == 0) ssq[wave * 16 + i] = ss;
        __syncthreads();
#pragma unroll
        for (int j = 0; j < 4; ++j) { const int cid = c.tid + 512 * j, row = cid >> 7, c16 = cid & 127; float tot = 0.f;
#pragma unroll
            for (int w = 0; w < 8; ++w) tot += ssq[w * 16 + row];
            const float rstd = 1.0f / sqrtf(tot * (1.0f / DM) + RMS_EPS);
            const LAS unsigned char* xs = c.lds + b * XBUF + row * XP + c16 * 32;
            const u32x4 wa = *(const LAS u32x4*)xs, wb = *(const LAS u32x4*)(xs + 16);
            u32x4 o;
#pragma unroll
            for (int q = 0; q < 4; ++q) { const unsigned wq0 = q < 2 ? wa[2 * q] : wb[2 * q - 4], wq1 = q < 2 ? wa[2 * q + 1] : wb[2 * q - 3];
                const f32x4 g4 = *(const f32x4*)(gnf + 16 * c16 + 4 * q) * rstd; int p = 0;
                p = __builtin_amdgcn_cvt_pk_fp8_f32(__builtin_amdgcn_fmed3f(bf_lo(wq0) * g4.x, -448.f, 448.f), __builtin_amdgcn_fmed3f(bf_hi(wq0) * g4.y, -448.f, 448.f), p, false);
                p = __builtin_amdgcn_cvt_pk_fp8_f32(__builtin_amdgcn_fmed3f(bf_lo(wq1) * g4.z, -448.f, 448.f), __builtin_amdgcn_fmed3f(bf_hi(wq1) * g4.w, -448.f, 448.f), p, true);
                o[q] = (unsigned)p; }
            *(u32x4*)(c.ws + WS_H8 + (size_t)(row0 + row) * DM + 16 * c16) = o; }
        if (wave == 0) {
            float* AFF = (float*)(c.ws + WS_AFF);
#pragma unroll
            for (int r = 0; r < 4; ++r) { const int row = 4 * g + r; float t2 = 0.f, lg = 0.f;
#pragma unroll
                for (int w = 0; w < 8; ++w) { t2 += ssq[w * 16 + row]; lg += red[w * 256 + row * 16 + i]; }
                lg *= 1.0f / sqrtf(t2 * (1.0f / DM) + RMS_EPS);
                float mx = lg;
#pragma unroll
                for (int o = 1; o < 16; o <<= 1) mx = fmaxf(mx, shx(mx, o, lane));
                const float ex = __expf(lg - mx); float sm = ex;
#pragma unroll
                for (int o = 1; o < 16; o <<= 1) sm += shx(sm, o, lane);
                const int grow = row0 + row;
                AFF[((size_t)(grow >> 11) * NE + i) * SEQ + (grow & (SEQ - 1))] = ex / sm; }
        }
    }
#undef RT_ISSUE
    asm volatile("s_waitcnt vmcnt(0)" ::: "memory");
}

__device__ __forceinline__ void topk_unit(const Ctx& c, int w) {
    const int be = w, e = be >> 3, b = be & 7, lane = c.lane, wave = c.wave, tid = c.tid;
    LAS unsigned* wsum = (LAS unsigned*)c.lds;
    const u32x4 mine = *(const u32x4*)((const unsigned*)(c.ws + WS_AFF) + (size_t)(b * NE + e) * SEQ + 4 * tid);
    __syncthreads();
    unsigned T = 0u;
    for (int bit = 30; bit >= 0; --bit) {
        const unsigned cand = T | (1u << bit);
        int cnt = (int)(mine.x >= cand) + (int)(mine.y >= cand) + (int)(mine.z >= cand) + (int)(mine.w >= cand);
#pragma unroll
        for (int o = 1; o < 64; o <<= 1) cnt += shx(cnt, o, lane);
        if (lane == 0) wsum[(bit & 1) * 8 + wave] = (unsigned)cnt;
        __syncthreads();
        unsigned tot = 0u;
#pragma unroll
        for (int k = 0; k < 8; ++k) tot += wsum[(bit & 1) * 8 + k];
        if (tot >= (unsigned)CAP) T = cand;
    }
    unsigned gt[4], eq[4]; unsigned val = 0u;
#pragma unroll
    for (int k = 0; k < 4; ++k) { gt[k] = mine[k] > T ? 1u : 0u; eq[k] = mine[k] == T ? 1u : 0u; val += gt[k] + (eq[k] << 16); }
    unsigned incl = val;
#pragma unroll
    for (int o = 1; o < 64; o <<= 1) { const unsigned t = shup(incl, o, lane); if (lane >= o) incl += t; }
    if (lane == 63) wsum[16 + wave] = incl;
    __syncthreads();
    unsigned base = 0u, total = 0u;
#pragma unroll
    for (int k = 0; k < 8; ++k) { const unsigned t = wsum[16 + k]; total += t; if (k < wave) base += t; }
    const unsigned excl = base + incl - val, need = (unsigned)CAP - (total & 0xffffu);
    unsigned gtb = excl & 0xffffu, eqb = excl >> 16;
    int* SEL = (int*)(c.ws + WS_SEL); float* GATE = (float*)(c.ws + WS_GATE); int* IDX = (int*)(c.ws + WS_IDX);
#pragma unroll
    for (int k = 0; k < 4; ++k) { const int s = 4 * tid + k; const bool sel = gt[k] || (eq[k] && eqb < need); const unsigned slot = gtb + (eqb < need ? eqb : need);
        if (sel) { IDX[be * CAP + slot] = b * SEQ + s; GATE[be * CAP + slot] = __uint_as_float(mine[k]); }
        SEL[((size_t)b * SEQ + s) * NE + e] = sel ? (int)slot : -1;
        gtb += gt[k]; eqb += eq[k]; }
}

template <int FINAL>
__device__ __forceinline__ void p_combine(const Ctx& c, const float* gw) {
    const int lane = c.lane, stride = c.G * NWAVES; int m = c.bid * NWAVES + c.wave;
    if (m >= M) return;
    const unsigned char* YE = c.ws + WS_YE; const int* SEL = (const int*)(c.ws + WS_SEL);
    u32x4 xw[4], xn[4]; int selv, seln;
    { const bf16* xr = (const bf16*)(c.ws + WS_XRES) + (size_t)m * DM;
#pragma unroll
      for (int j = 0; j < 4; ++j) xw[j] = *(const u32x4*)(xr + 512 * j + 8 * lane);
      selv = SEL[(size_t)m * NE + (lane & 15)]; }
    for (;;) {
        const int mn = m + stride; const bool more = mn < M;
        if (more) { const bf16* xr = (const bf16*)(c.ws + WS_XRES) + (size_t)mn * DM;
#pragma unroll
            for (int j = 0; j < 4; ++j) xn[j] = *(const u32x4*)(xr + 512 * j + 8 * lane);
            seln = SEL[(size_t)mn * NE + (lane & 15)]; }
        const int b = m >> 11;
        f32x4 v[8];
#pragma unroll
        for (int j = 0; j < 4; ++j) { const u32x4 w = xw[j];
            v[2 * j] = (f32x4){bf_lo(w.x), bf_hi(w.x), bf_lo(w.y), bf_hi(w.y)}; v[2 * j + 1] = (f32x4){bf_lo(w.z), bf_hi(w.z), bf_lo(w.w), bf_hi(w.w)}; }
        unsigned mask = (unsigned)__builtin_amdgcn_ballot_w64(selv >= 0) & 0xffffu;
        while (mask) {
            u32x2 y[4][4]; int have[4];
#pragma unroll
            for (int t = 0; t < 4; ++t) { have[t] = mask != 0u;
                if (have[t]) { const int e = __builtin_ctz(mask); mask &= mask - 1u; const int slot = __builtin_amdgcn_readlane(selv, e);
                    const unsigned char* yr = YE + (size_t)((e * 8 + b) * CAP + slot) * DM + 8 * lane;
#pragma unroll
                    for (int j = 0; j < 4; ++j) y[t][j] = *(const u32x2*)(yr + 512 * j); } }
#pragma unroll
            for (int t = 0; t < 4; ++t) if (have[t]) {
#pragma unroll
                for (int j = 0; j < 4; ++j) { const u32x2 yy = y[t][j]; constexpr float YI = 1.0f / YE_SCALE;
                    const auto a0 = __builtin_amdgcn_cvt_pk_f32_fp8((int)yy.x, false), a1 = __builtin_amdgcn_cvt_pk_f32_fp8((int)yy.x, true), a2 = __builtin_amdgcn_cvt_pk_f32_fp8((int)yy.y, false), a3 = __builtin_amdgcn_cvt_pk_f32_fp8((int)yy.y, true);
                    v[2 * j].x += a0[0] * YI; v[2 * j].y += a0[1] * YI; v[2 * j].z += a1[0] * YI; v[2 * j].w += a1[1] * YI;
                    v[2 * j + 1].x += a2[0] * YI; v[2 * j + 1].y += a2[1] * YI; v[2 * j + 1].z += a3[0] * YI; v[2 * j + 1].w += a3[1] * YI; } }
        }
        float ss = 0.f;
#pragma unroll
        for (int j = 0; j < 8; ++j) ss += (v[j].x * v[j].x + v[j].y * v[j].y) + (v[j].z * v[j].z + v[j].w * v[j].w);
        const float rstd = 1.0f / sqrtf(wave_sum(ss, lane) * (1.0f / DM) + RMS_EPS);
#pragma unroll
        for (int j = 0; j < 4; ++j) {
            const f32x4 g0 = *(const f32x4*)(gw + 512 * j + 8 * lane), g1 = *(const f32x4*)(gw + 512 * j + 8 * lane + 4);
            const f32x4 a = v[2 * j] * rstd * g0, b2 = v[2 * j + 1] * rstd * g1;
            if (FINAL) { float* orow = c.out + (size_t)m * DM + 512 * j + 8 * lane; *(f32x4*)orow = a; *(f32x4*)(orow + 4) = b2; }
            else { { u32x4 xo; xo.x = cvt_pk_bf16(v[2 * j].x, v[2 * j].y); xo.y = cvt_pk_bf16(v[2 * j].z, v[2 * j].w); xo.z = cvt_pk_bf16(v[2 * j + 1].x, v[2 * j + 1].y); xo.w = cvt_pk_bf16(v[2 * j + 1].z, v[2 * j + 1].w);
                    *(u32x4*)((bf16*)(c.ws + WS_XRES) + (size_t)m * DM + 512 * j + 8 * lane) = xo; }
                u32x4 o; o.x = cvt_pk_bf16(a.x, a.y); o.y = cvt_pk_bf16(a.z, a.w); o.z = cvt_pk_bf16(b2.x, b2.y); o.w = cvt_pk_bf16(b2.z, b2.w);
                *(u32x4*)((bf16*)(c.ws + WS_H) + (size_t)m * DM + 512 * j + 8 * lane) = o;
                int p0 = 0, p1 = 0;
                p0 = __builtin_amdgcn_cvt_pk_fp8_f32(__builtin_amdgcn_fmed3f(a.x, -448.f, 448.f), __builtin_amdgcn_fmed3f(a.y, -448.f, 448.f), p0, false); p0 = __builtin_amdgcn_cvt_pk_fp8_f32(__builtin_amdgcn_fmed3f(a.z, -448.f, 448.f), __builtin_amdgcn_fmed3f(a.w, -448.f, 448.f), p0, true);
                p1 = __builtin_amdgcn_cvt_pk_fp8_f32(__builtin_amdgcn_fmed3f(b2.x, -448.f, 448.f), __builtin_amdgcn_fmed3f(b2.y, -448.f, 448.f), p1, false); p1 = __builtin_amdgcn_cvt_pk_fp8_f32(__builtin_amdgcn_fmed3f(b2.z, -448.f, 448.f), __builtin_amdgcn_fmed3f(b2.w, -448.f, 448.f), p1, true);
                u32x2 w8; w8.x = (unsigned)p0; w8.y = (unsigned)p1; *(u32x2*)(c.ws + WS_H8 + (size_t)m * DM + 512 * j + 8 * lane) = w8; } }
        if (!more) break;
        m = mn; selv = seln;
#pragma unroll
        for (int j = 0; j < 4; ++j) xw[j] = xn[j];
    }
}

typedef __attribute__((address_space(4))) const unsigned char* kaptr_t;
__device__ __forceinline__ bool phase_enter(Ctx& c) { const int ln = lane_now(); int w = c.wave0; asm volatile("" : "+s"(w)); c.wave = w; c.lane = ln; c.tid = w * 64 + ln;
    kaptr_t ka = (kaptr_t)__builtin_amdgcn_kernarg_segment_ptr(); asm volatile("" : "+s"(ka));
    typedef const float* fptr_t; typedef float* mfptr_t; typedef unsigned char* ucptr_t; typedef __attribute__((address_space(4))) const fptr_t* inptr_t; inptr_t in = (inptr_t)ka;
    c.x = in[0]; c.norm_mix = in[1]; c.norm_ffn = in[2]; c.norm_final = in[3]; c.w_in_ab = in[4]; c.a_v_norm = in[5]; c.a_sw = in[6]; c.a_sb = in[7];
    c.b_rpb = in[8]; c.w_out_ab = in[9]; c.w_in_cd = in[10]; c.c_conv = in[11]; c.w_out_cd = in[12]; c.router = in[13]; c.w_gate = in[14]; c.w_up = in[15]; c.w_down = in[16];
    c.out = *(__attribute__((address_space(4))) const mfptr_t*)(ka + 136); c.ws = *(__attribute__((address_space(4))) const ucptr_t*)(ka + 144);
    return true; }
constexpr int NPH = 18;
struct Args { const float* in[17]; float* out; unsigned char* ws; int ph_lo, ph_hi; };
__global__ void __launch_bounds__(NTHR, 2) mk_fwd(Args args) {
    extern __shared__ __attribute__((aligned(16))) unsigned char lds_raw[];
    Ctx c;
    c.lds = (LAS unsigned char*)lds_raw;
    c.tid = threadIdx.x; c.lane = c.tid & 63; c.wave = __builtin_amdgcn_readfirstlane(c.tid >> 6); c.wave0 = c.wave; c.G = gridDim.x; c.bid = blockIdx.x;
    c.ws = args.ws;
    static_assert(sizeof(Args) == 160, "phase_enter reads the kernarg segment by offset");
    volatile LAS unsigned* MISC = (volatile LAS unsigned*)(c.lds + MISC_OFF);
    for (int u = c.tid; u < (LDS_BYTES - LDSCTL_OFF) / 4; u += NTHR) ((LAS unsigned*)(c.lds + LDSCTL_OFF))[u] = 0u;
    __syncthreads();
    unsigned* barw = (unsigned*)(c.ws + WS_CTL) + 1024;
    XcdBarrier bar; bar.bar = barw; bar.x = 0; bar.st = nullptr; bar.wave = c.wave0;
    const int lo = args.ph_lo, hi = args.ph_hi;
#define NOST ((hi - lo == 1) ? (MK_PROBE_NOSTORE) : 0)
    if (hi - lo > 1) bar = xcd_barrier_post(barw, MISC + 8, c.wave0);
#define IN(k) (lo <= (k) && (k) < hi && phase_enter(c))
#define PH(k) for (int rep_ = 0; rep_ < (((k) == MK_REPEAT) ? 2 : 1); ++rep_) if (IN(k))
#define INR(k) (lo <= (k) && (k) < hi)
#define SEAM(k) do { if (INR(k) && INR((k) + 1)) { xcd_barrier(bar); if (MK_DOUBLE_BAR) xcd_barrier(bar); } } while (0)
#define H ((bf16*)(c.ws + WS_H))
#define P ((bf16*)(c.ws + WS_P))
#define YC ((bf16*)(c.ws + WS_YCAT))
#define XRES ((bf16*)(c.ws + WS_XRES))

    PH(0) { p_prologue(c); } SEAM(0);
    for (int layer = 0; layer < 2; ++layer) {
        const int pb = 1 + 8 * layer;
        if (layer == 0) {
            PH(1) { conv_job_half(c, 1, 0); conv_job_half(c, 4, 0); __syncthreads();
                { pg8::Gemm g{H, (const bf16*)(c.ws + WS_WIN0), M, 2048, DM}; pg8::Order S; S.init(M, 2048, c.G, c.bid, 0);
                  pg8::EpiBf16 E{P, IN_AB, 8, 1 << 30, (bf16*)(c.ws + WS_QKV), QKV_STRIDE, 1.0f, NOST}; pg8::gemm_phase<pg8::EpiBf16, pg8::Order, MK_ALIGN, MK_SP2>(c.lds, g, S, E, c.tid); }
                { pg8::Gemm g{(const bf16*)(c.ws + WS_H8), (const bf16*)(c.ws + WS_WIN8), M, 3072, DM}; pg8::Order S; S.init(M, 3072, c.G, c.bid, 0);
                  { LAS int* tab = (LAS int*)(c.lds + RING_BYTES); S.tab = tab; pg8::Unit uu;
#pragma unroll 1
                    for (int kq = 0; kq < 15 && S.next(kq, uu); ++kq) if (c.tid < 256) tab[kq * 256 + c.tid] = uu.pm * 256 + c.tid;
                    __syncthreads(); }
                  pg8::EpiBf16 E{P, IN_AB, 0, 0, (bf16*)(c.ws + WS_QKV), QKV_STRIDE, 1.0f / W8_SCALE, NOST}; pg8::gemm_phase<pg8::EpiBf16, pg8::Order, MK_ALIGN, MK_SP2, true, true>(c.lds, g, S, E, c.tid); }
                conv_job_half(c, 1, 1); conv_job_half(c, 4, 1); } SEAM(1);
            PH(2) { for (int rp2 = 0; rp2 < (MK_REPEAT == 20 ? 2 : 1); ++rp2) for (int u = c.bid; u < 256; u += c.G) sgu_unit(c, u); for (int rp2 = 0; rp2 < (MK_REPEAT == 21 ? 2 : 1); ++rp2) p_natten(c); } SEAM(2);
            PH(3) { conv_job_half(c, 5, 0); __syncthreads(); pg8::Gemm g{YC, (const bf16*)(c.ws + WS_WOUT0), M, DM, DM}; pg8::Order S; S.init(M, DM, c.G, c.bid, 0);
                pg8::EpiResidB E{c.x, XRES, DM, 1}; pg8::gemm_phase<pg8::EpiResidB, pg8::Order, MK_ALIGN, MK_SP2>(c.lds, g, S, E, c.tid); conv_job_half(c, 5, 1); } SEAM(3);
        } else {
            PH(8) { p_combine<0>(c, c.norm_mix + DM); } SEAM(8);
            PH(9) { { pg8::Gemm g{H, (const bf16*)(c.ws + WS_WIN1), M, 3072, DM}; pg8::Order S; S.init(M, 3072, c.G, c.bid, 0);
                  pg8::EpiBf16 E{P, IN_CD, 0, 1 << 30, (bf16*)(c.ws + WS_QKV), QKV_STRIDE, 1.0f, NOST}; pg8::gemm_phase<pg8::EpiBf16, pg8::Order, MK_ALIGN, MK_SP2>(c.lds, g, S, E, c.tid); }
                { pg8::Gemm g{(const bf16*)(c.ws + WS_H8), (const bf16*)(c.ws + WS_WIN8 + 6 * MiB), M, 3072, DM}; pg8::Order S; S.init(M, 3072, c.G, c.bid, 0);
                  { LAS int* tab = (LAS int*)(c.lds + RING_BYTES); S.tab = tab; pg8::Unit uu;
#pragma unroll 1
                    for (int kq = 0; kq < 15 && S.next(kq, uu); ++kq) if (c.tid < 256) tab[kq * 256 + c.tid] = uu.pm * 256 + c.tid;
                    __syncthreads(); }
                  pg8::EpiBf16 E{P, IN_CD, 0, 0, (bf16*)(c.ws + WS_QKV), QKV_STRIDE, 1.0f / W8_SCALE, NOST}; pg8::gemm_phase<pg8::EpiBf16, pg8::Order, MK_ALIGN, MK_SP2, true, true>(c.lds, g, S, E, c.tid); } } SEAM(9);
            PH(10) { for (int rp2 = 0; rp2 < (MK_REPEAT == 100 ? 2 : 1); ++rp2) for (int u = c.bid; u < 256; u += c.G) conv_unit(c, u); for (int rp2 = 0; rp2 < (MK_REPEAT == 101 ? 2 : 1); ++rp2) p_dilated(c); } SEAM(10);
            PH(11) { p_merge(c); } SEAM(11);
            PH(12) { pg8::Gemm g{YC, (const bf16*)(c.ws + WS_WOUT1), M, DM, DM}; pg8::Order S; S.init(M, DM, c.G, c.bid, 0);
                pg8::EpiResidB E{XRES, XRES, DM, 0}; pg8::gemm_phase<pg8::EpiResidB, pg8::Order, MK_ALIGN, MK_SP2>(c.lds, g, S, E, c.tid); } SEAM(12);
        }
        const int pr = layer == 0 ? 4 : 13;
        PH(pr) { p_router(c, layer); } SEAM(pr);
        PH(pr + 1) { for (int u = c.bid; u < 128; u += c.G) topk_unit(c, u); } SEAM(pr + 1);
        PH(pr + 2) { if (layer == 0) { conv_job_half(c, 2, 0); conv_job_half(c, 3, 0); conv_job_half(c, 6, 0); } __syncthreads();
            pg8::Gemm g{(const bf16*)(c.ws + WS_H8), (const bf16*)(c.ws + WS_WGU + (size_t)layer * 128 * MiB), MOE_ROWS, 4096, DM};     pg8::Order S; S.init(MOE_ROWS, 4096, c.G, c.bid, 1);
            { LAS int* tab = (LAS int*)(c.lds + RING_BYTES); S.tab = tab; const int* IDX = (const int*)(c.ws + WS_IDX); pg8::Unit uu;
#pragma unroll 1
                for (int k = c.wave; k < 15 && S.next(k, uu); k += NWAVES) {
                    typedef int i32x4 __attribute__((ext_vector_type(4))); const i32x4 v = *(const i32x4*)(IDX + uu.pm * 256 + 4 * c.lane); *(LAS i32x4*)(tab + k * 256 + 4 * c.lane) = v; }
                __syncthreads(); }
            pg8::EpiSwiglu E{c.ws + WS_HID, DE, 1.0f / W8_SCALE, NOST};
#if MK_PROBE_NOSTORE >= 4
            if (hi - lo == 1) pg8::gemm_phase<pg8::EpiSwiglu, pg8::Order, MK_ALIGN, MK_SP2, true, true, MK_PROBE_NOSTORE>(c.lds, g, S, E, c.tid); else
#endif
            pg8::gemm_phase<pg8::EpiSwiglu, pg8::Order, MK_ALIGN, MK_SP2, true, true>(c.lds, g, S, E, c.tid); if (layer == 0) { conv_job_half(c, 2, 1); conv_job_half(c, 3, 1); conv_job_half(c, 6, 1); } } SEAM(pr + 2);
        PH(pr + 3) { if (layer == 0) conv_job_half(c, 7, 0); __syncthreads(); pg8::Gemm g{(const bf16*)(c.ws + WS_HID), (const bf16*)(c.ws + WS_WDN + (size_t)layer * 64 * MiB), MOE_ROWS, DM, DE};   pg8::Order S; S.init(MOE_ROWS, DM, c.G, c.bid, 1);
            { LAS int* tab = (LAS int*)(c.lds + RING_BYTES); S.tab = tab; pg8::Unit uu;
#pragma unroll 1
                for (int k = 0; k < 15 && S.next(k, uu); ++k) if (c.tid < 256) tab[k * 256 + c.tid] = uu.pm * 256 + c.tid;
                __syncthreads(); }
            pg8::EpiDown E{c.ws + WS_YE, DM, (const float*)(c.ws + WS_GATE), YE_SCALE / W8_SCALE, NOST}; pg8::gemm_phase<pg8::EpiDown, pg8::Order, MK_ALIGN, MK_SP2, true, true>(c.lds, g, S, E, c.tid); if (layer == 0) conv_job_half(c, 7, 1); } SEAM(pr + 3);
        (void)pb;
    }
    PH(17) { p_combine<1>(c, c.norm_final); }
#undef IN
#undef H
#undef P
#undef YC
#undef XRES
#undef PH
#undef INR
#undef SEAM
}

extern "C" void kernel_launch(void* const* d_in, const int* in_sizes, int n_in, void* d_out, int out_size, void* d_ws, size_t ws_size, hipStream_t stream) {
    static int grid = 0;
    if (grid == 0) {
        if (n_in != 17 || out_size != M * DM || ws_size < WS_END) { fprintf(stderr, "kernel_launch: unexpected shapes (n_in %d out %d ws %zu)\n", n_in, out_size, ws_size); grid = -1; return; }
        int dev = 0, cus = 0, per_cu = 0;
        if (hipGetDevice(&dev) != hipSuccess || hipDeviceGetAttribute(&cus, hipDeviceAttributeMultiprocessorCount, dev) != hipSuccess) { grid = -1; return; }
        if (hipFuncSetAttribute((const void*)mk_fwd, hipFuncAttributeMaxDynamicSharedMemorySize, LDS_BYTES) != hipSuccess) { fprintf(stderr, "kernel_launch: hipFuncSetAttribute failed\n"); grid = -1; return; }
        if (hipOccupancyMaxActiveBlocksPerMultiprocessor(&per_cu, (const void*)mk_fwd, NTHR, LDS_BYTES) != hipSuccess || per_cu < 1) { fprintf(stderr, "kernel_launch: occupancy query says %d\n", per_cu); (void)hipGetLastError(); }
        grid = cus;
    }
    if (grid < 0) return;
    (void)hipMemsetAsync((char*)d_ws + WS_CTL, 0, CTL_ZERO_BYTES, stream);
    Args a{};
    for (int i = 0; i < 17; ++i) a.in[i] = (const float*)d_in[i];
    a.out = (float*)d_out; a.ws = (unsigned char*)d_ws;
#if MK_N_LAUNCHES == 1
    a.ph_lo = 0; a.ph_hi = NPH;
    hipLaunchKernelGGL(mk_fwd, dim3(grid), dim3(NTHR), LDS_BYTES, stream, a);
#if MK_PROBE_PHASE >= 0
    a.ph_lo = MK_PROBE_PHASE; a.ph_hi = MK_PROBE_PHASE + 1;
    hipLaunchKernelGGL(mk_fwd, dim3(grid), dim3(NTHR), LDS_BYTES, stream, a);
#endif
#else
    for (int p = 0; p < NPH; ++p) { a.ph_lo = p; a.ph_hi = p + 1; hipLaunchKernelGGL(mk_fwd, dim3(grid), dim3(NTHR), LDS_BYTES, stream, a); }
#endif
}
```

```cpp
#include <hip/hip_runtime.h>
#include <cstdio>
#include <cstdint>
#ifndef MK_N_LAUNCHES
#define MK_N_LAUNCHES 1
#endif
#ifndef MK_REPEAT
#define MK_REPEAT (-1)
#endif
#ifndef MK_DIL_REPS
#define MK_DIL_REPS 1
#endif
#ifndef MK_CONV_PROBE
#define MK_CONV_PROBE 0
#endif
#ifndef MK_SP2
#define MK_SP2 true
#endif
#ifndef MK_ALIGN
#define MK_ALIGN true
#endif
#ifndef MK_EARLY_INV
#define MK_EARLY_INV 1
#endif
#ifndef MK_DOUBLE_BAR
#define MK_DOUBLE_BAR 0
#endif
#ifndef MK_PROBE_PHASE
#define MK_PROBE_PHASE (-1)
#endif
#ifndef MK_PROBE_NOSTORE
#define MK_PROBE_NOSTORE 0
#endif
#ifndef MK_CONV_SKEW
#define MK_CONV_SKEW 0
#endif
namespace pg8 {
#define PG8_LAS __attribute__((address_space(3)))
typedef unsigned short bf16_t;
typedef short bf16x8 __attribute__((ext_vector_type(8)));
typedef float f32x4 __attribute__((ext_vector_type(4)));
typedef int i32x8 __attribute__((ext_vector_type(8)));
typedef short bf16x16 __attribute__((ext_vector_type(16)));
typedef unsigned u32x4 __attribute__((ext_vector_type(4)));
constexpr int BM = 256, BK = 64, HALF = 128, HTB = HALF * BK * 2  , STAGE_BYTES = 8 * HTB, NXCD = 8, WGM = 2;

__host__ __device__ __forceinline__ int lds_byte(int r, int c) { const int st = (r >> 4) * 2 + (c >> 5), rr = r & 15, cc = c & 31, ob = rr * 64 + cc * 2; return st * 1024 + (ob ^ (((ob >> 9) & 1) << 5)); }
__host__ __device__ __forceinline__ void stage_rc(int b, int& R, int& C) { const int st = b / 1024, sb = b % 1024, swz = sb ^ (((sb >> 9) & 1) << 5); R = (st >> 1) * 16 + swz / 64; C = (st & 1) * 32 + (swz % 64) / 2; }
__host__ __device__ __forceinline__ int perm32(int rho) { const int n = rho >> 4, i = rho & 15; return 8 * (i >> 2) + 4 * n + (i & 3); }


struct Unit { int pm, pn, pb; };
struct Gemm { const bf16_t* A; const bf16_t* Bt; int M, N, K; };

struct Order {
    int nM, nN, nwg, G, c, moe; const PG8_LAS int* tab;
    __host__ __device__ __forceinline__ void init(int M, int N, int G_, int c_, int moe_) { nM = M / BM; nN = N / BM; nwg = nM * nN; G = G_; c = c_; moe = moe_; tab = nullptr; }
    __host__ __device__ __forceinline__ bool next(int i, Unit& u) const {
        const long L = (long)i * G + c; if (L >= nwg) return false;
        int wgid = (int)L; { const int q = nwg / NXCD, r = nwg % NXCD, xcd = wgid % NXCD, off = wgid / NXCD; wgid = (xcd < r ? xcd * (q + 1) : r * (q + 1) + (xcd - r) * q) + off; }
        const int nig = WGM * nN, gid = wgid / nig, fm = gid * WGM, gsz = (nM - fm) < WGM ? (nM - fm) : WGM;
        u.pm = fm + ((wgid % nig) % gsz); u.pn = (wgid % nig) / gsz; u.pb = moe ? (u.pm >> 3) * nN + u.pn : u.pn; return true;
    }
    __device__ __forceinline__ void a_ready(const Unit&) const {}
    __device__ __forceinline__ void done(const Unit&) const {}
};

typedef float f32x2_t __attribute__((ext_vector_type(2))); typedef __bf16 bf16x2_t __attribute__((ext_vector_type(2)));
__device__ __forceinline__ unsigned cvt_pk_bf16(float lo, float hi) { f32x2_t v = {lo, hi}; bf16x2_t b = __builtin_convertvector(v, bf16x2_t); return __builtin_bit_cast(unsigned, b); }
__device__ __forceinline__ float gelu_tanh(float x) {
    const float t = x * (1.5957691216057308f + 0.07135481282636639f * x * x);
    return x * __builtin_amdgcn_rcpf(1.0f + __builtin_amdgcn_exp2f(-1.4426950408889634f * t));
}
__device__ __forceinline__ float silu_f(float x) { return x * __builtin_amdgcn_rcpf(1.0f + __builtin_amdgcn_exp2f(-1.4426950408889634f * x)); }

#if MK_PROBE_NOSTORE
#define PG8_ST(x) do { if (nost != 1) { x; } } while (0)
#else
#define PG8_ST(x) do { x; } while (0)
#endif
struct EpiBf16 {
    static constexpr bool PERM = true, AFTER_DRAIN = false;
    bf16_t* O; int ldc; int gelu_tiles; int qkv_tile0; bf16_t* QKV; size_t qkv_stride; float sc; int nost;
    __device__ __forceinline__ void operator()(const f32x4 (&acc)[2][2][4][2], const Unit& u, int wr, int wc, int fr, int fq) const {
        const int row0 = u.pm * BM + wr * 64 + fr, col0 = u.pn * BM + wc * 32 + 8 * fq; const bool act = u.pn < gelu_tiles, hm = u.pn >= qkv_tile0;
        const int t = u.pn - qkv_tile0, which = t >> 2, hp = t & 3;
#pragma unroll
        for (int ai = 0; ai < 2; ++ai)
#pragma unroll
            for (int m = 0; m < 4; ++m) { const int row = row0 + ai * HALF + m * 16;
                bf16_t* rowp = O + (size_t)row * ldc + col0; size_t bjstep = HALF;
                if (hm) { rowp = QKV + (size_t)which * qkv_stride + ((size_t)((row >> 11) * 8 + 2 * hp) * 2048 + (row & 2047)) * 128 + wc * 32 + 8 * fq; bjstep = (size_t)2048 * 128; }
#pragma unroll
                for (int bj = 0; bj < 2; ++bj) { f32x4 v0 = acc[ai][bj][m][0] * sc, v1 = acc[ai][bj][m][1] * sc;
                    if (act) {
#pragma unroll
                        for (int j = 0; j < 4; ++j) { v0[j] = gelu_tanh(v0[j]); v1[j] = gelu_tanh(v1[j]); } }
                    u32x4 w; w.x = cvt_pk_bf16(v0[0], v0[1]); w.y = cvt_pk_bf16(v0[2], v0[3]); w.z = cvt_pk_bf16(v1[0], v1[1]); w.w = cvt_pk_bf16(v1[2], v1[3]);
                    PG8_ST(*(u32x4*)(rowp + bj * bjstep) = w); } }
    }
};
struct EpiResid {
    static constexpr bool PERM = false, AFTER_DRAIN = false;
    const float* base; float* out; int ldc;
    __device__ __forceinline__ void operator()(const f32x4 (&acc)[2][2][4][2], const Unit& u, int wr, int wc, int fr, int fq) const {
        const int row0 = u.pm * BM + wr * 64 + fr, col0 = u.pn * BM + wc * 32 + 4 * fq;
#pragma unroll
        for (int ai = 0; ai < 2; ++ai)
#pragma unroll
            for (int m = 0; m < 4; ++m) { const size_t off = (size_t)(row0 + ai * HALF + m * 16) * ldc + col0;
                f32x4 bs[2][2];
#pragma unroll
                for (int bj = 0; bj < 2; ++bj)
#pragma unroll
                    for (int n = 0; n < 2; ++n) bs[bj][n] = *(const f32x4*)(base + off + bj * HALF + n * 16);
#pragma unroll
                for (int bj = 0; bj < 2; ++bj)
#pragma unroll
                    for (int n = 0; n < 2; ++n) *(f32x4*)(out + off + bj * HALF + n * 16) = bs[bj][n] + acc[ai][bj][m][n];
                asm volatile("" ::: "memory"); }
    }
};
struct EpiResidB {
    static constexpr bool PERM = true, AFTER_DRAIN = false;
    const void* base; bf16_t* out; int ldc; int base_f32; int nost = 0;
    __device__ __forceinline__ void operator()(const f32x4 (&acc)[2][2][4][2], const Unit& u, int wr, int wc, int fr, int fq) const {
        const int row0 = u.pm * BM + wr * 64 + fr, col0 = u.pn * BM + wc * 32 + 8 * fq;
#pragma unroll
        for (int ai = 0; ai < 2; ++ai)
#pragma unroll
            for (int m = 0; m < 4; ++m) { const size_t off = (size_t)(row0 + ai * HALF + m * 16) * ldc + col0;
                f32x4 b0[2], b1[2];
                if (base_f32) {
#pragma unroll
                    for (int bj = 0; bj < 2; ++bj) { b0[bj] = *(const f32x4*)((const float*)base + off + bj * HALF); b1[bj] = *(const f32x4*)((const float*)base + off + bj * HALF + 4); }
                } else {
#pragma unroll
                    for (int bj = 0; bj < 2; ++bj) { const u32x4 w = *(const u32x4*)((const bf16_t*)base + off + bj * HALF);
                        b0[bj] = (f32x4){__uint_as_float(w.x << 16), __uint_as_float(w.x & 0xffff0000u), __uint_as_float(w.y << 16), __uint_as_float(w.y & 0xffff0000u)};
                        b1[bj] = (f32x4){__uint_as_float(w.z << 16), __uint_as_float(w.z & 0xffff0000u), __uint_as_float(w.w << 16), __uint_as_float(w.w & 0xffff0000u)}; }
                }
#pragma unroll
                for (int bj = 0; bj < 2; ++bj) { const f32x4 v0 = b0[bj] + acc[ai][bj][m][0], v1 = b1[bj] + acc[ai][bj][m][1];
                    u32x4 w; w.x = cvt_pk_bf16(v0[0], v0[1]); w.y = cvt_pk_bf16(v0[2], v0[3]); w.z = cvt_pk_bf16(v1[0], v1[1]); w.w = cvt_pk_bf16(v1[2], v1[3]);
                    *(u32x4*)(out + off + bj * HALF) = w; }
                asm volatile("" ::: "memory"); }
    }
};
struct EpiSwiglu {
    static constexpr bool PERM = true, AFTER_DRAIN = false;
    unsigned char* O; int ldc; float sc; int nost;
    __device__ __forceinline__ void operator()(const f32x4 (&acc)[2][2][4][2], const Unit& u, int wr, int wc, int fr, int fq) const {
        const int row0 = u.pm * BM + wr * 64 + fr, col0 = u.pn * HALF + wc * 32 + 8 * fq;
#pragma unroll
        for (int ai = 0; ai < 2; ++ai)
#pragma unroll
            for (int m = 0; m < 4; ++m) { unsigned char* rowp = O + (size_t)(row0 + ai * HALF + m * 16) * ldc + col0;
                f32x4 h0, h1;
#pragma unroll
                for (int j = 0; j < 4; ++j) { h0[j] = __builtin_amdgcn_fmed3f(silu_f(acc[ai][0][m][0][j] * sc) * (acc[ai][1][m][0][j] * sc), -448.f, 448.f); h1[j] = __builtin_amdgcn_fmed3f(silu_f(acc[ai][0][m][1][j] * sc) * (acc[ai][1][m][1][j] * sc), -448.f, 448.f); }
                int p0 = 0, p1 = 0;
                p0 = __builtin_amdgcn_cvt_pk_fp8_f32(h0[0], h0[1], p0, false); p0 = __builtin_amdgcn_cvt_pk_fp8_f32(h0[2], h0[3], p0, true);
                p1 = __builtin_amdgcn_cvt_pk_fp8_f32(h1[0], h1[1], p1, false); p1 = __builtin_amdgcn_cvt_pk_fp8_f32(h1[2], h1[3], p1, true);
                typedef unsigned u32x2v __attribute__((ext_vector_type(2))); u32x2v w; w.x = (unsigned)p0; w.y = (unsigned)p1;
                PG8_ST(*(u32x2v*)rowp = w); }
    }
};
struct EpiDown {
    static constexpr bool PERM = true, AFTER_DRAIN = false;
    unsigned char* O; int ldc; const float* gate; float sc; int nost;
    __device__ __forceinline__ void operator()(const f32x4 (&acc)[2][2][4][2], const Unit& u, int wr, int wc, int fr, int fq) const {
        const int row0 = u.pm * BM + wr * 64 + fr, col0 = u.pn * BM + wc * 32 + 8 * fq;
#pragma unroll
        for (int ai = 0; ai < 2; ++ai)
#pragma unroll
            for (int m = 0; m < 4; ++m) { const int row = row0 + ai * HALF + m * 16; const float gt = gate[row] * sc; unsigned char* rowp = O + (size_t)row * ldc + col0;
#pragma unroll
                for (int bj = 0; bj < 2; ++bj) { f32x4 v0 = acc[ai][bj][m][0] * gt, v1 = acc[ai][bj][m][1] * gt;
#pragma unroll
                    for (int j = 0; j < 4; ++j) { v0[j] = __builtin_amdgcn_fmed3f(v0[j], -448.f, 448.f); v1[j] = __builtin_amdgcn_fmed3f(v1[j], -448.f, 448.f); }
                    int p0 = 0, p1 = 0;
                    p0 = __builtin_amdgcn_cvt_pk_fp8_f32(v0[0], v0[1], p0, false); p0 = __builtin_amdgcn_cvt_pk_fp8_f32(v0[2], v0[3], p0, true);
                    p1 = __builtin_amdgcn_cvt_pk_fp8_f32(v1[0], v1[1], p1, false); p1 = __builtin_amdgcn_cvt_pk_fp8_f32(v1[2], v1[3], p1, true);
                    typedef unsigned u32x2v __attribute__((ext_vector_type(2))); u32x2v w; w.x = (unsigned)p0; w.y = (unsigned)p1;
                    PG8_ST(*(u32x2v*)(rowp + bj * HALF) = w); }
                asm volatile("" ::: "memory"); }
    }
};

template <class Epi, class Sched, bool ALIGN_EPI = false, bool SP2 = false, bool GATHER = false, bool FP8 = false, int PV = 0>
__device__ __forceinline__ void gemm_phase(PG8_LAS unsigned char* lds, const Gemm g, const Sched& S, const Epi& E, int tid_) {
    asm volatile("" : "+v"(tid_));
    const int tid = tid_, wid = __builtin_amdgcn_readfirstlane(tid >> 6), lane = tid & 63, wr = wid >> 2, wc = wid & 3, fr = lane & 15, fq = lane >> 4;
    constexpr int ES = FP8 ? 1 : 2;
#if MK_PROBE_NOSTORE
    const int K = g.K, nt = (K * ES / (BK * 2)) >> (E.nost == 3 ? 1 : 0);
#else
    const int K = g.K, nt = K * ES / (BK * 2);
#endif
    unsigned voffA[2], voffB[2];
#pragma unroll
    for (int i = 0; i < 2; ++i) { int R, C; stage_rc(tid * 16 + i * 8192, R, C); const int Rb = Epi::PERM ? ((R & ~31) + perm32(R & 31)) : R;
        voffA[i] = (unsigned)(R * K * ES + C * 2); voffB[i] = (unsigned)(Rb * K * ES + C * 2); }
    static_assert(!GATHER || SP2, "the gathered A operand is wired into the SP2 loop only");
    unsigned gofA[2][2] = {{0u, 0u}, {0u, 0u}};
#define PG8_GOFF(dst, ord) do { _Pragma("unroll") for (int _h = 0; _h < 2; ++_h) _Pragma("unroll") for (int _i = 0; _i < 2; ++_i) { int _R, _C; stage_rc(tid * 16 + _i * 8192, _R, _C); \
        dst[_h][_i] = (unsigned)(S.tab[(ord) * 256 + _h * 128 + _R] * K * ES + _C * 2); } } while (0)
#define PG8_STAGE_A(bufoff, gbase, h) do { if constexpr (GATHER) PG8_STAGE(bufoff, gbase, gofA[h]); else PG8_STAGE(bufoff, (gbase) + (h) * hstep, voffA); } while (0)
    const size_t kstep = (size_t)(BK * 2);
    const size_t hstep = (size_t)HALF * K * ES;
    const size_t tstep = 2 * hstep;
    const unsigned ldsw = (unsigned)wid * 1024u;
    const int aoff = lds_byte(wr * 64 + fr, fq * 8), boff = lds_byte(wc * 32 + fr, fq * 8);
#define PG8_SA(b, h) (((b) * 2 + (h)) * HTB)
#define PG8_SB(b, h) ((4 + (b) * 2 + (h)) * HTB)
#if MK_PROBE_NOSTORE
#define PG8_PV(v) (PV != (v))
#else
#define PG8_PV(v) true
#endif
#define PG8_STAGE(bufoff, gbase, voff) do { if constexpr (PG8_PV(4)) _Pragma("unroll") for (int _i = 0; _i < 2; ++_i) \
        __builtin_amdgcn_global_load_lds((const unsigned*)((const char*)(gbase) + (voff)[_i]), (PG8_LAS unsigned*)(lds + (bufoff) + ldsw + _i * 8192), 16, 0, 0); } while (0)
#define PG8_LDA(dst, b, h) do { if constexpr (PG8_PV(5)) _Pragma("unroll") for (int m = 0; m < 4; ++m) _Pragma("unroll") for (int k = 0; k < 2; ++k) dst[m][k] = *(const PG8_LAS bf16x8*)(lds + PG8_SA(b, h) + aoff + m * 2048 + k * 1024); } while (0)
#define PG8_LDB(dst, b, h) do { if constexpr (PG8_PV(5)) _Pragma("unroll") for (int n = 0; n < 2; ++n) _Pragma("unroll") for (int k = 0; k < 2; ++k) dst[n][k] = *(const PG8_LAS bf16x8*)(lds + PG8_SB(b, h) + boff + n * 2048 + k * 1024); } while (0)
#define PG8_MMA(ai, bj, At, Bt) do { __builtin_amdgcn_s_setprio(1); if constexpr (PV == 6) { _Pragma("unroll") for (int ks = 0; ks < 2; ++ks) _Pragma("unroll") for (int mp = 0; mp < 2; ++mp) { \
            const i32x8 _a = __builtin_bit_cast(i32x8, __builtin_shufflevector(Bt[ks][0], Bt[ks][1], 0, 1, 2, 3, 4, 5, 6, 7, 8, 9, 10, 11, 12, 13, 14, 15)); \
            const i32x8 _b = __builtin_bit_cast(i32x8, __builtin_shufflevector(At[2 * mp + ks][0], At[2 * mp + ks][1], 0, 1, 2, 3, 4, 5, 6, 7, 8, 9, 10, 11, 12, 13, 14, 15)); \
            acc16[ai][bj][mp] = __builtin_amdgcn_mfma_scale_f32_32x32x64_f8f6f4(_a, _b, acc16[ai][bj][mp], 0, 0, 0, 0x7f7f7f7f, 0, 0x7f7f7f7f); } } \
        else if constexpr (FP8) { _Pragma("unroll") for (int m = 0; m < 4; ++m) _Pragma("unroll") for (int n = 0; n < 2; ++n) { \
            const i32x8 _a = __builtin_bit_cast(i32x8, __builtin_shufflevector(Bt[n][0], Bt[n][1], 0, 1, 2, 3, 4, 5, 6, 7, 8, 9, 10, 11, 12, 13, 14, 15)); \
            const i32x8 _b = __builtin_bit_cast(i32x8, __builtin_shufflevector(At[m][0], At[m][1], 0, 1, 2, 3, 4, 5, 6, 7, 8, 9, 10, 11, 12, 13, 14, 15)); \
            acc[ai][bj][m][n] = __builtin_amdgcn_mfma_scale_f32_16x16x128_f8f6f4(_a, _b, acc[ai][bj][m][n], 0, 0, 0, 0x7f7f7f7f, 0, 0x7f7f7f7f); } } \
        else { _Pragma("unroll") for (int m = 0; m < 4; ++m) _Pragma("unroll") for (int n = 0; n < 2; ++n) _Pragma("unroll") for (int k = 0; k < 2; ++k) \
        acc[ai][bj][m][n] = __builtin_amdgcn_mfma_f32_16x16x32_bf16(Bt[n][k], At[m][k], acc[ai][bj][m][n], 0, 0, 0); } __builtin_amdgcn_s_setprio(0); } while (0)
#define PG8_WAIT_V(n) asm volatile("s_waitcnt vmcnt(" #n ")" ::: "memory")
#define PG8_WAIT_L(n) asm volatile("s_waitcnt lgkmcnt(" #n ")" ::: "memory")
#define PG8_BAR __builtin_amdgcn_s_barrier()
#define PG8_SCHED __builtin_amdgcn_sched_barrier(0)
    Unit cur, nxt; int ui = 0;
    if (!S.next(0, cur)) return;
    f32x4 acc[2][2][4][2];
#pragma unroll
    for (int a = 0; a < 2; ++a)
#pragma unroll
        for (int b = 0; b < 2; ++b)
#pragma unroll
            for (int m = 0; m < 4; ++m)
#pragma unroll
                for (int n = 0; n < 2; ++n) acc[a][b][m][n] = (f32x4){0.f, 0.f, 0.f, 0.f};
    bf16x8 At[4][2], B0[2][2], B1[2][2];
    typedef float f32x16_t __attribute__((ext_vector_type(16)));
    f32x16_t acc16[2][2][2];
    if constexpr (PV == 6) {
#pragma unroll
        for (int a = 0; a < 2; ++a)
#pragma unroll
            for (int b = 0; b < 2; ++b)
#pragma unroll
                for (int m = 0; m < 2; ++m)
#pragma unroll
                    for (int j = 0; j < 16; ++j) acc16[a][b][m][j] = 0.f; }
    const char* cA = (const char*)g.A + (GATHER ? (size_t)0 : (size_t)cur.pm * tstep); const char* cB = (const char*)g.Bt + (size_t)cur.pb * tstep;
    S.a_ready(cur);
    if constexpr (GATHER) PG8_GOFF(gofA, 0);
    if constexpr (SP2) {
        PG8_STAGE(PG8_SB(0, 0), cB, voffB); PG8_STAGE(PG8_SB(0, 1), cB + hstep, voffB); PG8_STAGE_A(PG8_SA(0, 0), cA, 0); PG8_STAGE_A(PG8_SA(0, 1), cA, 1);
        if (wr == 1) PG8_BAR;
        PG8_WAIT_V(2); PG8_BAR;
        PG8_STAGE(PG8_SB(1, 0), cB + kstep, voffB); PG8_STAGE_A(PG8_SA(1, 0), cA + kstep, 0); PG8_STAGE(PG8_SB(1, 1), cB + hstep + kstep, voffB);
        PG8_WAIT_V(6); PG8_BAR;
    } else {
        PG8_STAGE(PG8_SB(0, 0), cB, voffB); PG8_STAGE(PG8_SA(0, 0), cA, voffA); PG8_STAGE(PG8_SB(0, 1), cB + hstep, voffB); PG8_STAGE(PG8_SA(0, 1), cA + hstep, voffA);
        if (wr == 1) PG8_BAR;
        PG8_WAIT_V(4); PG8_BAR;
        PG8_STAGE(PG8_SB(1, 0), cB + kstep, voffB); PG8_STAGE(PG8_SA(1, 0), cA + kstep, voffA); PG8_STAGE(PG8_SB(1, 1), cB + hstep + kstep, voffB);
        PG8_WAIT_V(6); PG8_BAR;
    }
    for (;;) {
        const bool has_next = S.next(ui + 1, nxt);
        const char* nA = (has_next && !GATHER) ? (const char*)g.A + (size_t)nxt.pm * tstep : cA; const char* nB = has_next ? (const char*)g.Bt + (size_t)nxt.pb * tstep : cB;
        for (int t = 0; t < nt; t += 2) {
            const bool last = (t == nt - 2);
            const char* a1 = cA + (size_t)(t + 1) * kstep;
            const char* a2 = last ? nA : cA + (size_t)(t + 2) * kstep; const char* b2 = last ? nB : cB + (size_t)(t + 2) * kstep;
            const char* a3 = a2 + kstep; const char* b3 = b2 + kstep;
            if (last && has_next) S.a_ready(nxt);
            if constexpr (SP2) {
            PG8_LDB(B0, 0, 0); PG8_LDB(B1, 0, 1); PG8_SCHED; PG8_LDA(At, 0, 0); PG8_STAGE_A(PG8_SA(1, 1), a1, 1);
            if constexpr (GATHER) { if (last && has_next) PG8_GOFF(gofA, ui + 1); }
            PG8_WAIT_V(8); PG8_WAIT_L(0); PG8_BAR; PG8_MMA(0, 0, At, B0); PG8_MMA(0, 1, At, B1); PG8_BAR; PG8_SCHED;
            PG8_LDA(At, 0, 1); PG8_STAGE(PG8_SB(0, 0), b2, voffB); PG8_STAGE(PG8_SB(0, 1), b2 + hstep, voffB); PG8_STAGE_A(PG8_SA(0, 0), a2, 0);
            PG8_WAIT_V(8); PG8_WAIT_L(0); PG8_BAR; PG8_MMA(1, 0, At, B0); PG8_MMA(1, 1, At, B1); PG8_BAR; PG8_SCHED;
            PG8_LDB(B0, 1, 0); PG8_LDB(B1, 1, 1); PG8_SCHED; PG8_LDA(At, 1, 0); PG8_STAGE_A(PG8_SA(0, 1), a2, 1);
            PG8_WAIT_V(8); PG8_WAIT_L(0); PG8_BAR; PG8_MMA(0, 0, At, B0); PG8_MMA(0, 1, At, B1); PG8_BAR; PG8_SCHED;
            PG8_LDA(At, 1, 1); PG8_STAGE(PG8_SB(1, 0), b3, voffB); PG8_STAGE(PG8_SB(1, 1), b3 + hstep, voffB); PG8_STAGE_A(PG8_SA(1, 0), a3, 0);
            PG8_WAIT_V(8); PG8_WAIT_L(0); PG8_BAR; PG8_MMA(1, 0, At, B0); PG8_MMA(1, 1, At, B1); PG8_BAR; PG8_SCHED;
            } else {
            PG8_LDB(B0, 0, 0); PG8_SCHED; PG8_LDA(At, 0, 0); PG8_STAGE(PG8_SA(1, 1), a1 + hstep, voffA);
            PG8_WAIT_L(8); PG8_BAR; PG8_WAIT_L(0); PG8_MMA(0, 0, At, B0); PG8_BAR; PG8_SCHED;
            PG8_LDB(B1, 0, 1); PG8_STAGE(PG8_SB(0, 0), b2, voffB);
            PG8_BAR; PG8_WAIT_L(0); PG8_MMA(0, 1, At, B1); PG8_BAR;
            PG8_LDA(At, 0, 1); PG8_STAGE(PG8_SA(0, 0), a2, voffA);
            PG8_BAR; PG8_WAIT_L(0); PG8_MMA(1, 0, At, B0); PG8_BAR; PG8_SCHED;
            PG8_STAGE(PG8_SB(0, 1), b2 + hstep, voffB);
            PG8_WAIT_V(6); PG8_BAR; PG8_MMA(1, 1, At, B1); PG8_BAR;
            PG8_LDB(B0, 1, 0); PG8_SCHED; PG8_LDA(At, 1, 0); PG8_STAGE(PG8_SA(0, 1), a2 + hstep, voffA);
            PG8_WAIT_L(8); PG8_BAR; PG8_WAIT_L(0); PG8_MMA(0, 0, At, B0); PG8_BAR; PG8_SCHED;
            PG8_LDB(B1, 1, 1); PG8_STAGE(PG8_SB(1, 0), b3, voffB);
            PG8_BAR; PG8_WAIT_L(0); PG8_MMA(0, 1, At, B1); PG8_BAR;
            PG8_LDA(At, 1, 1); PG8_STAGE(PG8_SA(1, 0), a3, voffA);
            PG8_BAR; PG8_WAIT_L(0); PG8_MMA(1, 0, At, B0); PG8_BAR; PG8_SCHED;
            PG8_STAGE(PG8_SB(1, 1), b3 + hstep, voffB);
            PG8_WAIT_V(6); PG8_BAR; PG8_MMA(1, 1, At, B1); PG8_BAR;
            }
        }
        if constexpr (ALIGN_EPI) { if (wr == 0) PG8_BAR; }
        if constexpr (PV == 6) {
#pragma unroll
            for (int a = 0; a < 2; ++a)
#pragma unroll
                for (int b = 0; b < 2; ++b)
#pragma unroll
                    for (int m = 0; m < 2; ++m) asm volatile("" :: "v"(acc16[a][b][m])); }
        else
#if MK_PROBE_NOSTORE
        if (E.nost != 2)
#endif
        if constexpr (!Epi::AFTER_DRAIN) { E(acc, cur, wr, wc, fr, fq); S.done(cur); }
        if (!has_next) break;
#pragma unroll
        for (int a = 0; a < 2; ++a)
#pragma unroll
            for (int b = 0; b < 2; ++b)
#pragma unroll
                for (int m = 0; m < 4; ++m)
#pragma unroll
                    for (int n = 0; n < 2; ++n) acc[a][b][m][n] = (f32x4){0.f, 0.f, 0.f, 0.f};
        cur = nxt; cA = nA; cB = nB; ++ui;
        if constexpr (ALIGN_EPI) { if (wr == 1) PG8_BAR; }
    }
    PG8_WAIT_V(0);
    if constexpr (!ALIGN_EPI) { if (wr == 0) PG8_BAR; }
    PG8_BAR;
    if constexpr (Epi::AFTER_DRAIN) { E.fused(acc, cur, wr, wc, fr, fq, lds, wid, lane); S.done(cur); }
#undef PG8_SA
#undef PG8_GOFF
#undef PG8_STAGE_A
#undef PG8_SB
#undef PG8_STAGE
#undef PG8_LDA
#undef PG8_LDB
#undef PG8_MMA
#undef PG8_WAIT_V
#undef PG8_WAIT_L
#undef PG8_BAR
#undef PG8_SCHED
}
}

#ifndef PG8_SP2
#define PG8_SP2 true
#endif
#ifndef PG8_ALIGN
#define PG8_ALIGN true
#endif

constexpr int BATCH = 8, SEQ = 2048, DM = 2048, M = BATCH * SEQ;
constexpr int NE = 16, CAP = 256, DE = 2048, MOE_ROWS = BATCH * NE * CAP;
constexpr int IN_AB = 5120, IN_CD = 6144;
constexpr float RMS_EPS = 1e-6f, LN_EPS = 1e-5f;
constexpr float LOG2E = 1.4426950408889634f, LN2 = 0.6931471805599453f;
constexpr float ATT_SCALE = 0.08838834764831845f;
constexpr int NWAVES = 8, NTHR = 512;

constexpr size_t MiB = 1ull << 20;
constexpr size_t WS_CTL = 0, CTL_ZERO_BYTES = 1 * MiB;
constexpr size_t WS_AFF = 1 * MiB;
constexpr size_t WS_SEL = 2 * MiB;
constexpr size_t WS_GATE = 3 * MiB;
constexpr size_t WS_IDX = 3 * MiB + 512 * 1024;
constexpr size_t WS_LSE = 4 * MiB;
constexpr size_t WS_WIN0 = 8 * MiB, WS_WOUT0 = 28 * MiB, WS_WIN1 = 36 * MiB, WS_WOUT1 = 60 * MiB;
constexpr size_t WS_WGU = 68 * MiB;
constexpr size_t WS_WDN = 580 * MiB;
constexpr size_t WS_XRES = 836 * MiB;
constexpr size_t WS_H = 964 * MiB;
constexpr size_t WS_P = 1028 * MiB;
constexpr size_t WS_YCAT = 1220 * MiB;
constexpr size_t WS_OP = 1764 * MiB;
constexpr size_t OP_STRIDE = (size_t)16384 * 1024 + 4096 + 512;
constexpr size_t QKV_STRIDE = (size_t)64 * 2048 * 128 + 4096 + 512;
constexpr size_t WS_XE = 1380 * MiB;
constexpr size_t WS_QKV = WS_XE;
constexpr size_t WS_HID = 1508 * MiB;
constexpr size_t WS_YE = 1636 * MiB;
constexpr size_t WS_WIN8 = 1896 * MiB;
constexpr size_t WS_H8 = 1864 * MiB;
constexpr size_t WS_END = 1908 * MiB;
constexpr float YE_SCALE = 64.0f;
constexpr float W8_SCALE = 64.0f;

constexpr int RING_BYTES = 131072;
constexpr int LDSCTL_OFF = 147328, MISC_OFF = LDSCTL_OFF;
constexpr int LDS_BYTES = 147456;

#define GAS __attribute__((address_space(1)))
#define LAS __attribute__((address_space(3)))
typedef unsigned short bf16;
typedef unsigned u32x4 __attribute__((ext_vector_type(4)));
typedef unsigned u32x2 __attribute__((ext_vector_type(2)));
typedef float f32x4 __attribute__((ext_vector_type(4)));
typedef short bf16x8 __attribute__((ext_vector_type(8)));
typedef short s16x4 __attribute__((ext_vector_type(4)));
typedef GAS unsigned gu32;
#define RLX_AGENT __ATOMIC_RELAXED, __HIP_MEMORY_SCOPE_AGENT
#define LDS_WAIT() asm volatile("s_waitcnt lgkmcnt(0)" ::: "memory")
#define VM_WAIT() asm volatile("s_waitcnt vmcnt(0)" ::: "memory")
using pg8::cvt_pk_bf16;
__device__ __forceinline__ float bf_lo(unsigned w) { return __uint_as_float(w << 16); }
__device__ __forceinline__ float bf_hi(unsigned w) { return __uint_as_float(w & 0xffff0000u); }
__device__ __forceinline__ int lane_now() { int l; asm volatile("v_mbcnt_lo_u32_b32 %0, -1, 0\n\tv_mbcnt_hi_u32_b32 %0, -1, %0" : "=v"(l)); return l; }
__device__ __forceinline__ int shx(int v, int o, int lane) { return __builtin_amdgcn_ds_bpermute((lane ^ o) << 2, v); }
__device__ __forceinline__ unsigned shx(unsigned v, int o, int lane) { return (unsigned)__builtin_amdgcn_ds_bpermute((lane ^ o) << 2, (int)v); }
__device__ __forceinline__ float shx(float v, int o, int lane) { return __int_as_float(__builtin_amdgcn_ds_bpermute((lane ^ o) << 2, __float_as_int(v))); }
__device__ __forceinline__ unsigned shup(unsigned v, int o, int lane) { return (unsigned)__builtin_amdgcn_ds_bpermute((lane - o) << 2, (int)v); }
__device__ __forceinline__ float wave_sum(float v, int lane) {
#pragma unroll
    for (int o = 1; o < 64; o <<= 1) v += shx(v, o, lane);
    return v;
}
__device__ __forceinline__ s16x4 vtr(const LAS unsigned char* p) { return __builtin_bit_cast(s16x4, __builtin_amdgcn_ds_read_tr16_b64_v4i16((LAS s16x4*)p)); }

#define XB_TMO      128
#define XB_XCNT(j)  (256  + 64 * (j))
#define XB_XSUB(j)  (1280 + 64 * (j))
#define XB_XGEN(j)  (2304 + 64 * (j))
#define XB_TOP      3328
#define XB_TOPGEN   3392
#define XCD_BAR_WORDS 3456
#define XB_SPIN_CAP (1u << 18)

__device__ __forceinline__ unsigned xb_ld(unsigned* p)              { return __hip_atomic_load(p, __ATOMIC_RELAXED, __HIP_MEMORY_SCOPE_AGENT); }
__device__ __forceinline__ unsigned xb_add(unsigned* p, unsigned v) { return __hip_atomic_fetch_add(p, v, __ATOMIC_RELAXED, __HIP_MEMORY_SCOPE_AGENT); }
__device__ __forceinline__ unsigned xb_xcc_id() { return (unsigned)__builtin_amdgcn_s_getreg((3 << 11) | 20) & 0xFu; }
#define XB_SPIN(cond, bar) do { unsigned _sp = 0; while (cond) { __builtin_amdgcn_s_sleep(1); \
    if ((++_sp & 255u) == 0u) { if (xb_ld(&(bar)[XB_TMO])) break; if (_sp > XB_SPIN_CAP) { atomicAdd(&(bar)[XB_TMO], 1u); break; } } } } while (0)

struct XcdBarrier {
    unsigned* bar; unsigned x; int wave;
    volatile LAS unsigned* st;
};

__device__ __forceinline__ XcdBarrier xcd_barrier_post(unsigned* bar, volatile LAS unsigned* st, int wave) {
    XcdBarrier b; b.bar = bar; b.x = xb_xcc_id(); b.st = st; b.wave = wave;
    if (b.wave == 0 && lane_now() == 0) (void)xb_add(&bar[XB_XCNT(b.x)], 1u);
    return b;
}
__device__ __forceinline__ void xcd_barrier_complete(unsigned* bar, unsigned x, unsigned& nloc, unsigned& nx) {
    const unsigned G = gridDim.x * gridDim.y * gridDim.z;
    unsigned sum, cnt, mine, sp = 0u;
    for (;;) {
        sum = 0u; cnt = 0u; mine = 0u;
#pragma unroll
        for (unsigned j = 0; j < 16; ++j) { const unsigned c = xb_ld(&bar[XB_XCNT(j)]); sum += c; cnt += (c > 0u) ? 1u : 0u; mine = (j == x) ? c : mine; }
        if (sum == G) break;
        __builtin_amdgcn_s_sleep(1);
        if ((++sp & 255u) == 0u) { if (xb_ld(&bar[XB_TMO])) break; if (sp > XB_SPIN_CAP) { atomicAdd(&bar[XB_TMO], 1u); break; } }
    }
    nloc = mine > 0u ? mine : 1u; nx = cnt > 0u ? cnt : 1u;
}

__device__ __forceinline__ void xcd_barrier(const XcdBarrier& b) {
    asm volatile("s_waitcnt vmcnt(0)" ::: "memory");
    __syncthreads();
    if (b.wave == 0 && lane_now() == 0) {
        unsigned* bar = b.bar;
        __builtin_amdgcn_s_waitcnt(0);
#if MK_EARLY_INV
        asm volatile("buffer_inv sc1" ::: "memory");
#endif
        unsigned nloc = b.st[0], nx = b.st[1];
        if (nloc == 0u) { xcd_barrier_complete(bar, b.x, nloc, nx); b.st[0] = nloc; b.st[1] = nx; }
        const unsigned old = xb_add(&bar[XB_XSUB(b.x)], 1u);
        const unsigned gen = old / nloc;
        if (old + 1u == (gen + 1u) * nloc) {
            __builtin_amdgcn_fence(__ATOMIC_RELEASE, "agent");
            asm volatile("s_waitcnt vmcnt(0)" ::: "memory");
            const unsigned og = xb_add(&bar[XB_TOP], 1u);
            const unsigned tg = og / nx;
            if (og + 1u == (tg + 1u) * nx) xb_add(&bar[XB_TOPGEN], 1u);
            else XB_SPIN(xb_ld(&bar[XB_TOPGEN]) == tg, bar);
            __builtin_amdgcn_fence(__ATOMIC_ACQUIRE, "agent");
            xb_add(&bar[XB_XGEN(b.x)], 1u);
            asm volatile("s_waitcnt vmcnt(0)" ::: "memory");
        } else {
            XB_SPIN(xb_ld(&bar[XB_XGEN(b.x)]) == gen, bar);
#if !MK_EARLY_INV
            __builtin_amdgcn_fence(__ATOMIC_ACQUIRE, "agent");
#endif
            asm volatile("s_waitcnt vmcnt(0)" ::: "memory");
        }
    }
    __syncthreads();
}

struct Ctx {
    const float *x, *norm_mix, *norm_ffn, *norm_final, *w_in_ab, *a_v_norm, *a_sw, *a_sb, *b_rpb, *w_out_ab, *w_in_cd, *c_conv, *w_out_cd, *router, *w_gate, *w_up, *w_down;
    float* out; unsigned char* ws;
    LAS unsigned char* lds;
    int tid, lane, wave, wave0, G, bid;
};

__device__ __forceinline__ void tr_load(const float* src, int N, f32x4 (&v)[16], int lane) {
    const int cc = lane & 15, rg = lane >> 4;
#pragma unroll
    for (int i = 0; i < 16; ++i) { const int k = (i & 1) + 2 * rg + 8 * (i >> 1); v[i] = *(const f32x4*)(src + (size_t)k * N + 4 * cc); }
}
__device__ __forceinline__ void tr_store(const f32x4 (&v)[16], bf16* dst, LAS unsigned* scr, int lane) {
    const int cc = lane & 15, rg = lane >> 4;
#pragma unroll
    for (int j = 0; j < 8; ++j)
#pragma unroll
        for (int q = 0; q < 4; ++q) scr[(4 * cc + q) * 33 + rg + 4 * j] = cvt_pk_bf16(v[2 * j][q], v[2 * j + 1][q]);
    LDS_WAIT(); asm volatile("" ::: "memory");
    const int ch = lane & 7;
#pragma unroll
    for (int jj = 0; jj < 8; ++jj) { const int n = (lane >> 3) + 8 * jj; const LAS unsigned* s = scr + n * 33 + 4 * ch;
        u32x4 o; o.x = s[0]; o.y = s[1]; o.z = s[2]; o.w = s[3];
        *(u32x4*)(dst + (size_t)n * DM + 8 * ch) = o; }
    LDS_WAIT(); asm volatile("" ::: "memory");
}
__device__ __forceinline__ void rms_row_load(const float* xrow, f32x4 (&v)[8], int lane) {
#pragma unroll
    for (int j = 0; j < 4; ++j) { v[2 * j] = *(const f32x4*)(xrow + 512 * j + 8 * lane); v[2 * j + 1] = *(const f32x4*)(xrow + 512 * j + 8 * lane + 4); }
}
__device__ __forceinline__ void rms_row_to_bf16(const f32x4 (&v)[8], const float* gw, bf16* orow, unsigned char* orow8, int lane) {
    float ss = 0.f;
#pragma unroll
    for (int j = 0; j < 8; ++j) ss += (v[j].x * v[j].x + v[j].y * v[j].y) + (v[j].z * v[j].z + v[j].w * v[j].w);
    const float rstd = 1.0f / sqrtf(wave_sum(ss, lane) * (1.0f / DM) + RMS_EPS);
#pragma unroll
    for (int j = 0; j < 4; ++j) { const f32x4 g0 = *(const f32x4*)(gw + 512 * j + 8 * lane), g1 = *(const f32x4*)(gw + 512 * j + 8 * lane + 4);
        const f32x4 a = v[2 * j] * rstd * g0, b2 = v[2 * j + 1] * rstd * g1;
        u32x4 o; o.x = cvt_pk_bf16(a.x, a.y); o.y = cvt_pk_bf16(a.z, a.w); o.z = cvt_pk_bf16(b2.x, b2.y); o.w = cvt_pk_bf16(b2.z, b2.w);
        *(u32x4*)(orow + 512 * j + 8 * lane) = o;
        { int p0 = 0, p1 = 0;
          p0 = __builtin_amdgcn_cvt_pk_fp8_f32(__builtin_amdgcn_fmed3f(a.x, -448.f, 448.f), __builtin_amdgcn_fmed3f(a.y, -448.f, 448.f), p0, false); p0 = __builtin_amdgcn_cvt_pk_fp8_f32(__builtin_amdgcn_fmed3f(a.z, -448.f, 448.f), __builtin_amdgcn_fmed3f(a.w, -448.f, 448.f), p0, true);
          p1 = __builtin_amdgcn_cvt_pk_fp8_f32(__builtin_amdgcn_fmed3f(b2.x, -448.f, 448.f), __builtin_amdgcn_fmed3f(b2.y, -448.f, 448.f), p1, false); p1 = __builtin_amdgcn_cvt_pk_fp8_f32(__builtin_amdgcn_fmed3f(b2.z, -448.f, 448.f), __builtin_amdgcn_fmed3f(b2.w, -448.f, 448.f), p1, true);
          u32x2 w8; w8.x = (unsigned)p0; w8.y = (unsigned)p1; *(u32x2*)(orow8 + 512 * j + 8 * lane) = w8; } }
}
__device__ __forceinline__ int conv_job_items(int job) { return job == 0 ? 32 * 80 : job == 2 ? 32 * 96 : job < 4 ? 32 * 32 : ((job - 4) & 1) ? 16 * 1024 : 32 * 1024; }
struct ConvItem { const float* src; int N; bf16* dst; int fp8; };
__device__ __forceinline__ ConvItem conv_decode(const Ctx& c, int job, int r) {
    ConvItem t;
    if (job < 4) {
        const float* W = job == 0 ? c.w_in_ab : job == 1 ? c.w_out_ab : job == 2 ? c.w_in_cd : c.w_out_cd;
        const int N = job == 0 ? IN_AB : job == 2 ? IN_CD : DM;
        bf16* WT = (bf16*)(c.ws + (job == 0 ? WS_WIN0 : job == 1 ? WS_WOUT0 : job == 2 ? WS_WIN1 : WS_WOUT1));
        const int nsb = N / 128, sub = r & 7, sup = r >> 3, kb = 4 * (sup / nsb) + (sub & 3), nb = 2 * (sup % nsb) + (sub >> 2);
        t.src = W + (size_t)(64 * kb) * N + 64 * nb; t.N = N; t.dst = WT + (size_t)(64 * nb) * DM + 64 * kb; t.fp8 = 0;
        const int q0 = job == 0 ? 32 : job == 2 ? 48 : 1 << 30;
        if (nb >= q0) { t.fp8 = 1; t.dst = (bf16*)(c.ws + WS_WIN8 + (job == 2 ? 6 * MiB : 0) + (size_t)(64 * (nb - q0)) * DM + 64 * kb); }
    } else {
        const int l = (job - 4) >> 1, isdn = (job - 4) & 1, mat = r >> 10, w = r & 1023, sub = w & 7, sup = w >> 3, kb = 4 * (sup >> 4) + (sub & 3), n0 = 64 * (2 * (sup & 15) + (sub >> 2));
        const int e = isdn ? mat : mat >> 1, which = isdn ? 2 : (mat & 1);
        t.src = (which == 0 ? c.w_gate : which == 1 ? c.w_up : c.w_down) + ((size_t)(l * NE + e) * 2048 + 64 * kb) * 2048 + n0; t.N = 2048;
        t.fp8 = 1;
        if (which < 2) t.dst = (bf16*)(c.ws + WS_WGU + (size_t)l * 128 * MiB + (size_t)(e * 4096 + (n0 >> 7) * 256 + which * 128 + (n0 & 127)) * 2048 + 64 * kb);
        else t.dst = (bf16*)(c.ws + WS_WDN + (size_t)l * 64 * MiB + (size_t)(e * 2048 + n0) * 2048 + 64 * kb);
    }
    return t;
}
__device__ __forceinline__ void conv_job(const Ctx& c, int job, int lo, int hi, int icu, int ncu) {
    LAS unsigned* scr = (LAS unsigned*)(c.lds + c.wave * 8704);
    const int step = ncu * NWAVES; int it = lo + icu * NWAVES + c.wave;
    if (it >= hi) return;
    f32x4 va[16], vb[16];
    ConvItem ta = conv_decode(c, job, it), tb = ta;
    tr_load(ta.src, ta.N, va, c.lane);
    for (;;) {
        if (it + step < hi) { tb = conv_decode(c, job, it + step); tr_load(tb.src, tb.N, vb, c.lane); }
        tr_store(va, ta.dst, scr, c.lane);
        it += step; if (it >= hi) break;
        if (it + step < hi) { ta = conv_decode(c, job, it + step); tr_load(ta.src, ta.N, va, c.lane); }
        tr_store(vb, tb.dst, scr, c.lane);
        it += step; if (it >= hi) break;
    }
}
constexpr int DMA_PIECE = 1040, DMA_BUF = 8 * DMA_PIECE;
__device__ __forceinline__ void dma_issue(const float* src, int N, LAS unsigned char* buf, int lane) {
    const float* p = src + (size_t)(lane >> 3) * N + 4 * (lane & 7);
#pragma unroll
    for (int j = 0; j < 8; ++j) __builtin_amdgcn_global_load_lds((const unsigned*)(p + (size_t)(8 * j) * N), (LAS unsigned*)(buf + j * DMA_PIECE), 16, 0, 2);
}
__device__ __forceinline__ void dma_drain_store(const LAS unsigned char* buf, bf16* dst, int lane) {
    const int ch = lane & 7, nr = lane >> 3;
#pragma unroll
    for (int pass = 0; pass < 4; ++pass) { const int n = nr + 8 * pass; const LAS float* s = (const LAS float*)(buf + ch * DMA_PIECE) + n;
        float f[8];
#pragma unroll
        for (int q = 0; q < 8; ++q) f[q] = s[q * 32];
        u32x4 o; o.x = cvt_pk_bf16(f[0], f[1]); o.y = cvt_pk_bf16(f[2], f[3]); o.z = cvt_pk_bf16(f[4], f[5]); o.w = cvt_pk_bf16(f[6], f[7]);
        __builtin_nontemporal_store(o, (u32x4*)(dst + (size_t)n * DM + 8 * ch)); }
}
__device__ __forceinline__ void dma_drain_store_fp8(const LAS unsigned char* buf, unsigned char* dst8, int lane) {
    const int ch = lane & 3, nr = lane >> 2;
#pragma unroll
    for (int pass = 0; pass < 2; ++pass) { const int n = nr + 16 * pass; const LAS float* s = (const LAS float*)(buf + 2 * ch * DMA_PIECE) + n;
        float f[16];
#pragma unroll
        for (int q = 0; q < 16; ++q) f[q] = s[(q >> 3) * (DMA_PIECE / 4) + (q & 7) * 32] * W8_SCALE;
        u32x4 o;
#pragma unroll
        for (int w = 0; w < 4; ++w) { int p = 0; p = __builtin_amdgcn_cvt_pk_fp8_f32(f[4 * w], f[4 * w + 1], p, false); p = __builtin_amdgcn_cvt_pk_fp8_f32(f[4 * w + 2], f[4 * w + 3], p, true); o[w] = (unsigned)p; }
        __builtin_nontemporal_store(o, (u32x4*)(dst8 + (size_t)n * DM + 16 * ch)); }
}
__device__ __forceinline__ void conv_job_dma(const Ctx& c, int job, int lo, int hi, int icu, int ncu) {
    LAS unsigned char* b0 = c.lds + c.wave * (2 * DMA_BUF); LAS unsigned char* b1 = b0 + DMA_BUF;
    const int step = ncu * NWAVES; int it = lo + icu * NWAVES + c.wave;
    if (it >= hi) return;
    ConvItem t = conv_decode(c, job, it);
    dma_issue(t.src, t.N, b0, c.lane);
    for (;;) {
        dma_issue(t.src + 32, t.N, b1, c.lane);
        asm volatile("s_waitcnt vmcnt(8)" ::: "memory");
        if (t.fp8) dma_drain_store_fp8(b0, (unsigned char*)t.dst, c.lane); else dma_drain_store(b0, t.dst, c.lane);
        asm volatile("s_waitcnt lgkmcnt(0)" ::: "memory");
        const int nit = it + step; ConvItem tn = t;
        if (nit < hi) { tn = conv_decode(c, job, nit); dma_issue(tn.src, tn.N, b0, c.lane); asm volatile("s_waitcnt vmcnt(8)" ::: "memory"); }
        else asm volatile("s_waitcnt vmcnt(0)" ::: "memory");
        if (t.fp8) dma_drain_store_fp8(b1, (unsigned char*)t.dst + (size_t)32 * DM, c.lane); else dma_drain_store(b1, t.dst + (size_t)32 * DM, c.lane);
        asm volatile("s_waitcnt lgkmcnt(0)" ::: "memory");
        if (nit >= hi) break;
        it = nit; t = tn;
    }
}
constexpr int WT_PITCH = 1040, WT_BYTES = 64 * WT_PITCH;
__device__ __forceinline__ int conv_job_tiles(int job) { return job == 0 ? 32 * 20 : job == 2 ? 32 * 24 : job < 4 ? 32 * 8 : ((job - 4) & 1) ? 16 * 256 : 32 * 256; }
struct ConvTile { const float* src; int N; int rowbase  ; int k0; int kind  ; unsigned char* dstb; };
__device__ __forceinline__ ConvTile conv_tile_decode(const Ctx& c, int job, int tt) {
    ConvTile t;
    if (job < 4) {
        const float* W = job == 0 ? c.w_in_ab : job == 1 ? c.w_out_ab : job == 2 ? c.w_in_cd : c.w_out_cd;
        const int N = job == 0 ? IN_AB : job == 2 ? IN_CD : DM, nT = N / 256, kb = tt / nT, nt = tt % nT;
        t.src = W + (size_t)(64 * kb) * N + 256 * nt; t.N = N; t.rowbase = 256 * nt; t.k0 = 64 * kb; t.kind = 0;
        t.dstb = c.ws + (job == 0 ? WS_WIN0 : job == 1 ? WS_WOUT0 : job == 2 ? WS_WIN1 : WS_WOUT1);
        const int q0 = job == 0 ? 8 : job == 2 ? 12 : 1 << 30;
        if (nt >= q0) { t.kind = 2; t.rowbase = 256 * (nt - q0); t.dstb = c.ws + WS_WIN8 + (job == 2 ? 6 * MiB : 0); }
    } else {
        const int l = (job - 4) >> 1, isdn = (job - 4) & 1, mat = tt >> 8, w = tt & 255, kb = w >> 3, nt = w & 7;
        const int e = isdn ? mat : mat >> 1, which = isdn ? 2 : (mat & 1);
        t.src = (which == 0 ? c.w_gate : which == 1 ? c.w_up : c.w_down) + ((size_t)(l * NE + e) * 2048 + 64 * kb) * 2048 + 256 * nt; t.N = 2048; t.k0 = 64 * kb;
        if (which < 2) { t.kind = 1; t.rowbase = e * 4096 + (2 * nt) * 256 + which * 128; t.dstb = c.ws + WS_WGU + (size_t)l * 128 * MiB; }
        else { t.kind = 2; t.rowbase = e * 2048 + 256 * nt; t.dstb = c.ws + WS_WDN + (size_t)l * 64 * MiB; }
    }
    return t;
}
__device__ __forceinline__ void wt_issue(const Ctx& c, const ConvTile& t, LAS unsigned char* buf) {
    const float* p = t.src + (size_t)(8 * c.wave) * t.N + 4 * c.lane;
#pragma unroll
    for (int j = 0; j < 8; ++j) __builtin_amdgcn_global_load_lds((const unsigned*)(p + (size_t)j * t.N), (LAS unsigned*)(buf + (8 * c.wave + j) * WT_PITCH), 16, 0, 2);
}
__device__ __forceinline__ void wt_drain(const Ctx& c, const ConvTile& t, const LAS unsigned char* buf) {
    if (t.kind == 0) {
#pragma unroll
        for (int j = 0; j < 4; ++j) { const int id = c.tid + 512 * j, n = id >> 3, ch = id & 7; const LAS float* s = (const LAS float*)(buf + (8 * ch) * WT_PITCH) + n;
            float f[8];
#pragma unroll
            for (int q = 0; q < 8; ++q) f[q] = s[q * (WT_PITCH / 4)];
            u32x4 o; o.x = cvt_pk_bf16(f[0], f[1]); o.y = cvt_pk_bf16(f[2], f[3]); o.z = cvt_pk_bf16(f[4], f[5]); o.w = cvt_pk_bf16(f[6], f[7]);
            __builtin_nontemporal_store(o, (u32x4*)((bf16*)t.dstb + (size_t)(t.rowbase + n) * DM + t.k0 + 8 * ch)); }
    } else {
#pragma unroll
        for (int j = 0; j < 2; ++j) { const int id = c.tid + 512 * j, n = id >> 2, ch = id & 3; const LAS float* s = (const LAS float*)(buf + (16 * ch) * WT_PITCH) + n;
            float f[16];
#pragma unroll
            for (int q = 0; q < 16; ++q) f[q] = s[q * (WT_PITCH / 4)] * W8_SCALE;
            u32x4 o;
#pragma unroll
            for (int w = 0; w < 4; ++w) { int p = 0; p = __builtin_amdgcn_cvt_pk_fp8_f32(f[4 * w], f[4 * w + 1], p, false); p = __builtin_amdgcn_cvt_pk_fp8_f32(f[4 * w + 2], f[4 * w + 3], p, true); o[w] = (unsigned)p; }
            const int row = t.kind == 1 ? t.rowbase + (n >> 7) * 256 + (n & 127) : t.rowbase + n;
            __builtin_nontemporal_store(o, (u32x4*)(t.dstb + (size_t)row * DM + t.k0 + 16 * ch)); }
    }
}
__device__ __forceinline__ void conv_job_wg(const Ctx& c, int job, int lo, int hi, int icu, int ncu) {
    int tt = lo + icu; if (tt >= hi) return;
    LAS unsigned char* b0 = c.lds; LAS unsigned char* b1 = c.lds + WT_BYTES;
    ConvTile t = conv_tile_decode(c, job, tt);
    wt_issue(c, t, b0);
    for (int b = 0;; b ^= 1) {
        const int nx = tt + ncu; ConvTile tn = t;
        asm volatile("" ::: "memory"); __builtin_amdgcn_s_barrier(); asm volatile("" ::: "memory");
        if (nx < hi) { tn = conv_tile_decode(c, job, nx); wt_issue(c, tn, b ? b0 : b1); asm volatile("s_waitcnt vmcnt(8)" ::: "memory"); }
        else asm volatile("s_waitcnt vmcnt(0)" ::: "memory");
        __builtin_amdgcn_s_barrier(); asm volatile("" ::: "memory");
        wt_drain(c, t, b ? b1 : b0);
        asm volatile("s_waitcnt lgkmcnt(0)" ::: "memory");
        if (nx >= hi) break;
        tt = nx; t = tn;
    }
}
__device__ __forceinline__ void conv_job_loads(const Ctx& c, int job, int lo, int hi, int icu, int ncu) {
    const int step = ncu * NWAVES;
    for (int it = lo + icu * NWAVES + c.wave; it < hi; it += step) { f32x4 v[16]; const ConvItem t = conv_decode(c, job, it); tr_load(t.src, t.N, v, c.lane);
#pragma unroll
        for (int k = 0; k < 16; ++k) asm volatile("" :: "v"(v[k])); }
}
__device__ __forceinline__ void conv_job_half(const Ctx& c, int job, int when  ) {
#if MK_CONV_SKEW
    const int n = conv_job_items(job), pass = c.G * NWAVES, per = (n + pass - 1) / pass, j = c.bid >> 3, q = ((j >> 1) * per) / (((c.G + 7) >> 3) * 2);
    const int s = (j & 1) ? q : per - q, cut = s * pass < n ? s * pass : n;
    if (when == 0) { if (cut > 0) conv_job_dma(c, job, 0, cut, c.bid, c.G); }
    else if (cut < n) conv_job_dma(c, job, cut, n, c.bid, c.G);
#else
    const int hg = c.G >> 1, half = c.bid >= hg ? 1 : 0, n = conv_job_items(job), mid = (n >> 1);
    if (half != when) return;
    conv_job_dma(c, job, half ? mid : 0, half ? n : mid, half ? c.bid - hg : c.bid, half ? c.G - hg : hg);
#endif
}
__device__ __forceinline__ void p_prologue(const Ctx& c) {
    conv_job_dma(c, 0, 0, conv_job_items(0), c.bid, c.G); __syncthreads();
    const int gw = c.bid * NWAVES + c.wave, NGW = c.G * NWAVES;
    bf16* H = (bf16*)(c.ws + WS_H);
    f32x4 va[8], vb[8]; int m = gw;
    if (m < M) rms_row_load(c.x + (size_t)m * DM, va, c.lane);
    for (; m < M; m += NGW) { const int mn = m + NGW;
        if (mn < M) rms_row_load(c.x + (size_t)mn * DM, vb, c.lane);
        rms_row_to_bf16(va, c.norm_mix, H + (size_t)m * DM, c.ws + WS_H8 + (size_t)m * DM, c.lane);
#pragma unroll
        for (int j = 0; j < 8; ++j) va[j] = vb[j]; }
}
constexpr int KP = 272, VP = 288, ATT_K_OFF = 0, ATT_V_OFF = 256 * KP, ATT_RP_OFF = ATT_V_OFF + 256 * VP;
__device__ __forceinline__ void att_write_lds(const Ctx& c, const u32x4 (&kr)[8], const u32x4 (&vr)[8], int rot) {
#pragma unroll
    for (int j = 0; j < 8; ++j) { const int id = c.tid + 512 * j, row = ((id >> 4) & 128) | (((id >> 4) + rot) & 127), c16 = id & 15;
        *(LAS u32x4*)(c.lds + ATT_K_OFF + row * KP + 16 * c16) = kr[j]; *(LAS u32x4*)(c.lds + ATT_V_OFF + row * VP + 16 * c16) = vr[j]; }
}
template <int NB, class Fn>
__device__ __forceinline__ void attn_blocks(const LAS unsigned char* lds, const int (&krow)[NB], const bf16x8 (&qf)[4], f32x4 (&O)[8], float& m, float& l, int i, int g, const Fn (&fn)[NB]) {
    const LAS unsigned char* kbp[NB]; const LAS unsigned char* vbp[NB];
#pragma unroll
    for (int nb = 0; nb < NB; ++nb) { const unsigned ko = (unsigned)(ATT_K_OFF + (krow[nb] + i) * KP + 16 * g), vo = (unsigned)(ATT_V_OFF + (krow[nb] + 4 * g + (i >> 2)) * VP + 8 * (i & 3));
        kbp[nb] = lds + ko; vbp[nb] = lds + vo; }
    f32x4 S[NB][2];
#pragma unroll
    for (int nb = 0; nb < NB; ++nb) { S[nb][0] = (f32x4){0.f, 0.f, 0.f, 0.f}; S[nb][1] = (f32x4){0.f, 0.f, 0.f, 0.f}; }
#pragma unroll
    for (int kh = 0; kh < 2; ++kh) {
        bf16x8 kf[2][NB][2];
#pragma unroll
        for (int kk = 0; kk < 2; ++kk)
#pragma unroll
            for (int nb = 0; nb < NB; ++nb)
#pragma unroll
                for (int t = 0; t < 2; ++t) kf[kk][nb][t] = *(const LAS bf16x8*)(kbp[nb] + 16 * t * KP + 64 * (2 * kh + kk));
#pragma unroll
        for (int kk = 0; kk < 2; ++kk)
#pragma unroll
            for (int nb = 0; nb < NB; ++nb)
#pragma unroll
                for (int t = 0; t < 2; ++t) S[nb][t] = __builtin_amdgcn_mfma_f32_16x16x32_bf16(kf[kk][nb][t], qf[2 * kh + kk], S[nb][t], 0, 0, 0);
    }
    s16x4 vlo[8][NB], vhi[8][NB];
#pragma unroll
    for (int dn = 0; dn < 2; ++dn)
#pragma unroll
        for (int nb = 0; nb < NB; ++nb) { const LAS unsigned char* vb = vbp[nb] + 32 * dn; vlo[dn][nb] = vtr(vb); vhi[dn][nb] = vtr(vb + 16 * VP); }
    float sc[NB][8]; float mx = -INFINITY;
#pragma unroll
    for (int nb = 0; nb < NB; ++nb)
#pragma unroll
        for (int r = 0; r < 4; ++r) { sc[nb][r] = fn[nb](0, r, S[nb][0][r]); sc[nb][4 + r] = fn[nb](1, r, S[nb][1][r]); mx = fmaxf(mx, fmaxf(sc[nb][r], sc[nb][4 + r])); }
    { const int ln = (g << 4) | i; mx = fmaxf(mx, shx(mx, 16, ln)); mx = fmaxf(mx, shx(mx, 32, ln)); }
    const float mn = fmaxf(m, mx), alpha = __builtin_amdgcn_exp2f(m - mn);
    float ps = 0.f; bf16x8 pf[NB];
#pragma unroll
    for (int nb = 0; nb < NB; ++nb) { float p[8];
#pragma unroll
        for (int j = 0; j < 8; ++j) { p[j] = __builtin_amdgcn_exp2f(sc[nb][j] - mn); ps += p[j]; }
        u32x4 pw; pw.x = cvt_pk_bf16(p[0], p[1]); pw.y = cvt_pk_bf16(p[2], p[3]); pw.z = cvt_pk_bf16(p[4], p[5]); pw.w = cvt_pk_bf16(p[6], p[7]);
        pf[nb] = __builtin_bit_cast(bf16x8, pw); }
    l = l * alpha + ps; m = mn;
#pragma unroll
    for (int dn = 2; dn < 8; ++dn)
#pragma unroll
        for (int nb = 0; nb < NB; ++nb) { const LAS unsigned char* vb = vbp[nb] + 32 * dn; vlo[dn][nb] = vtr(vb); vhi[dn][nb] = vtr(vb + 16 * VP); }
#pragma unroll
    for (int dn = 0; dn < 8; ++dn) O[dn] = O[dn] * alpha;
#pragma unroll
    for (int dn = 0; dn < 8; ++dn)
#pragma unroll
        for (int nb = 0; nb < NB; ++nb) {
            const bf16x8 vf = {vlo[dn][nb][0], vlo[dn][nb][1], vlo[dn][nb][2], vlo[dn][nb][3], vhi[dn][nb][0], vhi[dn][nb][1], vhi[dn][nb][2], vhi[dn][nb][3]};
            O[dn] = __builtin_amdgcn_mfma_f32_16x16x32_bf16(vf, pf[nb], O[dn], 0, 0, 0); }
}

__device__ __forceinline__ void sgu_unit(const Ctx& c, int u) {
    const int b = u >> 5, chn = (u >> 1) & 15, half = u & 1, tok0 = b * SEQ + chn * 128;
    const bf16* P = (const bf16*)(c.ws + WS_P); bf16* Y = (bf16*)(c.ws + WS_YCAT);
    LAS unsigned char* Vs = c.lds; LAS float* stat = (LAS float*)(c.lds + 128 * 272);
    const int lane = c.lane, wave = c.wave, i = lane & 15, g = lane >> 4;
    __syncthreads();
#pragma unroll
    for (int it = 0; it < 2; ++it) {
        u32x4 raw[2][8];
#pragma unroll
        for (int ps = 0; ps < 2; ++ps) { const bf16* row = P + (size_t)(tok0 + 16 * wave + 8 * it + 4 * ps + g) * IN_AB + 1024 + 8 * i;
#pragma unroll
            for (int j = 0; j < 8; ++j) raw[ps][j] = *(const u32x4*)(row + 128 * j); }
#pragma unroll
        for (int ps = 0; ps < 2; ++ps) { float s = 0.f;
#pragma unroll
            for (int j = 0; j < 8; ++j)
#pragma unroll
                for (int k = 0; k < 4; ++k) s += bf_lo(raw[ps][j][k]) + bf_hi(raw[ps][j][k]);
#pragma unroll
            for (int o = 1; o < 16; o <<= 1) s += shx(s, o, lane);
            const float mean = s * (1.0f / 1024.0f); float q2 = 0.f;
#pragma unroll
            for (int j = 0; j < 8; ++j)
#pragma unroll
                for (int k = 0; k < 4; ++k) { const float d0 = bf_lo(raw[ps][j][k]) - mean, d1 = bf_hi(raw[ps][j][k]) - mean; q2 += d0 * d0 + d1 * d1; }
#pragma unroll
            for (int o = 1; o < 16; o <<= 1) q2 += shx(q2, o, lane);
            const float rstd = 1.0f / sqrtf(q2 * (1.0f / 1024.0f) + LN_EPS);
            if (i == 0) { const int tk = 16 * wave + 8 * it + 4 * ps + g; stat[2 * tk] = mean; stat[2 * tk + 1] = rstd; } }
    }
    u32x4 rawv[4];
#pragma unroll
    for (int j = 0; j < 4; ++j) { const int id = c.tid + 512 * j, tok = id >> 4, c16 = id & 15; rawv[j] = *(const u32x4*)(P + (size_t)(tok0 + tok) * IN_AB + 1024 + (4 * half) * 128 + 8 * c16); }
    __syncthreads();
    for (int gi = 0; gi < 4; ++gi) {
        const int gidx = 4 * half + gi;
#pragma unroll
        for (int j = 0; j < 4; ++j) { const int id = c.tid + 512 * j, tok = id >> 4, c16 = id & 15;
            const u32x4 raw = rawv[j];
            const float mean = stat[2 * tok], rstd = stat[2 * tok + 1];
            const f32x4 g0 = *(const f32x4*)(c.a_v_norm + gidx * 128 + 8 * c16), g1 = *(const f32x4*)(c.a_v_norm + gidx * 128 + 8 * c16 + 4);
            u32x4 w;
            w.x = cvt_pk_bf16((bf_lo(raw.x) - mean) * rstd * g0.x, (bf_hi(raw.x) - mean) * rstd * g0.y);
            w.y = cvt_pk_bf16((bf_lo(raw.y) - mean) * rstd * g0.z, (bf_hi(raw.y) - mean) * rstd * g0.w);
            w.z = cvt_pk_bf16((bf_lo(raw.z) - mean) * rstd * g1.x, (bf_hi(raw.z) - mean) * rstd * g1.y);
            w.w = cvt_pk_bf16((bf_lo(raw.w) - mean) * rstd * g1.z, (bf_hi(raw.w) - mean) * rstd * g1.w);
            *(LAS u32x4*)(Vs + tok * 272 + 16 * c16) = w; }
        const int t = 16 * wave + i;
        const float* wrow = c.a_sw + (size_t)(gidx * 128 + t) * 128;
        bf16x8 bw[4];
#pragma unroll
        for (int kk = 0; kk < 4; ++kk) { const f32x4 lo = *(const f32x4*)(wrow + 32 * kk + 4 * g), hi = *(const f32x4*)(wrow + 32 * kk + 16 + 4 * g);
            u32x4 w; w.x = cvt_pk_bf16(lo.x, lo.y); w.y = cvt_pk_bf16(lo.z, lo.w); w.z = cvt_pk_bf16(hi.x, hi.y); w.w = cvt_pk_bf16(hi.z, hi.w); bw[kk] = __builtin_bit_cast(bf16x8, w); }
        const float bias = c.a_sb[gidx * 128 + t];
        if (gi < 3) {
#pragma unroll
            for (int j = 0; j < 4; ++j) { const int id = c.tid + 512 * j, tok = id >> 4, c16 = id & 15; rawv[j] = *(const u32x4*)(P + (size_t)(tok0 + tok) * IN_AB + 1024 + (gidx + 1) * 128 + 8 * c16); } }
        u32x2 uu[8];
#pragma unroll
        for (int mt = 0; mt < 8; ++mt) uu[mt] = *(const u32x2*)(P + (size_t)(tok0 + t) * IN_AB + gidx * 128 + 16 * mt + 4 * g);
        __syncthreads();
        f32x4 acc[8];
#pragma unroll
        for (int mt = 0; mt < 8; ++mt) { acc[mt] = (f32x4){0.f, 0.f, 0.f, 0.f};
#pragma unroll
            for (int kk = 0; kk < 4; ++kk) {
                const s16x4 lo = vtr(Vs + (32 * kk + 4 * g + (i >> 2)) * 272 + 32 * mt + 8 * (i & 3)), hi = vtr(Vs + (32 * kk + 16 + 4 * g + (i >> 2)) * 272 + 32 * mt + 8 * (i & 3));
                const bf16x8 af = {lo[0], lo[1], lo[2], lo[3], hi[0], hi[1], hi[2], hi[3]};
                acc[mt] = __builtin_amdgcn_mfma_f32_16x16x32_bf16(af, bw[kk], acc[mt], 0, 0, 0);
            } }
#pragma unroll
        for (int mt = 0; mt < 8; ++mt) { const int col = gidx * 128 + 16 * mt + 4 * g;
            u32x2 o; o.x = cvt_pk_bf16(bf_lo(uu[mt].x) * (acc[mt][0] + bias), bf_hi(uu[mt].x) * (acc[mt][1] + bias)); o.y = cvt_pk_bf16(bf_lo(uu[mt].y) * (acc[mt][2] + bias), bf_hi(uu[mt].y) * (acc[mt][3] + bias));
            *(u32x2*)(Y + (size_t)(tok0 + t) * DM + col) = o; }
        __syncthreads();
    }
}
struct NattenFn { const LAS float* rp; int brow, band0, cs, qc, g;
    __device__ __forceinline__ float operator()(int t, int reg, float s) const {
        const int kc = band0 + 16 * t + 4 * g + reg, rel = kc - cs; int bi = kc - qc + 15; bi = bi < 0 ? 0 : (bi > 30 ? 30 : bi);
        const float v = (s * ATT_SCALE + rp[brow + bi]) * LOG2E;
        return ((unsigned)rel < 16u) ? v : -INFINITY; } };
__device__ __forceinline__ void nat_issue(const Ctx& c, int item, u32x4 (&kr)[8], u32x4 (&vr)[8], bf16x8 (&qn)[4], int rot) {
    const int unit = item >> 2, chunk = item & 3, hp = unit & 3, r = (unit >> 2) & 31, b = unit >> 7;
    const int rs = r - 4 < 0 ? 0 : (r - 4 > 24 ? 24 : r - 4);
    const bf16* QKV = (const bf16*)(c.ws + WS_QKV); constexpr size_t WSTEP = QKV_STRIDE;
#pragma unroll
    for (int j = 0; j < 8; ++j) { const int id = c.tid + 512 * j, hh = id >> 11, row = ((id >> 4) + rot) & 127, c16 = id & 15;
        const bf16* src = QKV + WSTEP + ((size_t)(b * 8 + 2 * hp + hh) * SEQ + rs * 64 + chunk * 128 + row) * 128 + 8 * c16;
        kr[j] = *(const u32x4*)src; vr[j] = *(const u32x4*)(src + WSTEP); }
    if (chunk == 0) { const int i = c.lane & 15, g = c.lane >> 4, hh = c.wave >> 2, cb = c.wave & 3;
#pragma unroll
        for (int kk = 0; kk < 4; ++kk) qn[kk] = *(const bf16x8*)(QKV + ((size_t)(b * 8 + 2 * hp + hh) * SEQ + r * 64 + cb * 16 + i) * 128 + 32 * kk + 8 * g); }
}
__device__ __forceinline__ int nat_unit(const Ctx& c, int k) {
    if (c.G == 256) { const int x = c.bid & 7, ci = c.bid >> 3, set = 4 * x + k; return ((set >> 2) << 7) | (ci << 2) | (set & 3); }
    return c.bid + k * c.G;
}
__device__ __forceinline__ void p_natten(const Ctx& c) {
    const int NK = (1024 - c.bid + c.G - 1) / c.G, NITEM = NK * 4;
    const int lane = c.lane, wave = c.wave, i = lane & 15, g = lane >> 4, hh = wave >> 2, cb = wave & 3;
    LAS float* rp = (LAS float*)(c.lds + ATT_RP_OFF);
    u32x4 kr[8], vr[8]; bf16x8 qn[4], qf[4]; f32x4 O[8]; float m = -1e30f, l = 0.f;
#pragma unroll
    for (int kk = 0; kk < 4; ++kk) { qn[kk] = (bf16x8){0, 0, 0, 0, 0, 0, 0, 0}; qf[kk] = qn[kk]; }
#pragma unroll
    for (int dn = 0; dn < 8; ++dn) O[dn] = (f32x4){0.f, 0.f, 0.f, 0.f};
    const int band0 = cb * 16 - 8 < 0 ? 0 : (cb * 16 - 8 > 32 ? 32 : cb * 16 - 8), qc = cb * 16 + i, cs = qc - 8 < 0 ? 0 : (qc - 8 > 48 ? 48 : qc - 8);
    int item = 0;
    const int rot = (c.bid * 13) & 127;
    if (item < NITEM) nat_issue(c, nat_unit(c, 0) * 4, kr, vr, qn, rot);
    while (item < NITEM) {
        const int unit = nat_unit(c, item >> 2), chunk = item & 3, hp = unit & 3, r = (unit >> 2) & 31, b = unit >> 7;
        const int rs = r - 4 < 0 ? 0 : (r - 4 > 24 ? 24 : r - 4);
        __syncthreads();
        att_write_lds(c, kr, vr, rot);
        if (chunk == 0) {
            for (int k = c.tid; k < 930; k += NTHR) rp[k] = c.b_rpb[(2 * hp) * 465 + k];
#pragma unroll
            for (int kk = 0; kk < 4; ++kk) qf[kk] = qn[kk];
        }
        __syncthreads();
        const int nitem = item + 1;
        if (nitem < NITEM) nat_issue(c, nat_unit(c, nitem >> 2) * 4 + (nitem & 3), kr, vr, qn, rot);
        {
            const int a0 = 2 * chunk;
            const NattenFn fn[2] = {{rp + hh * 465, (rs + a0 - r + 7) * 31, band0, cs, qc, g}, {rp + hh * 465, (rs + a0 + 1 - r + 7) * 31, band0, cs, qc, g}};
            const int krow[2] = {hh * 128 + band0, hh * 128 + 64 + band0};
            attn_blocks<2, NattenFn>(c.lds, krow, qf, O, m, l, i, g, fn);
        }
        if (chunk == 3) {
            float lt = l; lt += shx(lt, 16, lane); lt += shx(lt, 32, lane);
            const float inv = 1.0f / lt;
            bf16* Y = (bf16*)(c.ws + WS_YCAT) + (size_t)(b * SEQ + r * 64 + qc) * DM + 1024 + (2 * hp + hh) * 128 + 4 * g;
#pragma unroll
            for (int dn = 0; dn < 8; ++dn) { u32x2 o; o.x = cvt_pk_bf16(O[dn][0] * inv, O[dn][1] * inv); o.y = cvt_pk_bf16(O[dn][2] * inv, O[dn][3] * inv);
                *(u32x2*)(Y + 16 * dn) = o; O[dn] = (f32x4){0.f, 0.f, 0.f, 0.f}; }
            m = -1e30f; l = 0.f;
        }
        item = nitem;
    }
}

struct ConvRegs { u32x4 cbv[2], cc[2][3], cx[2][3]; float wt[2][3]; };
__device__ __forceinline__ void conv_load(const Ctx& c, int u, int j, ConvRegs& r) {
    const bf16* P = (const bf16*)(c.ws + WS_P);
#pragma unroll
    for (int k = 0; k < 2; ++k) { const int id = c.tid + 512 * (j + k), tok = 64 * u + (id >> 7), c8 = id & 127, s = tok & (SEQ - 1);
        const bf16* row = P + (size_t)tok * IN_CD + 8 * c8; r.cbv[k] = *(const u32x4*)row;
#pragma unroll
        for (int w = 0; w < 3; ++w) { const int ss = s + w - 1; const bool in = ss >= 0 && ss < SEQ; r.wt[k][w] = in ? 1.f : 0.f;
            const bf16* rr = row + (ptrdiff_t)(in ? w - 1 : 0) * IN_CD; r.cc[k][w] = *(const u32x4*)(rr + 1024); r.cx[k][w] = *(const u32x4*)(rr + 2048); } }
}
__device__ __forceinline__ void conv_finish(const Ctx& c, int u, int j, const ConvRegs& r) {
    bf16* Y = (bf16*)(c.ws + WS_YCAT);
#pragma unroll
    for (int k = 0; k < 2; ++k) { const int id = c.tid + 512 * (j + k), tok = 64 * u + (id >> 7), c8 = id & 127;
        f32x4 acc0 = {0.f, 0.f, 0.f, 0.f}, acc1 = {0.f, 0.f, 0.f, 0.f};
#pragma unroll
        for (int w = 0; w < 3; ++w) { const f32x4 t0 = *(const f32x4*)(c.c_conv + w * 1024 + 8 * c8) * r.wt[k][w], t1 = *(const f32x4*)(c.c_conv + w * 1024 + 8 * c8 + 4) * r.wt[k][w];
            const u32x4 a = r.cc[k][w], x = r.cx[k][w];
            acc0.x += t0.x * bf_lo(a.x) * bf_lo(x.x); acc0.y += t0.y * bf_hi(a.x) * bf_hi(x.x); acc0.z += t0.z * bf_lo(a.y) * bf_lo(x.y); acc0.w += t0.w * bf_hi(a.y) * bf_hi(x.y);
            acc1.x += t1.x * bf_lo(a.z) * bf_lo(x.z); acc1.y += t1.y * bf_hi(a.z) * bf_hi(x.z); acc1.z += t1.z * bf_lo(a.w) * bf_lo(x.w); acc1.w += t1.w * bf_hi(a.w) * bf_hi(x.w); }
        const u32x4 b = r.cbv[k];
        u32x4 o; o.x = cvt_pk_bf16(bf_lo(b.x) * acc0.x, bf_hi(b.x) * acc0.y); o.y = cvt_pk_bf16(bf_lo(b.y) * acc0.z, bf_hi(b.y) * acc0.w);
        o.z = cvt_pk_bf16(bf_lo(b.z) * acc1.x, bf_hi(b.z) * acc1.y); o.w = cvt_pk_bf16(bf_lo(b.w) * acc1.z, bf_hi(b.w) * acc1.w);
        *(u32x4*)(Y + (size_t)tok * DM + 8 * c8) = o; }
}
__device__ __forceinline__ void conv_unit(const Ctx& c, int u) {
    ConvRegs ra, rb;
    conv_load(c, u, 0, ra);
#pragma unroll 1
    for (int j = 0; j < 16; j += 4) {
        conv_load(c, u, j + 2, rb);
        conv_finish(c, u, j, ra);
        if (j + 4 < 16) conv_load(c, u, j + 4, ra);
        conv_finish(c, u, j + 2, rb);
    }
}
struct DilFn { float slope_dil; int qi, g, klbase, length, rowb;
    __device__ __forceinline__ float operator()(int t, int reg, float s) const {
        const int jj = rowb + 16 * t + 4 * g + reg, delta = jj - 64 - qi, ad = delta < 0 ? -delta : delta, kl = klbase + jj;
        const float v = (s * ATT_SCALE - slope_dil * (float)ad) * LOG2E;
        return (ad <= 64 && kl >= 0 && kl < length) ? v : -INFINITY; } };
struct DilDec { int pat, h, b, dil, L, qc, res; };
__device__ __forceinline__ DilDec dil_decode(int u) { DilDec d; d.pat = u >> 10; d.h = u & 7; d.b = (u >> 3) & 7; const int sub = (u >> 6) & 15; d.dil = 1 << (2 * d.pat); const int nch = 16 >> (2 * d.pat);
    d.L = SEQ >> (2 * d.pat); d.qc = sub % nch; d.res = sub / nch; return d; }
__device__ __forceinline__ void dil_issue(const Ctx& c, int u, u32x4 (&kr)[8], u32x4 (&vr)[8], bf16x8 (&qn)[4], int rot) {
    const DilDec d = dil_decode(u);
    const bf16* QKV = (const bf16*)(c.ws + WS_QKV) + (size_t)(d.b * 8 + d.h) * SEQ * 128; constexpr size_t WSTEP = QKV_STRIDE;
#pragma unroll
    for (int j = 0; j < 8; ++j) { const int id = c.tid + 512 * j, row = ((id >> 4) & 128) | (((id >> 4) + rot) & 127), c16 = id & 15; int kl = 128 * d.qc - 64 + row;
        kl = kl < 0 ? 0 : (kl > d.L - 1 ? d.L - 1 : kl);
        const bf16* src = QKV + WSTEP + (size_t)(kl * d.dil + d.res) * 128 + 8 * c16; kr[j] = *(const u32x4*)src; vr[j] = *(const u32x4*)(src + WSTEP); }
    const int i = c.lane & 15, g = c.lane >> 4;
#pragma unroll
    for (int kk = 0; kk < 4; ++kk) qn[kk] = *(const bf16x8*)(QKV + (size_t)((128 * d.qc + 16 * c.wave + i) * d.dil + d.res) * 128 + 32 * kk + 8 * g);
}
__device__ __forceinline__ int dil_unit(const Ctx& c, int k) {
    if (c.G == 256) { const int x = c.bid & 7, ci = c.bid >> 3, lu = (k % 3) * 32 + ci, bh = 8 * x + 2 * (k / 3) + lu / 48, v = lu % 48;
        return ((v / 16) << 10) | ((v % 16) << 6) | bh; }
    return c.bid + k * c.G;
}
__device__ __forceinline__ void p_dilated(const Ctx& c) {
    const int NU = (3072 - c.bid + c.G - 1) / c.G;
    const int lane = c.lane, wave = c.wave, i = lane & 15, g = lane >> 4;
    u32x4 kr[8], vr[8]; bf16x8 qn[4], qf[4];
    const int rot = (c.bid * 13) & 127;
    if (0 < NU) dil_issue(c, dil_unit(c, 0), kr, vr, qn, rot);
    for (int k = 0; k < NU; ++k) {
        const int u = dil_unit(c, k);
        const DilDec d = dil_decode(u);
        __syncthreads();
        att_write_lds(c, kr, vr, rot);
#pragma unroll
        for (int kk = 0; kk < 4; ++kk) qf[kk] = qn[kk];
        __syncthreads();
        if (k + 1 < NU) dil_issue(c, dil_unit(c, k + 1), kr, vr, qn, rot);
        f32x4 O[8]; float m = -1e30f, l = 0.f;
        const int qi = 16 * wave + i, klbase = 128 * d.qc - 64, kb0 = wave >> 1;
#pragma unroll 1
        for (int crep = 0; crep < MK_DIL_REPS; ++crep) {
        m = -1e30f; l = 0.f;
#pragma unroll
        for (int dn = 0; dn < 8; ++dn) O[dn] = (f32x4){0.f, 0.f, 0.f, 0.f};
        const int lo_row = klbase < 0 ? -klbase : 0, hi_row = d.L - klbase < 256 ? d.L - klbase : 256;
        const float slope_dil = __builtin_amdgcn_exp2f(-(float)(d.h + 1)) * (float)d.dil;
#pragma unroll 1
        for (int pr = 0; pr < 2; ++pr) { const int r0 = 32 * (kb0 + 2 * pr);
            if (r0 + 64 > lo_row && r0 < hi_row) {
                const DilFn fn[2] = {{slope_dil, qi, g, klbase, d.L, r0}, {slope_dil, qi, g, klbase, d.L, r0 + 32}};
                const int krow[2] = {r0, r0 + 32};
                attn_blocks<2, DilFn>(c.lds, krow, qf, O, m, l, i, g, fn); } }
        { const int r0 = 32 * (kb0 + 4);
            if (r0 + 32 > lo_row && r0 < hi_row) {
                const DilFn fn[1] = {{slope_dil, qi, g, klbase, d.L, r0}};
                const int krow[1] = {r0};
                attn_blocks<1, DilFn>(c.lds, krow, qf, O, m, l, i, g, fn); } }
        }
        float lt = l; lt += shx(lt, 16, lane); lt += shx(lt, 32, lane);
        const float inv = 1.0f / lt;
        const int tokq = d.b * SEQ + (128 * d.qc + qi) * d.dil + d.res;
        bf16* OP = (bf16*)(c.ws + WS_OP) + (size_t)d.pat * OP_STRIDE + (size_t)tokq * 1024 + d.h * 128 + 4 * g;
#pragma unroll
        for (int dn = 0; dn < 8; ++dn) { u32x2 o; o.x = cvt_pk_bf16(O[dn][0] * inv, O[dn][1] * inv); o.y = cvt_pk_bf16(O[dn][2] * inv, O[dn][3] * inv); *(u32x2*)(OP + 16 * dn) = o; }
        if (g == 0) ((float*)(c.ws + WS_LSE))[((size_t)d.pat * M + tokq) * 8 + d.h] = (m + __builtin_amdgcn_logf(lt)) * LN2;
    }
}
__device__ __forceinline__ void p_merge(const Ctx& c) {
    const bf16* OP = (const bf16*)(c.ws + WS_OP); const float* LSE = (const float*)(c.ws + WS_LSE); bf16* Y = (bf16*)(c.ws + WS_YCAT);
    const int stride = c.G * NTHR;
    for (int id0 = c.bid * NTHR + c.tid; id0 < M * 128; id0 += 4 * stride) {
        float l[4][3]; u32x4 a[4][3]; bool ok[4];
#pragma unroll
        for (int k = 0; k < 4; ++k) { const int id = id0 + k * stride; ok[k] = id < M * 128; const int idc = ok[k] ? id : id0, tok = idc >> 7, c8 = idc & 127, h = c8 >> 4;
#pragma unroll
            for (int p = 0; p < 3; ++p) { l[k][p] = LSE[((size_t)p * M + tok) * 8 + h]; a[k][p] = *(const u32x4*)(OP + (size_t)p * OP_STRIDE + (size_t)tok * 1024 + 8 * c8); } }
#pragma unroll
        for (int k = 0; k < 4; ++k) { const int id = id0 + k * stride, tok = id >> 7, c8 = id & 127;
            const float mx = fmaxf(l[k][0], fmaxf(l[k][1], l[k][2])); float w0 = __expf(l[k][0] - mx), w1 = __expf(l[k][1] - mx), w2 = __expf(l[k][2] - mx); const float inv = 1.0f / (w0 + w1 + w2); w0 *= inv; w1 *= inv; w2 *= inv;
            u32x4 o;
#pragma unroll
            for (int q = 0; q < 4; ++q) o[q] = cvt_pk_bf16(w0 * bf_lo(a[k][0][q]) + w1 * bf_lo(a[k][1][q]) + w2 * bf_lo(a[k][2][q]), w0 * bf_hi(a[k][0][q]) + w1 * bf_hi(a[k][1][q]) + w2 * bf_hi(a[k][2][q]));
            if (ok[k]) *(u32x4*)(Y + (size_t)tok * DM + 1024 + 8 * c8) = o; }
    }
}

__device__ __forceinline__ void p_router(const Ctx& c, int layer) {
    const int lane = c.lane, wave = c.wave, i = lane & 15, g = lane >> 4, NU = M / 16;
    constexpr int XP = 4112, XBUF = 16 * XP;
    LAS float* red = (LAS float*)(c.lds + 2 * XBUF); LAS float* ssq = red + 2048;
    const float* gnf = c.norm_ffn + layer * DM;
    const float* gn = gnf + 256 * wave + 4 * g;
    const float* R = c.router + (size_t)layer * DM * NE + (size_t)(256 * wave + 4 * g) * NE + i;
    float rg[64];
#pragma unroll
    for (int kk = 0; kk < 16; ++kk) { const f32x4 g4 = *(const f32x4*)(gn + 16 * kk);
#pragma unroll
        for (int s = 0; s < 4; ++s) rg[4 * kk + s] = R[(size_t)(16 * kk + s) * NE] * g4[s]; }
    const unsigned char* XR = c.ws + WS_XRES;
#define RT_ISSUE(uu, bb) do { _Pragma("unroll") for (int _j = 0; _j < 8; ++_j) { const int _p = 8 * wave + _j; \
        __builtin_amdgcn_global_load_lds((const unsigned*)(XR + ((size_t)(uu) * 16 + (_p >> 2)) * 4096 + (_p & 3) * 1024 + lane * 16), (LAS unsigned*)(c.lds + (bb) * XBUF + (_p >> 2) * XP + (_p & 3) * 1024), 16, 0, 0); } } while (0)
    __syncthreads();
    int u = c.bid, b = 0;
    if (u < NU) RT_ISSUE(u, 0);
    for (; u < NU; u += c.G, b ^= 1) {
        const int row0 = u * 16;
        asm volatile("s_waitcnt vmcnt(0)" ::: "memory"); __syncthreads();
        if (u + c.G < NU) RT_ISSUE(u + c.G, b ^ 1);
        const LAS unsigned char* xb = c.lds + b * XBUF + i * XP + (256 * wave + 4 * g) * 2;
        float ss = 0.f; f32x4 acc0 = {0.f, 0.f, 0.f, 0.f}, acc1 = {0.f, 0.f, 0.f, 0.f};
#pragma unroll
        for (int kk = 0; kk < 16; ++kk) { const u32x2 w = *(const LAS u32x2*)(xb + 32 * kk); const float x0 = bf_lo(w.x), x1 = bf_hi(w.x), x2 = bf_lo(w.y), x3 = bf_hi(w.y);
            ss += (x0 * x0 + x1 * x1) + (x2 * x2 + x3 * x3);
            acc0 = __builtin_amdgcn_mfma_f32_16x16x4f32(x0, rg[4 * kk + 0], acc0, 0, 0, 0); acc1 = __builtin_amdgcn_mfma_f32_16x16x4f32(x1, rg[4 * kk + 1], acc1, 0, 0, 0);
            acc0 = __builtin_amdgcn_mfma_f32_16x16x4f32(x2, rg[4 * kk + 2], acc0, 0, 0, 0); acc1 = __builtin_amdgcn_mfma_f32_16x16x4f32(x3, rg[4 * kk + 3], acc1, 0, 0, 0); }
        const f32x4 acc = acc0 + acc1;
        ss += shx(ss, 16, lane); ss += shx(ss, 32, lane);
#pragma unroll
        for (int r = 0; r < 4; ++r) red[wave * 256 + (4 * g + r) * 16 + i] = acc[r];
        if (g == 0) ssq[wave * 16 + i] = ss;
        __syncthreads();
#pragma unroll
        for (int j = 0; j < 4; ++j) { const int cid = c.tid + 512 * j, row = cid >> 7, c16 = cid & 127; float tot = 0.f;
#pragma unroll
            for (int w = 0; w < 8; ++w) tot += ssq[w * 16 + row];
            const float rstd = 1.0f / sqrtf(tot * (1.0f / DM) + RMS_EPS);
            const LAS unsigned char* xs = c.lds + b * XBUF + row * XP + c16 * 32;
            const u32x4 wa = *(const LAS u32x4*)xs, wb = *(const LAS u32x4*)(xs + 16);
            u32x4 o;
#pragma unroll
            for (int q = 0; q < 4; ++q) { const unsigned wq0 = q < 2 ? wa[2 * q] : wb[2 * q - 4], wq1 = q < 2 ? wa[2 * q + 1] : wb[2 * q - 3];
                const f32x4 g4 = *(const f32x4*)(gnf + 16 * c16 + 4 * q) * rstd; int p = 0;
                p = __builtin_amdgcn_cvt_pk_fp8_f32(__builtin_amdgcn_fmed3f(bf_lo(wq0) * g4.x, -448.f, 448.f), __builtin_amdgcn_fmed3f(bf_hi(wq0) * g4.y, -448.f, 448.f), p, false);
                p = __builtin_amdgcn_cvt_pk_fp8_f32(__builtin_amdgcn_fmed3f(bf_lo(wq1) * g4.z, -448.f, 448.f), __builtin_amdgcn_fmed3f(bf_hi(wq1) * g4.w, -448.f, 448.f), p, true);
                o[q] = (unsigned)p; }
            *(u32x4*)(c.ws + WS_H8 + (size_t)(row0 + row) * DM + 16 * c16) = o; }
        if (wave == 0) {
            float* AFF = (float*)(c.ws + WS_AFF);
#pragma unroll
            for (int r = 0; r < 4; ++r) { const int row = 4 * g + r; float t2 = 0.f, lg = 0.f;
#pragma unroll
                for (int w = 0; w < 8; ++w) { t2 += ssq[w * 16 + row]; lg += red[w * 256 + row * 16 + i]; }
                lg *= 1.0f / sqrtf(t2 * (1.0f / DM) + RMS_EPS);
                float mx = lg;
#pragma unroll
                for (int o = 1; o < 16; o <<= 1) mx = fmaxf(mx, shx(mx, o, lane));
                const float ex = __expf(lg - mx); float sm = ex;
#pragma unroll
                for (int o = 1; o < 16; o <<= 1) sm += shx(sm, o, lane);
                const int grow = row0 + row;
                AFF[((size_t)(grow >> 11) * NE + i) * SEQ + (grow & (SEQ - 1))] = ex / sm; }
        }
    }
#undef RT_ISSUE
    asm volatile("s_waitcnt vmcnt(0)" ::: "memory");
}

__device__ __forceinline__ void topk_unit(const Ctx& c, int w) {
    const int be = w, e = be >> 3, b = be & 7, lane = c.lane, wave = c.wave, tid = c.tid;
    LAS unsigned* wsum = (LAS unsigned*)c.lds;
    const u32x4 mine = *(const u32x4*)((const unsigned*)(c.ws + WS_AFF) + (size_t)(b * NE + e) * SEQ + 4 * tid);
    __syncthreads();
    unsigned T = 0u;
    for (int bit = 30; bit >= 0; --bit) {
        const unsigned cand = T | (1u << bit);
        int cnt = (int)(mine.x >= cand) + (int)(mine.y >= cand) + (int)(mine.z >= cand) + (int)(mine.w >= cand);
#pragma unroll
        for (int o = 1; o < 64; o <<= 1) cnt += shx(cnt, o, lane);
        if (lane == 0) wsum[(bit & 1) * 8 + wave] = (unsigned)cnt;
        __syncthreads();
        unsigned tot = 0u;
#pragma unroll
        for (int k = 0; k < 8; ++k) tot += wsum[(bit & 1) * 8 + k];
        if (tot >= (unsigned)CAP) T = cand;
    }
    unsigned gt[4], eq[4]; unsigned val = 0u;
#pragma unroll
    for (int k = 0; k < 4; ++k) { gt[k] = mine[k] > T ? 1u : 0u; eq[k] = mine[k] == T ? 1u : 0u; val += gt[k] + (eq[k] << 16); }
    unsigned incl = val;
#pragma unroll
    for (int o = 1; o < 64; o <<= 1) { const unsigned t = shup(incl, o, lane); if (lane >= o) incl += t; }
    if (lane == 63) wsum[16 + wave] = incl;
    __syncthreads();
    unsigned base = 0u, total = 0u;
#pragma unroll
    for (int k = 0; k < 8; ++k) { const unsigned t = wsum[16 + k]; total += t; if (k < wave) base += t; }
    const unsigned excl = base + incl - val, need = (unsigned)CAP - (total & 0xffffu);
    unsigned gtb = excl & 0xffffu, eqb = excl >> 16;
    int* SEL = (int*)(c.ws + WS_SEL); float* GATE = (float*)(c.ws + WS_GATE); int* IDX = (int*)(c.ws + WS_IDX);
#pragma unroll
    for (int k = 0; k < 4; ++k) { const int s = 4 * tid + k; const bool sel = gt[k] || (eq[k] && eqb < need); const unsigned slot = gtb + (eqb < need ? eqb : need);
        if (sel) { IDX[be * CAP + slot] = b * SEQ + s; GATE[be * CAP + slot] = __uint_as_float(mine[k]); }
        SEL[((size_t)b * SEQ + s) * NE + e] = sel ? (int)slot : -1;
        gtb += gt[k]; eqb += eq[k]; }
}

template <int FINAL>
__device__ __forceinline__ void p_combine(const Ctx& c, const float* gw) {
    const int lane = c.lane, stride = c.G * NWAVES; int m = c.bid * NWAVES + c.wave;
    if (m >= M) return;
    const unsigned char* YE = c.ws + WS_YE; const int* SEL = (const int*)(c.ws + WS_SEL);
    u32x4 xw[4], xn[4]; int selv, seln;
    { const bf16* xr = (const bf16*)(c.ws + WS_XRES) + (size_t)m * DM;
#pragma unroll
      for (int j = 0; j < 4; ++j) xw[j] = *(const u32x4*)(xr + 512 * j + 8 * lane);
      selv = SEL[(size_t)m * NE + (lane & 15)]; }
    for (;;) {
        const int mn = m + stride; const bool more = mn < M;
        if (more) { const bf16* xr = (const bf16*)(c.ws + WS_XRES) + (size_t)mn * DM;
#pragma unroll
            for (int j = 0; j < 4; ++j) xn[j] = *(const u32x4*)(xr + 512 * j + 8 * lane);
            seln = SEL[(size_t)mn * NE + (lane & 15)]; }
        const int b = m >> 11;
        f32x4 v[8];
#pragma unroll
        for (int j = 0; j < 4; ++j) { const u32x4 w = xw[j];
            v[2 * j] = (f32x4){bf_lo(w.x), bf_hi(w.x), bf_lo(w.y), bf_hi(w.y)}; v[2 * j + 1] = (f32x4){bf_lo(w.z), bf_hi(w.z), bf_lo(w.w), bf_hi(w.w)}; }
        unsigned mask = (unsigned)__builtin_amdgcn_ballot_w64(selv >= 0) & 0xffffu;
        while (mask) {
            u32x2 y[4][4]; int have[4];
#pragma unroll
            for (int t = 0; t < 4; ++t) { have[t] = mask != 0u;
                if (have[t]) { const int e = __builtin_ctz(mask); mask &= mask - 1u; const int slot = __builtin_amdgcn_readlane(selv, e);
                    const unsigned char* yr = YE + (size_t)((e * 8 + b) * CAP + slot) * DM + 8 * lane;
#pragma unroll
                    for (int j = 0; j < 4; ++j) y[t][j] = *(const u32x2*)(yr + 512 * j); } }
#pragma unroll
            for (int t = 0; t < 4; ++t) if (have[t]) {
#pragma unroll
                for (int j = 0; j < 4; ++j) { const u32x2 yy = y[t][j]; constexpr float YI = 1.0f / YE_SCALE;
                    const auto a0 = __builtin_amdgcn_cvt_pk_f32_fp8((int)yy.x, false), a1 = __builtin_amdgcn_cvt_pk_f32_fp8((int)yy.x, true), a2 = __builtin_amdgcn_cvt_pk_f32_fp8((int)yy.y, false), a3 = __builtin_amdgcn_cvt_pk_f32_fp8((int)yy.y, true);
                    v[2 * j].x += a0[0] * YI; v[2 * j].y += a0[1] * YI; v[2 * j].z += a1[0] * YI; v[2 * j].w += a1[1] * YI;
                    v[2 * j + 1].x += a2[0] * YI; v[2 * j + 1].y += a2[1] * YI; v[2 * j + 1].z += a3[0] * YI; v[2 * j + 1].w += a3[1] * YI; } }
        }
        float ss = 0.f;
#pragma unroll
        for (int j = 0; j < 8; ++j) ss += (v[j].x * v[j].x + v[j].y * v[j].y) + (v[j].z * v[j].z + v[j].w * v[j].w);
        const float rstd = 1.0f / sqrtf(wave_sum(ss, lane) * (1.0f / DM) + RMS_EPS);
#pragma unroll
        for (int j = 0; j < 4; ++j) {
            const f32x4 g0 = *(const f32x4*)(gw + 512 * j + 8 * lane), g1 = *(const f32x4*)(gw + 512 * j + 8 * lane + 4);
            const f32x4 a = v[2 * j] * rstd * g0, b2 = v[2 * j + 1] * rstd * g1;
            if (FINAL) { float* orow = c.out + (size_t)m * DM + 512 * j + 8 * lane; *(f32x4*)orow = a; *(f32x4*)(orow + 4) = b2; }
            else { { u32x4 xo; xo.x = cvt_pk_bf16(v[2 * j].x, v[2 * j].y); xo.y = cvt_pk_bf16(v[2 * j].z, v[2 * j].w); xo.z = cvt_pk_bf16(v[2 * j + 1].x, v[2 * j + 1].y); xo.w = cvt_pk_bf16(v[2 * j + 1].z, v[2 * j + 1].w);
                    *(u32x4*)((bf16*)(c.ws + WS_XRES) + (size_t)m * DM + 512 * j + 8 * lane) = xo; }
                u32x4 o; o.x = cvt_pk_bf16(a.x, a.y); o.y = cvt_pk_bf16(a.z, a.w); o.z = cvt_pk_bf16(b2.x, b2.y); o.w = cvt_pk_bf16(b2.z, b2.w);
                *(u32x4*)((bf16*)(c.ws + WS_H) + (size_t)m * DM + 512 * j + 8 * lane) = o;
                int p0 = 0, p1 = 0;
                p0 = __builtin_amdgcn_cvt_pk_fp8_f32(__builtin_amdgcn_fmed3f(a.x, -448.f, 448.f), __builtin_amdgcn_fmed3f(a.y, -448.f, 448.f), p0, false); p0 = __builtin_amdgcn_cvt_pk_fp8_f32(__builtin_amdgcn_fmed3f(a.z, -448.f, 448.f), __builtin_amdgcn_fmed3f(a.w, -448.f, 448.f), p0, true);
                p1 = __builtin_amdgcn_cvt_pk_fp8_f32(__builtin_amdgcn_fmed3f(b2.x, -448.f, 448.f), __builtin_amdgcn_fmed3f(b2.y, -448.f, 448.f), p1, false); p1 = __builtin_amdgcn_cvt_pk_fp8_f32(__builtin_amdgcn_fmed3f(b2.z, -448.f, 448.f), __builtin_amdgcn_fmed3f(b2.w, -448.f, 448.f), p1, true);
                u32x2 w8; w8.x = (unsigned)p0; w8.y = (unsigned)p1; *(u32x2*)(c.ws + WS_H8 + (size_t)m * DM + 512 * j + 8 * lane) = w8; } }
        if (!more) break;
        m = mn; selv = seln;
#pragma unroll
        for (int j = 0; j < 4; ++j) xw[j] = xn[j];
    }
}

typedef __attribute__((address_space(4))) const unsigned char* kaptr_t;
__device__ __forceinline__ bool phase_enter(Ctx& c) { const int ln = lane_now(); int w = c.wave0; asm volatile("" : "+s"(w)); c.wave = w; c.lane = ln; c.tid = w * 64 + ln;
    kaptr_t ka = (kaptr_t)__builtin_amdgcn_kernarg_segment_ptr(); asm volatile("" : "+s"(ka));
    typedef const float* fptr_t; typedef float* mfptr_t; typedef unsigned char* ucptr_t; typedef __attribute__((address_space(4))) const fptr_t* inptr_t; inptr_t in = (inptr_t)ka;
    c.x = in[0]; c.norm_mix = in[1]; c.norm_ffn = in[2]; c.norm_final = in[3]; c.w_in_ab = in[4]; c.a_v_norm = in[5]; c.a_sw = in[6]; c.a_sb = in[7];
    c.b_rpb = in[8]; c.w_out_ab = in[9]; c.w_in_cd = in[10]; c.c_conv = in[11]; c.w_out_cd = in[12]; c.router = in[13]; c.w_gate = in[14]; c.w_up = in[15]; c.w_down = in[16];
    c.out = *(__attribute__((address_space(4))) const mfptr_t*)(ka + 136); c.ws = *(__attribute__((address_space(4))) const ucptr_t*)(ka + 144);
    return true; }
constexpr int NPH = 18;
struct Args { const float* in[17]; float* out; unsigned char* ws; int ph_lo, ph_hi; };
__global__ void __launch_bounds__(NTHR, 2) mk_fwd(Args args) {
    extern __shared__ __attribute__((aligned(16))) unsigned char lds_raw[];
    Ctx c;
    c.lds = (LAS unsigned char*)lds_raw;
    c.tid = threadIdx.x; c.lane = c.tid & 63; c.wave = __builtin_amdgcn_readfirstlane(c.tid >> 6); c.wave0 = c.wave; c.G = gridDim.x; c.bid = blockIdx.x;
    c.ws = args.ws;
    static_assert(sizeof(Args) == 160, "phase_enter reads the kernarg segment by offset");
    volatile LAS unsigned* MISC = (volatile LAS unsigned*)(c.lds + MISC_OFF);
    for (int u = c.tid; u < (LDS_BYTES - LDSCTL_OFF) / 4; u += NTHR) ((LAS unsigned*)(c.lds + LDSCTL_OFF))[u] = 0u;
    __syncthreads();
    unsigned* barw = (unsigned*)(c.ws + WS_CTL) + 1024;
    XcdBarrier bar; bar.bar = barw; bar.x = 0; bar.st = nullptr; bar.wave = c.wave0;
    const int lo = args.ph_lo, hi = args.ph_hi;
#define NOST ((hi - lo == 1) ? (MK_PROBE_NOSTORE) : 0)
    if (hi - lo > 1) bar = xcd_barrier_post(barw, MISC + 8, c.wave0);
#define IN(k) (lo <= (k) && (k) < hi && phase_enter(c))
#define PH(k) for (int rep_ = 0; rep_ < (((k) == MK_REPEAT) ? 2 : 1); ++rep_) if (IN(k))
#define INR(k) (lo <= (k) && (k) < hi)
#define SEAM(k) do { if (INR(k) && INR((k) + 1)) { xcd_barrier(bar); if (MK_DOUBLE_BAR) xcd_barrier(bar); } } while (0)
#define H ((bf16*)(c.ws + WS_H))
#define P ((bf16*)(c.ws + WS_P))
#define YC ((bf16*)(c.ws + WS_YCAT))
#define XRES ((bf16*)(c.ws + WS_XRES))

    PH(0) { p_prologue(c); } SEAM(0);
    for (int layer = 0; layer < 2; ++layer) {
        const int pb = 1 + 8 * layer;
        if (layer == 0) {
            PH(1) { conv_job_half(c, 1, 0); conv_job_half(c, 4, 0); __syncthreads();
                { pg8::Gemm g{H, (const bf16*)(c.ws + WS_WIN0), M, 2048, DM}; pg8::Order S; S.init(M, 2048, c.G, c.bid, 0);
                  pg8::EpiBf16 E{P, IN_AB, 8, 1 << 30, (bf16*)(c.ws + WS_QKV), QKV_STRIDE, 1.0f, NOST}; pg8::gemm_phase<pg8::EpiBf16, pg8::Order, MK_ALIGN, MK_SP2>(c.lds, g, S, E, c.tid); }
                { pg8::Gemm g{(const bf16*)(c.ws + WS_H8), (const bf16*)(c.ws + WS_WIN8), M, 3072, DM}; pg8::Order S; S.init(M, 3072, c.G, c.bid, 0);
                  { LAS int* tab = (LAS int*)(c.lds + RING_BYTES); S.tab = tab; pg8::Unit uu;
#pragma unroll 1
                    for (int kq = 0; kq < 15 && S.next(kq, uu); ++kq) if (c.tid < 256) tab[kq * 256 + c.tid] = uu.pm * 256 + c.tid;
                    __syncthreads(); }
                  pg8::EpiBf16 E{P, IN_AB, 0, 0, (bf16*)(c.ws + WS_QKV), QKV_STRIDE, 1.0f / W8_SCALE, NOST}; pg8::gemm_phase<pg8::EpiBf16, pg8::Order, MK_ALIGN, MK_SP2, true, true>(c.lds, g, S, E, c.tid); }
                conv_job_half(c, 1, 1); conv_job_half(c, 4, 1); } SEAM(1);
            PH(2) { for (int rp2 = 0; rp2 < (MK_REPEAT == 20 ? 2 : 1); ++rp2) for (int u = c.bid; u < 256; u += c.G) sgu_unit(c, u); for (int rp2 = 0; rp2 < (MK_REPEAT == 21 ? 2 : 1); ++rp2) p_natten(c); } SEAM(2);
            PH(3) { conv_job_half(c, 5, 0); __syncthreads(); pg8::Gemm g{YC, (const bf16*)(c.ws + WS_WOUT0), M, DM, DM}; pg8::Order S; S.init(M, DM, c.G, c.bid, 0);
                pg8::EpiResidB E{c.x, XRES, DM, 1}; pg8::gemm_phase<pg8::EpiResidB, pg8::Order, MK_ALIGN, MK_SP2>(c.lds, g, S, E, c.tid); conv_job_half(c, 5, 1); } SEAM(3);
        } else {
            PH(8) { p_combine<0>(c, c.norm_mix + DM); } SEAM(8);
            PH(9) { { pg8::Gemm g{H, (const bf16*)(c.ws + WS_WIN1), M, 3072, DM}; pg8::Order S; S.init(M, 3072, c.G, c.bid, 0);
                  pg8::EpiBf16 E{P, IN_CD, 0, 1 << 30, (bf16*)(c.ws + WS_QKV), QKV_STRIDE, 1.0f, NOST}; pg8::gemm_phase<pg8::EpiBf16, pg8::Order, MK_ALIGN, MK_SP2>(c.lds, g, S, E, c.tid); }
                { pg8::Gemm g{(const bf16*)(c.ws + WS_H8), (const bf16*)(c.ws + WS_WIN8 + 6 * MiB), M, 3072, DM}; pg8::Order S; S.init(M, 3072, c.G, c.bid, 0);
                  { LAS int* tab = (LAS int*)(c.lds + RING_BYTES); S.tab = tab; pg8::Unit uu;
#pragma unroll 1
                    for (int kq = 0; kq < 15 && S.next(kq, uu); ++kq) if (c.tid < 256) tab[kq * 256 + c.tid] = uu.pm * 256 + c.tid;
                    __syncthreads(); }
                  pg8::EpiBf16 E{P, IN_CD, 0, 0, (bf16*)(c.ws + WS_QKV), QKV_STRIDE, 1.0f / W8_SCALE, NOST}; pg8::gemm_phase<pg8::EpiBf16, pg8::Order, MK_ALIGN, MK_SP2, true, true>(c.lds, g, S, E, c.tid); } } SEAM(9);
            PH(10) { for (int rp2 = 0; rp2 < (MK_REPEAT == 100 ? 2 : 1); ++rp2) for (int u = c.bid; u < 256; u += c.G) conv_unit(c, u); for (int rp2 = 0; rp2 < (MK_REPEAT == 101 ? 2 : 1); ++rp2) p_dilated(c); } SEAM(10);
            PH(11) { p_merge(c); } SEAM(11);
            PH(12) { pg8::Gemm g{YC, (const bf16*)(c.ws + WS_WOUT1), M, DM, DM}; pg8::Order S; S.init(M, DM, c.G, c.bid, 0);
                pg8::EpiResidB E{XRES, XRES, DM, 0}; pg8::gemm_phase<pg8::EpiResidB, pg8::Order, MK_ALIGN, MK_SP2>(c.lds, g, S, E, c.tid); } SEAM(12);
        }
        const int pr = layer == 0 ? 4 : 13;
        PH(pr) { p_router(c, layer); } SEAM(pr);
        PH(pr + 1) { for (int u = c.bid; u < 128; u += c.G) topk_unit(c, u); } SEAM(pr + 1);
        PH(pr + 2) { if (layer == 0) { conv_job_half(c, 2, 0); conv_job_half(c, 3, 0); conv_job_half(c, 6, 0); } __syncthreads();
            pg8::Gemm g{(const bf16*)(c.ws + WS_H8), (const bf16*)(c.ws + WS_WGU + (size_t)layer * 128 * MiB), MOE_ROWS, 4096, DM};     pg8::Order S; S.init(MOE_ROWS, 4096, c.G, c.bid, 1);
            { LAS int* tab = (LAS int*)(c.lds + RING_BYTES); S.tab = tab; const int* IDX = (const int*)(c.ws + WS_IDX); pg8::Unit uu;
#pragma unroll 1
                for (int k = c.wave; k < 15 && S.next(k, uu); k += NWAVES) {
                    typedef int i32x4 __attribute__((ext_vector_type(4))); const i32x4 v = *(const i32x4*)(IDX + uu.pm * 256 + 4 * c.lane); *(LAS i32x4*)(tab + k * 256 + 4 * c.lane) = v; }
                __syncthreads(); }
            pg8::EpiSwiglu E{c.ws + WS_HID, DE, 1.0f / W8_SCALE, NOST};
#if MK_PROBE_NOSTORE >= 4
            if (hi - lo == 1) pg8::gemm_phase<pg8::EpiSwiglu, pg8::Order, MK_ALIGN, MK_SP2, true, true, MK_PROBE_NOSTORE>(c.lds, g, S, E, c.tid); else
#endif
            pg8::gemm_phase<pg8::EpiSwiglu, pg8::Order, MK_ALIGN, MK_SP2, true, true>(c.lds, g, S, E, c.tid); if (layer == 0) { conv_job_half(c, 2, 1); conv_job_half(c, 3, 1); conv_job_half(c, 6, 1); } } SEAM(pr + 2);
        PH(pr + 3) { if (layer == 0) conv_job_half(c, 7, 0); __syncthreads(); pg8::Gemm g{(const bf16*)(c.ws + WS_HID), (const bf16*)(c.ws + WS_WDN + (size_t)layer * 64 * MiB), MOE_ROWS, DM, DE};   pg8::Order S; S.init(MOE_ROWS, DM, c.G, c.bid, 1);
            { LAS int* tab = (LAS int*)(c.lds + RING_BYTES); S.tab = tab; pg8::Unit uu;
#pragma unroll 1
                for (int k = 0; k < 15 && S.next(k, uu); ++k) if (c.tid < 256) tab[k * 256 + c.tid] = uu.pm * 256 + c.tid;
                __syncthreads(); }
            pg8::EpiDown E{c.ws + WS_YE, DM, (const float*)(c.ws + WS_GATE), YE_SCALE / W8_SCALE, NOST}; pg8::gemm_phase<pg8::EpiDown, pg8::Order, MK_ALIGN, MK_SP2, true, true>(c.lds, g, S, E, c.tid); if (layer == 0) conv_job_half(c, 7, 1); } SEAM(pr + 3);
        (void)pb;
    }
    PH(17) { p_combine<1>(c, c.norm_final); }
#undef IN
#undef H
#undef P
#undef YC
#undef XRES
#undef PH
#undef INR
#undef SEAM
}

extern "C" void kernel_launch(void* const* d_in, const int* in_sizes, int n_in, void* d_out, int out_size, void* d_ws, size_t ws_size, hipStream_t stream) {
    static int grid = 0;
    if (grid == 0) {
        if (n_in != 17 || out_size != M * DM || ws_size < WS_END) { fprintf(stderr, "kernel_launch: unexpected shapes (n_in %d out %d ws %zu)\n", n_in, out_size, ws_size); grid = -1; return; }
        int dev = 0, cus = 0, per_cu = 0;
        if (hipGetDevice(&dev) != hipSuccess || hipDeviceGetAttribute(&cus, hipDeviceAttributeMultiprocessorCount, dev) != hipSuccess) { grid = -1; return; }
        if (hipFuncSetAttribute((const void*)mk_fwd, hipFuncAttributeMaxDynamicSharedMemorySize, LDS_BYTES) != hipSuccess) { fprintf(stderr, "kernel_launch: hipFuncSetAttribute failed\n"); grid = -1; return; }
        if (hipOccupancyMaxActiveBlocksPerMultiprocessor(&per_cu, (const void*)mk_fwd, NTHR, LDS_BYTES) != hipSuccess || per_cu < 1) { fprintf(stderr, "kernel_launch: occupancy query says %d\n", per_cu); (void)hipGetLastError(); }
        grid = cus;
    }
    if (grid < 0) return;
    (void)hipMemsetAsync((char*)d_ws + WS_CTL, 0, CTL_ZERO_BYTES, stream);
    Args a{};
    for (int i = 0; i < 17; ++i) a.in[i] = (const float*)d_in[i];
    a.out = (float*)d_out; a.ws = (unsigned char*)d_ws;
#if MK_N_LAUNCHES == 1
    a.ph_lo = 0; a.ph_hi = NPH;
    hipLaunchKernelGGL(mk_fwd, dim3(grid), dim3(NTHR), LDS_BYTES, stream, a);
#if MK_PROBE_PHASE >= 0
    a.ph_lo = MK_PROBE_PHASE; a.ph_hi = MK_PROBE_PHASE + 1;
    hipLaunchKernelGGL(mk_fwd, dim3(grid), dim3(NTHR), LDS_BYTES, stream, a);
#endif
#else
    for (int p = 0; p < NPH; ++p) { a.ph_lo = p; a.ph_hi = p + 1; hipLaunchKernelGGL(mk_fwd, dim3(grid), dim3(NTHR), LDS_BYTES, stream, a); }
#endif
}
```
